# Optimizing an MI355X kernel written in HIP

```python
import math
import jax
import jax.numpy as jnp
from jax import lax
import numpy as np

D_MODEL = 1024
BATCH = 8
SEQ = 2048
DEPTH = 2
DEC_BATCH = 32
DEC_SEQ = 4
PAST_LEN = 16384
PAGE_SIZE = 128

CONV_WIDTH = 4
SSD_HEADS = 16
SSD_HEAD_DIM = 64
SSD_WIDTH = SSD_HEADS * SSD_HEAD_DIM
SSD_GROUPS = 2
SSD_STATE = 128
SSD_CONV_DIM = SSD_WIDTH + 2 * SSD_GROUPS * SSD_STATE
SSD_CHUNK = 128
MLA_HEADS = 8
MLA_NOPE = 64
MLA_ROPE = 32
MLA_V = 64
MLA_WIDTH = MLA_HEADS * MLA_V
MLA_Q_RANK = 384
MLA_KV_RANK = 256
MLA_SCALE = (MLA_NOPE + MLA_ROPE) ** -0.5
ROPE_THETA = 10000.0
Q_BLOCK = 128
GDN_HEADS = 4
GDN_HEAD_DIM = 128
GDN_WIDTH = GDN_HEADS * GDN_HEAD_DIM
GDN_CONV_DIM = 3 * GDN_WIDTH
GDN_CHUNK = 64

MIX_WIDTH = SSD_WIDTH + MLA_WIDTH + GDN_WIDTH
IN_SIZES = (SSD_WIDTH, SSD_CONV_DIM, SSD_HEADS,
            MLA_Q_RANK, MLA_KV_RANK, MLA_ROPE, MLA_WIDTH,
            GDN_CONV_DIM, GDN_WIDTH, GDN_HEADS, GDN_HEADS)
IN_WIDTH = sum(IN_SIZES)
IN_OFFSETS = tuple(int(o) for o in np.cumsum(IN_SIZES)[:-1])

DEEPNORM_ALPHA = (2 * DEPTH) ** 0.25
DEEPNORM_BETA = (8 * DEPTH) ** -0.25
LN_EPS = 1e-5
RMS_EPS = 1e-6
L2_EPS = 1e-6

kernel_name = 'hymba_ssd_mla_gdn_deepnorm_step'


def layer_norm(x, g, b):
    xf = x.astype(jnp.float32)
    mu = jnp.mean(xf, -1, keepdims=True)
    var = jnp.mean(jnp.square(xf - mu), -1, keepdims=True)
    return ((xf - mu) * lax.rsqrt(var + LN_EPS) * g + b).astype(x.dtype)


def rms_norm(x, g):
    xf = x.astype(jnp.float32)
    return (xf * lax.rsqrt(jnp.mean(xf * xf, -1, keepdims=True) + RMS_EPS) * g).astype(x.dtype)


def l2_normalize(x):
    return x * lax.rsqrt(jnp.sum(x * x, -1, keepdims=True) + L2_EPS)


def causal_conv(x, prev, w):
    xp = jnp.concatenate([prev.astype(x.dtype), x], axis=1)
    y = lax.conv_general_dilated(xp, w[:, None, :].astype(x.dtype), (1,), 'VALID',
                                 dimension_numbers=('NWC', 'WIO', 'NWC'),
                                 feature_group_count=x.shape[-1])
    return y, xp[:, xp.shape[1] - (CONV_WIDTH - 1):]


def rope(x, pos):
    half = x.shape[-1] // 2
    inv = ROPE_THETA ** (-jnp.arange(half, dtype=jnp.float32) / half)
    ang = pos.astype(jnp.float32)[:, None] * inv[None, :]
    cos, sin = jnp.cos(ang)[:, None, :], jnp.sin(ang)[:, None, :]
    xf = x.astype(jnp.float32)
    x1, x2 = xf[..., :half], xf[..., half:]
    return jnp.concatenate([x1 * cos - x2 * sin, x2 * cos + x1 * sin], -1).astype(x.dtype)


def chunk_len(t, c):
    return c if t % c == 0 else t


def to_chunks(a, L):
    b, t = a.shape[:2]
    return jnp.moveaxis(a.reshape(b, t // L, L, *a.shape[2:]), 1, 0)


def from_chunks(a):
    nc, b, L = a.shape[:3]
    return jnp.moveaxis(a, 0, 1).reshape(b, nc * L, *a.shape[3:])


def ssd_scan(x, dt, a, bm, cm, h0):
    L = chunk_len(x.shape[1], SSD_CHUNK)
    causal = jnp.tril(jnp.ones((L, L), bool))

    def step(h, inp):
        xc, dtc, bc, cc = inp
        acum = jnp.cumsum(dtc * a, axis=1)
        seg = acum[:, :, None, :] - acum[:, None, :, :]
        decay = jnp.exp(jnp.where(causal[None, :, :, None], seg, -jnp.inf))
        xdt = xc * dtc[..., None]
        scores = jnp.einsum('bthn,bshn->btsh', cc, bc) * decay
        y_in = jnp.einsum('btsh,bshp->bthp', scores, xdt)
        y_st = jnp.einsum('bthn,bhpn->bthp', cc, h) * jnp.exp(acum)[..., None]
        last = acum[:, -1]
        wdec = jnp.exp(last[:, None, :] - acum)
        h_new = h * jnp.exp(last)[:, :, None, None] + jnp.einsum('bshn,bshp->bhpn', bc * wdec[..., None], xdt)
        return h_new, y_in + y_st

    h_fin, ys = lax.scan(step, h0, (to_chunks(x, L), to_chunks(dt, L), to_chunks(bm, L), to_chunks(cm, L)))
    return from_chunks(ys), h_fin


def gdn_scan(q, k, v, g, beta, s0):
    L = chunk_len(q.shape[1], GDN_CHUNK)
    incl = jnp.tril(jnp.ones((L, L), bool))
    strict = jnp.tril(jnp.ones((L, L), bool), -1)
    eye = jnp.eye(L, dtype=jnp.float32)

    def step(s, inp):
        qc, kc, vc, gc, bc = inp
        gcum = jnp.cumsum(gc, axis=1)
        gh = jnp.swapaxes(gcum, 1, 2)
        diff = gh[..., :, None] - gh[..., None, :]
        dec = jnp.exp(jnp.where(incl, diff, -jnp.inf))
        kb = kc * bc[..., None]
        amat = jnp.where(strict, jnp.einsum('bthd,bshd->bhts', kb, kc) * dec, 0.0)
        tmat = lax.linalg.triangular_solve(amat + eye, jnp.broadcast_to(eye, amat.shape),
                                           left_side=True, lower=True)
        u = jnp.einsum('bhts,bshe->bthe', tmat, vc * bc[..., None])
        w = jnp.einsum('bhts,bshd->bthd', tmat, kb * jnp.exp(gcum)[..., None])
        v_new = u - jnp.einsum('bthd,bhde->bthe', w, s)
        attn = jnp.where(incl, jnp.einsum('bthd,bshd->bhts', qc, kc) * dec, 0.0)
        o = (jnp.einsum('bthd,bhde->bthe', qc * jnp.exp(gcum)[..., None], s)
             + jnp.einsum('bhts,bshe->bthe', attn, v_new))
        last = gcum[:, -1]
        kd = kc * jnp.exp(last[:, None, :] - gcum)[..., None]
        s_new = s * jnp.exp(last)[..., None, None] + jnp.einsum('bshd,bshe->bhde', kd, v_new)
        return s_new, o

    s_fin, os_ = lax.scan(step, s0, (to_chunks(q, L), to_chunks(k, L), to_chunks(v, L),
                                     to_chunks(g, L), to_chunks(beta, L)))
    return from_chunks(os_), s_fin


def mla_attention(q_lat, q_rope, kv_lat, k_rope, q_pos):
    nt = q_lat.shape[1]
    k_pos = jnp.arange(kv_lat.shape[1])

    def attend(blk):
        ql, qr, qp = blk
        s = (jnp.einsum('bthr,bsr->bhts', ql, kv_lat)
             + jnp.einsum('bthd,bsd->bhts', qr, k_rope)).astype(jnp.float32) * MLA_SCALE
        s = jnp.where(k_pos[None, :] <= qp[:, None], s, -jnp.inf)
        p = jax.nn.softmax(s, axis=-1).astype(kv_lat.dtype)
        return jnp.einsum('bhts,bsr->bthr', p, kv_lat)

    if nt > Q_BLOCK and nt % Q_BLOCK == 0:
        blocks = (to_chunks(q_lat, Q_BLOCK), to_chunks(q_rope, Q_BLOCK), q_pos.reshape(nt // Q_BLOCK, Q_BLOCK))
        return from_chunks(lax.map(attend, blocks))
    return attend((q_lat, q_rope, q_pos))


def mixer_layer(x, pos, past_lat, past_rope, ssd_conv_prev, ssd_prev, gdn_conv_prev, gdn_prev,
                w_in, ssd_conv_w, ssd_conv_b, ssd_dt_bias, ssd_a_log, ssd_d, ssd_norm_w,
                mla_q_norm_w, mla_w_uq, mla_kv_norm_w, mla_w_uk, mla_w_uv,
                gdn_conv_w, gdn_dt_bias, gdn_a_log, gdn_norm_w, w_out, ln_g, ln_b):
    nb, nt, _ = x.shape
    f32 = jnp.float32
    proj = x @ w_in
    (ssd_z, ssd_xbc, ssd_dt, mla_cq, mla_ckv, mla_kr, mla_gate,
     gdn_qkv, gdn_z, gdn_b, gdn_a) = jnp.split(proj, IN_OFFSETS, axis=-1)

    xbc, ssd_conv_new = causal_conv(ssd_xbc, ssd_conv_prev, ssd_conv_w)
    xbc = jax.nn.silu(xbc + ssd_conv_b)
    xs, bs, cs = jnp.split(xbc, (SSD_WIDTH, SSD_WIDTH + SSD_GROUPS * SSD_STATE), axis=-1)
    xh = xs.reshape(nb, nt, SSD_HEADS, SSD_HEAD_DIM).astype(f32)
    rep = SSD_HEADS // SSD_GROUPS
    bh = jnp.repeat(bs.reshape(nb, nt, SSD_GROUPS, SSD_STATE).astype(f32), rep, axis=2)
    ch = jnp.repeat(cs.reshape(nb, nt, SSD_GROUPS, SSD_STATE).astype(f32), rep, axis=2)
    dt = jax.nn.softplus(ssd_dt.astype(f32) + ssd_dt_bias)
    a = -jnp.exp(ssd_a_log.astype(f32))
    y, ssd_new = ssd_scan(xh, dt, a, bh, ch, ssd_prev.astype(f32))
    y = y + ssd_d.astype(f32)[:, None] * xh
    y = (y.reshape(nb, nt, SSD_WIDTH) * jax.nn.silu(ssd_z.astype(f32))).reshape(nb, nt, SSD_GROUPS, -1)
    y_ssd = rms_norm(y, ssd_norm_w.reshape(SSD_GROUPS, -1)).reshape(nb, nt, SSD_WIDTH).astype(x.dtype)

    cq = rms_norm(mla_cq, mla_q_norm_w)
    q = (cq @ mla_w_uq).reshape(nb, nt, MLA_HEADS, MLA_NOPE + MLA_ROPE)
    q_nope, q_rope = q[..., :MLA_NOPE], rope(q[..., MLA_NOPE:], pos)
    ckv = rms_norm(mla_ckv, mla_kv_norm_w)
    kr = rope(mla_kr[:, :, None, :], pos)[:, :, 0]
    q_lat = jnp.einsum('bthd,rhd->bthr', q_nope, mla_w_uk)
    keys_lat = jnp.concatenate([past_lat.astype(x.dtype), ckv], axis=1)
    keys_rope = jnp.concatenate([past_rope.astype(x.dtype), kr], axis=1)
    o_lat = mla_attention(q_lat, q_rope, keys_lat, keys_rope, pos)
    o = jnp.einsum('bthr,rhd->bthd', o_lat, mla_w_uv).reshape(nb, nt, MLA_WIDTH)
    y_mla = o * jax.nn.silu(mla_gate)

    qkv, gdn_conv_new = causal_conv(gdn_qkv, gdn_conv_prev, gdn_conv_w)
    qkv = jax.nn.silu(qkv).astype(f32).reshape(nb, nt, 3, GDN_HEADS, GDN_HEAD_DIM)
    gq = l2_normalize(qkv[:, :, 0]) * GDN_HEAD_DIM ** -0.5
    gk = l2_normalize(qkv[:, :, 1])
    gv = qkv[:, :, 2]
    beta = jax.nn.sigmoid(gdn_b.astype(f32))
    g = -jnp.exp(gdn_a_log.astype(f32)) * jax.nn.softplus(gdn_a.astype(f32) + gdn_dt_bias)
    go, gdn_new = gdn_scan(gq, gk, gv, g, beta, gdn_prev.astype(f32))
    go = rms_norm(go, gdn_norm_w) * jax.nn.silu(gdn_z.astype(f32).reshape(nb, nt, GDN_HEADS, GDN_HEAD_DIM))
    y_gdn = go.reshape(nb, nt, GDN_WIDTH).astype(x.dtype)

    mix = jnp.concatenate([y_ssd, y_mla, y_gdn], axis=-1)
    x_new = layer_norm(DEEPNORM_ALPHA * x + mix @ w_out, ln_g, ln_b)
    return x_new, (ckv, kr, ssd_conv_new, ssd_new.astype(x.dtype), gdn_conv_new, gdn_new.astype(x.dtype))


def trunk(x, pos, past_lat, past_rope, ssd_conv, ssd_state, gdn_conv, gdn_state,
          emb_ln_g, emb_ln_b, layer_weights):
    h = layer_norm(x, emb_ln_g, emb_ln_b)
    new = []
    for l in range(DEPTH):
        h, st = mixer_layer(h, pos, past_lat[l], past_rope[l], ssd_conv[l], ssd_state[l],
                            gdn_conv[l], gdn_state[l], *[w[l] for w in layer_weights])
        new.append(st)
    return h, tuple(jnp.stack(s) for s in zip(*new))


def setup_inputs(seed: int = 0) -> dict:
    key = jax.random.key(seed)
    ks = list(jax.random.split(key, 32))
    f32 = jnp.float32

    def nrm(i, shape, scale):
        return jax.random.normal(ks[i], shape, f32) * scale

    def gain(i, n):
        return 1.0 + nrm(i, (DEPTH, n), 0.02)

    def dt_bias(i, n):
        dt = jnp.exp(jax.random.uniform(ks[i], (DEPTH, n), f32, math.log(1e-3), math.log(1e-1)))
        return dt + jnp.log(-jnp.expm1(-dt))

    def a_log(i, n):
        return jnp.log(jax.random.uniform(ks[i], (DEPTH, n), f32, 1.0, 16.0))

    n_pages = PAST_LEN // PAGE_SIZE
    n_used = DEC_BATCH * n_pages
    n_phys = n_used + max(1, n_used // 4)
    page_table = jax.random.permutation(ks[0], n_phys)[:n_used].reshape(DEC_BATCH, n_pages).astype(jnp.int32)
    return {
        'x_prompt': nrm(1, (BATCH, SEQ, D_MODEL), 1.0),
        'x_sample': nrm(2, (DEC_BATCH, DEC_SEQ, D_MODEL), 1.0),
        'cache_kv_latent': nrm(3, (DEPTH, n_phys, PAGE_SIZE, MLA_KV_RANK), 1.0),
        'cache_k_rope': nrm(4, (DEPTH, n_phys, PAGE_SIZE, MLA_ROPE), 1.0),
        'state_ssd_conv': nrm(5, (DEPTH, DEC_BATCH, CONV_WIDTH - 1, SSD_CONV_DIM), 1.0),
        'state_ssd': nrm(6, (DEPTH, DEC_BATCH, SSD_HEADS, SSD_HEAD_DIM, SSD_STATE), 0.1),
        'state_gdn_conv': nrm(7, (DEPTH, DEC_BATCH, CONV_WIDTH - 1, GDN_CONV_DIM), 1.0),
        'state_gdn': nrm(8, (DEPTH, DEC_BATCH, GDN_HEADS, GDN_HEAD_DIM, GDN_HEAD_DIM), 0.1),
        'page_table': page_table,
        'emb_ln_g': 1.0 + nrm(9, (D_MODEL,), 0.02),
        'emb_ln_b': nrm(10, (D_MODEL,), 0.02),
        'w_in': nrm(11, (DEPTH, D_MODEL, IN_WIDTH), D_MODEL ** -0.5),
        'ssd_conv_w': nrm(12, (DEPTH, CONV_WIDTH, SSD_CONV_DIM), CONV_WIDTH ** -0.5),
        'ssd_conv_b': nrm(13, (DEPTH, SSD_CONV_DIM), 0.02),
        'ssd_dt_bias': dt_bias(14, SSD_HEADS),
        'ssd_a_log': a_log(15, SSD_HEADS),
        'ssd_d': gain(16, SSD_HEADS),
        'ssd_norm_w': gain(17, SSD_WIDTH),
        'mla_q_norm_w': gain(18, MLA_Q_RANK),
        'mla_w_uq': nrm(19, (DEPTH, MLA_Q_RANK, MLA_HEADS * (MLA_NOPE + MLA_ROPE)), MLA_Q_RANK ** -0.5),
        'mla_kv_norm_w': gain(20, MLA_KV_RANK),
        'mla_w_uk': nrm(21, (DEPTH, MLA_KV_RANK, MLA_HEADS, MLA_NOPE), MLA_KV_RANK ** -0.5),
        'mla_w_uv': nrm(22, (DEPTH, MLA_KV_RANK, MLA_HEADS, MLA_V), MLA_KV_RANK ** -0.5),
        'gdn_conv_w': nrm(23, (DEPTH, CONV_WIDTH, GDN_CONV_DIM), CONV_WIDTH ** -0.5),
        'gdn_dt_bias': dt_bias(24, GDN_HEADS),
        'gdn_a_log': a_log(25, GDN_HEADS),
        'gdn_norm_w': gain(26, GDN_HEAD_DIM),
        'w_out': nrm(27, (DEPTH, MIX_WIDTH, D_MODEL), DEEPNORM_BETA * MIX_WIDTH ** -0.5),
        'ln_g': gain(28, D_MODEL),
        'ln_b': nrm(29, (DEPTH, D_MODEL), 0.02),
    }


def reference(x_prompt, x_sample, cache_kv_latent, cache_k_rope, state_ssd_conv, state_ssd,
              state_gdn_conv, state_gdn, page_table, emb_ln_g, emb_ln_b, w_in, ssd_conv_w, ssd_conv_b,
              ssd_dt_bias, ssd_a_log, ssd_d, ssd_norm_w, mla_q_norm_w, mla_w_uq, mla_kv_norm_w,
              mla_w_uk, mla_w_uv, gdn_conv_w, gdn_dt_bias, gdn_a_log, gdn_norm_w, w_out, ln_g, ln_b):
    layer_weights = (w_in, ssd_conv_w, ssd_conv_b, ssd_dt_bias, ssd_a_log, ssd_d, ssd_norm_w,
                     mla_q_norm_w, mla_w_uq, mla_kv_norm_w, mla_w_uk, mla_w_uv,
                     gdn_conv_w, gdn_dt_bias, gdn_a_log, gdn_norm_w, w_out, ln_g, ln_b)
    dtype = x_prompt.dtype

    bp, tp, _ = x_prompt.shape
    pos_p = jnp.arange(tp)
    y_prompt, (p_lat, p_rope, p_ssd_conv, p_ssd, p_gdn_conv, p_gdn) = trunk(
        x_prompt, pos_p,
        jnp.zeros((DEPTH, bp, 0, MLA_KV_RANK), dtype), jnp.zeros((DEPTH, bp, 0, MLA_ROPE), dtype),
        jnp.zeros((DEPTH, bp, CONV_WIDTH - 1, SSD_CONV_DIM), dtype),
        jnp.zeros((DEPTH, bp, SSD_HEADS, SSD_HEAD_DIM, SSD_STATE), dtype),
        jnp.zeros((DEPTH, bp, CONV_WIDTH - 1, GDN_CONV_DIM), dtype),
        jnp.zeros((DEPTH, bp, GDN_HEADS, GDN_HEAD_DIM, GDN_HEAD_DIM), dtype),
        emb_ln_g, emb_ln_b, layer_weights)

    bs, ts, _ = x_sample.shape
    past_len = page_table.shape[1] * PAGE_SIZE
    pos_s = past_len + jnp.arange(ts)
    past_lat = [cache_kv_latent[l][page_table].reshape(bs, past_len, MLA_KV_RANK) for l in range(DEPTH)]
    past_rope = [cache_k_rope[l][page_table].reshape(bs, past_len, MLA_ROPE) for l in range(DEPTH)]
    y_sample, (s_lat, s_rope, s_ssd_conv, s_ssd, s_gdn_conv, s_gdn) = trunk(
        x_sample, pos_s, past_lat, past_rope, state_ssd_conv, state_ssd, state_gdn_conv, state_gdn,
        emb_ln_g, emb_ln_b, layer_weights)

    return (y_prompt, y_sample, p_lat, p_rope, p_ssd_conv, p_ssd, p_gdn_conv, p_gdn,
            s_lat, s_rope, s_ssd_conv, s_ssd, s_gdn_conv, s_gdn)
```

```cpp
#include <hip/hip_runtime.h>
#include <cstdio>
#include <cstdint>

#define LAS __attribute__((address_space(3)))
#define GAS __attribute__((address_space(1)))
typedef unsigned short bf16;
typedef short bf16x8 __attribute__((ext_vector_type(8)));
typedef short bf16x4 __attribute__((ext_vector_type(4)));
typedef float f32x4 __attribute__((ext_vector_type(4)));
typedef float f32x2 __attribute__((ext_vector_type(2)));
typedef float f32x16 __attribute__((ext_vector_type(16)));
typedef unsigned u32x4 __attribute__((ext_vector_type(4)));
typedef unsigned u32x2 __attribute__((ext_vector_type(2)));

namespace pg8 {
#define PG8_LAS __attribute__((address_space(3)))
typedef unsigned short bf16_t;
constexpr int BM = 256, BK = 64, HALF = 128, HTB = HALF * BK * 2, STAGE_BYTES = 8 * HTB, NXCD = 8, WGM = 8;
__host__ __device__ __forceinline__ int lds_byte(int r, int c) { const int st = (r >> 4) * 2 + (c >> 5), rr = r & 15, cc = c & 31, ob = rr * 64 + cc * 2; return st * 1024 + (ob ^ (((ob >> 9) & 1) << 5)); }
__host__ __device__ __forceinline__ void stage_rc(int b, int& R, int& C) { const int st = b / 1024, sb = b % 1024, swz = sb ^ (((sb >> 9) & 1) << 5); R = (st >> 1) * 16 + swz / 64; C = (st & 1) * 32 + (swz % 64) / 2; }
__host__ __device__ __forceinline__ int perm32(int rho) { const int n = rho >> 4, i = rho & 15; return 8 * (i >> 2) + 4 * n + (i & 3); }
struct Unit { int pm, pn; };
struct Gemm { const bf16_t* A; const bf16_t* Bt; int M, N, K, lda, ldb; };
struct StaticOrder {
    int nM, nN, nwg, G, c;
    __host__ __device__ void init(int M, int N, int G_, int c_) { nM = M / BM; nN = N / BM; nwg = nM * nN; G = G_; c = c_; }
    __host__ __device__ bool next(int i, Unit& u) const {
        const long L = (long)i * G + c; if (L >= nwg) return false;
        int wgid = (int)L; { const int q = nwg / NXCD, r = nwg % NXCD, xcd = wgid % NXCD, off = wgid / NXCD; wgid = (xcd < r ? xcd * (q + 1) : r * (q + 1) + (xcd - r) * q) + off; }
        const int nig = WGM * nN, gid = wgid / nig, fm = gid * WGM, gsz = (nM - fm) < WGM ? (nM - fm) : WGM;
        u.pm = fm + ((wgid % nig) % gsz); u.pn = (wgid % nig) / gsz; return true;
    }
    __device__ __forceinline__ void a_ready(const Unit&) const {}
    __device__ __forceinline__ void done(const Unit&) const {}
};
__device__ __forceinline__ unsigned cvt_pk_bf16(float lo, float hi) { unsigned r; asm volatile("v_cvt_pk_bf16_f32 %0, %1, %2" : "=v"(r) : "v"(lo), "v"(hi)); return r; }
struct EpiBf16 {
    static constexpr bool PERM = true, AFTER_DRAIN = false;
    bf16_t* O; int ldc; int remap;
    __device__ __forceinline__ void operator()(const f32x4 (&acc)[2][2][4][2], const Unit& u, int wr, int wc, int fr, int fq) const {
        const int row0 = u.pm * BM + wr * 64 + fr, colb = u.pn * BM + wc * 32 + 8 * fq;
#pragma unroll
        for (int ai = 0; ai < 2; ++ai)
#pragma unroll
            for (int m = 0; m < 4; ++m) { bf16_t* rowp = O + (size_t)(row0 + ai * HALF + m * 16) * ldc;
#pragma unroll
                for (int bj = 0; bj < 2; ++bj) { int c = colb + bj * HALF; if (remap) c = (c >> 6) * 96 + (c & 63);
                    const f32x4 v0 = acc[ai][bj][m][0], v1 = acc[ai][bj][m][1];
                    u32x4 w; w.x = cvt_pk_bf16(v0[0], v0[1]); w.y = cvt_pk_bf16(v0[2], v0[3]); w.z = cvt_pk_bf16(v1[0], v1[1]); w.w = cvt_pk_bf16(v1[2], v1[3]);
                    *(u32x4*)(rowp + c) = w; } }
    }
};
struct EpiF32Res {
    static constexpr bool PERM = false, AFTER_DRAIN = false;
    float* Y; const float* X; int ldc; float alpha;
    __device__ __forceinline__ void operator()(const f32x4 (&acc)[2][2][4][2], const Unit& u, int wr, int wc, int fr, int fq) const {
        const int row0 = u.pm * BM + wr * 64 + fr, col0 = u.pn * BM + wc * 32 + 4 * fq;
#pragma unroll
        for (int ai = 0; ai < 2; ++ai)
#pragma unroll
            for (int m = 0; m < 4; ++m) { const size_t ro = (size_t)(row0 + ai * HALF + m * 16) * ldc + col0;
#pragma unroll
                for (int bj = 0; bj < 2; ++bj)
#pragma unroll
                    for (int n = 0; n < 2; ++n) { const f32x4 x = *(const f32x4*)(X + ro + bj * HALF + n * 16); *(f32x4*)(Y + ro + bj * HALF + n * 16) = acc[ai][bj][m][n] + x * alpha; } }
    }
};
template <class Epi, class Sched, bool ALIGN_EPI = false, bool SP2 = false>
__device__ __forceinline__ void gemm_phase(PG8_LAS unsigned char* lds, const Gemm g, const Sched& S, const Epi& E) {
    int tid_ = threadIdx.x; asm volatile("" : "+v"(tid_));
    const int tid = tid_, wid = __builtin_amdgcn_readfirstlane(tid >> 6), lane = tid & 63, wr = wid >> 2, wc = wid & 3, fr = lane & 15, fq = lane >> 4;
    const int K = g.K, nt = K / BK;
    unsigned voffA[2], voffB[2];
#pragma unroll
    for (int i = 0; i < 2; ++i) { int R, C; stage_rc(tid * 16 + i * 8192, R, C); const int Rb = Epi::PERM ? ((R & ~31) + perm32(R & 31)) : R;
        voffA[i] = (unsigned)(R * g.lda + C) * 2u; voffB[i] = (unsigned)(Rb * g.ldb + C) * 2u; }
    const size_t kstep = (size_t)(BK * 2);
    const size_t hstepA = (size_t)HALF * g.lda * 2, hstepB = (size_t)HALF * g.ldb * 2;
    const size_t tstepA = 2 * hstepA, tstepB = 2 * hstepB;
    const unsigned ldsw = (unsigned)wid * 1024u;
    const int aoff = lds_byte(wr * 64 + fr, fq * 8), boff = lds_byte(wc * 32 + fr, fq * 8);
#define PG8_SA(b, h) (((b) * 2 + (h)) * HTB)
#define PG8_SB(b, h) ((4 + (b) * 2 + (h)) * HTB)
#define PG8_STAGE(bufoff, gbase, voff) do { _Pragma("unroll") for (int _i = 0; _i < 2; ++_i) \
        __builtin_amdgcn_global_load_lds((const unsigned*)((const char*)(gbase) + (voff)[_i]), (PG8_LAS unsigned*)(lds + (bufoff) + ldsw + _i * 8192), 16, 0, 0); } while (0)
#define PG8_LDA(dst, b, h) do { _Pragma("unroll") for (int m = 0; m < 4; ++m) _Pragma("unroll") for (int k = 0; k < 2; ++k) dst[m][k] = *(const PG8_LAS bf16x8*)(lds + PG8_SA(b, h) + aoff + m * 2048 + k * 1024); } while (0)
#define PG8_LDB(dst, b, h) do { _Pragma("unroll") for (int n = 0; n < 2; ++n) _Pragma("unroll") for (int k = 0; k < 2; ++k) dst[n][k] = *(const PG8_LAS bf16x8*)(lds + PG8_SB(b, h) + boff + n * 2048 + k * 1024); } while (0)
#define PG8_MMA(ai, bj, At, Bt) do { __builtin_amdgcn_s_setprio(1); _Pragma("unroll") for (int m = 0; m < 4; ++m) _Pragma("unroll") for (int n = 0; n < 2; ++n) _Pragma("unroll") for (int k = 0; k < 2; ++k) \
        acc[ai][bj][m][n] = __builtin_amdgcn_mfma_f32_16x16x32_bf16(Bt[n][k], At[m][k], acc[ai][bj][m][n], 0, 0, 0); __builtin_amdgcn_s_setprio(0); } while (0)
#define PG8_WAIT_V(n) asm volatile("s_waitcnt vmcnt(" #n ")" ::: "memory")
#define PG8_WAIT_L(n) asm volatile("s_waitcnt lgkmcnt(" #n ")" ::: "memory")
#define PG8_BAR __builtin_amdgcn_s_barrier()
#define PG8_SCHED __builtin_amdgcn_sched_barrier(0)
    Unit cur, nxt; int ui = 0;
    if (!S.next(0, cur)) return;
    f32x4 acc[2][2][4][2];
#pragma unroll
    for (int a = 0; a < 2; ++a)
#pragma unroll
        for (int b = 0; b < 2; ++b)
#pragma unroll
            for (int m = 0; m < 4; ++m)
#pragma unroll
                for (int n = 0; n < 2; ++n) acc[a][b][m][n] = (f32x4){0.f, 0.f, 0.f, 0.f};
    bf16x8 At[4][2], B0[2][2], B1[2][2];
    const char* cA = (const char*)g.A + (size_t)cur.pm * tstepA; const char* cB = (const char*)g.Bt + (size_t)cur.pn * tstepB;
    S.a_ready(cur);
    if constexpr (SP2) {
        PG8_STAGE(PG8_SB(0, 0), cB, voffB); PG8_STAGE(PG8_SB(0, 1), cB + hstepB, voffB); PG8_STAGE(PG8_SA(0, 0), cA, voffA); PG8_STAGE(PG8_SA(0, 1), cA + hstepA, voffA);
        if (wr == 1) PG8_BAR;
        PG8_WAIT_V(2); PG8_BAR;
        PG8_STAGE(PG8_SB(1, 0), cB + kstep, voffB); PG8_STAGE(PG8_SA(1, 0), cA + kstep, voffA); PG8_STAGE(PG8_SB(1, 1), cB + hstepB + kstep, voffB);
        PG8_WAIT_V(6); PG8_BAR;
    } else {
        PG8_STAGE(PG8_SB(0, 0), cB, voffB); PG8_STAGE(PG8_SA(0, 0), cA, voffA); PG8_STAGE(PG8_SB(0, 1), cB + hstepB, voffB); PG8_STAGE(PG8_SA(0, 1), cA + hstepA, voffA);
        if (wr == 1) PG8_BAR;
        PG8_WAIT_V(4); PG8_BAR;
        PG8_STAGE(PG8_SB(1, 0), cB + kstep, voffB); PG8_STAGE(PG8_SA(1, 0), cA + kstep, voffA); PG8_STAGE(PG8_SB(1, 1), cB + hstepB + kstep, voffB);
        PG8_WAIT_V(6); PG8_BAR;
    }
    for (;;) {
        const bool has_next = S.next(ui + 1, nxt);
        const char* nA = has_next ? (const char*)g.A + (size_t)nxt.pm * tstepA : cA; const char* nB = has_next ? (const char*)g.Bt + (size_t)nxt.pn * tstepB : cB;
        for (int t = 0; t < nt; t += 2) {
            const bool last = (t == nt - 2);
            const char* a1 = cA + (size_t)(t + 1) * kstep;
            const char* a2 = last ? nA : cA + (size_t)(t + 2) * kstep; const char* b2 = last ? nB : cB + (size_t)(t + 2) * kstep;
            const char* a3 = a2 + kstep; const char* b3 = b2 + kstep;
            if (last && has_next) S.a_ready(nxt);
            if constexpr (SP2) {
            PG8_LDB(B0, 0, 0); PG8_LDB(B1, 0, 1); PG8_SCHED; PG8_LDA(At, 0, 0); PG8_STAGE(PG8_SA(1, 1), a1 + hstepA, voffA);
            PG8_WAIT_V(8); PG8_WAIT_L(0); PG8_BAR; PG8_MMA(0, 0, At, B0); PG8_MMA(0, 1, At, B1); PG8_BAR; PG8_SCHED;
            PG8_LDA(At, 0, 1); PG8_STAGE(PG8_SB(0, 0), b2, voffB); PG8_STAGE(PG8_SB(0, 1), b2 + hstepB, voffB); PG8_STAGE(PG8_SA(0, 0), a2, voffA);
            PG8_WAIT_V(8); PG8_WAIT_L(0); PG8_BAR; PG8_MMA(1, 0, At, B0); PG8_MMA(1, 1, At, B1); PG8_BAR; PG8_SCHED;
            PG8_LDB(B0, 1, 0); PG8_LDB(B1, 1, 1); PG8_SCHED; PG8_LDA(At, 1, 0); PG8_STAGE(PG8_SA(0, 1), a2 + hstepA, voffA);
            PG8_WAIT_V(8); PG8_WAIT_L(0); PG8_BAR; PG8_MMA(0, 0, At, B0); PG8_MMA(0, 1, At, B1); PG8_BAR; PG8_SCHED;
            PG8_LDA(At, 1, 1); PG8_STAGE(PG8_SB(1, 0), b3, voffB); PG8_STAGE(PG8_SB(1, 1), b3 + hstepB, voffB); PG8_STAGE(PG8_SA(1, 0), a3, voffA);
            PG8_WAIT_V(8); PG8_WAIT_L(0); PG8_BAR; PG8_MMA(1, 0, At, B0); PG8_MMA(1, 1, At, B1); PG8_BAR; PG8_SCHED;
            } else {
            PG8_LDB(B0, 0, 0); PG8_SCHED; PG8_LDA(At, 0, 0); PG8_STAGE(PG8_SA(1, 1), a1 + hstepA, voffA);
            PG8_WAIT_L(8); PG8_BAR; PG8_WAIT_L(0); PG8_MMA(0, 0, At, B0); PG8_BAR; PG8_SCHED;
            PG8_LDB(B1, 0, 1); PG8_STAGE(PG8_SB(0, 0), b2, voffB);
            PG8_BAR; PG8_WAIT_L(0); PG8_MMA(0, 1, At, B1); PG8_BAR;
            PG8_LDA(At, 0, 1); PG8_STAGE(PG8_SA(0, 0), a2, voffA);
            PG8_BAR; PG8_WAIT_L(0); PG8_MMA(1, 0, At, B0); PG8_BAR; PG8_SCHED;
            PG8_STAGE(PG8_SB(0, 1), b2 + hstepB, voffB);
            PG8_WAIT_V(6); PG8_BAR; PG8_MMA(1, 1, At, B1); PG8_BAR;
            PG8_LDB(B0, 1, 0); PG8_SCHED; PG8_LDA(At, 1, 0); PG8_STAGE(PG8_SA(0, 1), a2 + hstepA, voffA);
            PG8_WAIT_L(8); PG8_BAR; PG8_WAIT_L(0); PG8_MMA(0, 0, At, B0); PG8_BAR; PG8_SCHED;
            PG8_LDB(B1, 1, 1); PG8_STAGE(PG8_SB(1, 0), b3, voffB);
            PG8_BAR; PG8_WAIT_L(0); PG8_MMA(0, 1, At, B1); PG8_BAR;
            PG8_LDA(At, 1, 1); PG8_STAGE(PG8_SA(1, 0), a3, voffA);
            PG8_BAR; PG8_WAIT_L(0); PG8_MMA(1, 0, At, B0); PG8_BAR; PG8_SCHED;
            PG8_STAGE(PG8_SB(1, 1), b3 + hstepB, voffB);
            PG8_WAIT_V(6); PG8_BAR; PG8_MMA(1, 1, At, B1); PG8_BAR;
            }
        }
        if constexpr (ALIGN_EPI) { if (wr == 0) PG8_BAR; }
        if constexpr (!Epi::AFTER_DRAIN) { E(acc, cur, wr, wc, fr, fq); S.done(cur); }
        if (!has_next) break;
#pragma unroll
        for (int a = 0; a < 2; ++a)
#pragma unroll
            for (int b = 0; b < 2; ++b)
#pragma unroll
                for (int m = 0; m < 4; ++m)
#pragma unroll
                    for (int n = 0; n < 2; ++n) acc[a][b][m][n] = (f32x4){0.f, 0.f, 0.f, 0.f};
        cur = nxt; cA = nA; cB = nB; ++ui;
        if constexpr (ALIGN_EPI) { if (wr == 1) PG8_BAR; }
    }
    PG8_WAIT_V(0);
    if constexpr (!ALIGN_EPI) { if (wr == 0) PG8_BAR; }
    PG8_BAR;
    if constexpr (Epi::AFTER_DRAIN) { E.fused(acc, cur, wr, wc, fr, fq, lds, wid, lane); S.done(cur); }
#undef PG8_SA
#undef PG8_SB
#undef PG8_STAGE
#undef PG8_LDA
#undef PG8_LDB
#undef PG8_MMA
#undef PG8_WAIT_V
#undef PG8_WAIT_L
#undef PG8_BAR
#undef PG8_SCHED
}
}

constexpr int DM = 1024, NPB = 8, SEQ = 2048, NP = NPB * SEQ, NSB = 32, DSQ = 4, NS = NSB * DSQ, MT = NP + NS, MP = 16640;
constexpr int PASTL = 16384, PAGE = 128, NPAGES = 128, NPHYS = 5120;
constexpr int INW = 5816, INWP = 5888, MIXW = 2048;
constexpr int O_SSDZ = 0, O_XBC = 1024, O_DT = 2560, O_CQ = 2576, O_CKV = 2960, O_KR = 3216, O_GATE = 3248, O_GQKV = 3760, O_GZ = 5296, O_GB = 5808, O_GA = 5812;
constexpr float LN_EPS = 1e-5f, RMS_EPS = 1e-6f, L2_EPS = 1e-6f, ALPHA = 1.41421356237309515f;
constexpr float LOG2E = 1.4426950408889634f;
constexpr float ATT_SC = 0.10206207261596575f * LOG2E;
constexpr size_t OUT_YP = 0, OUT_YS = OUT_YP + 16777216, OUT_PLAT = OUT_YS + 131072, OUT_PROPE = OUT_PLAT + 8388608, OUT_PSC = OUT_PROPE + 1048576, OUT_PSSD = OUT_PSC + 73728,
                 OUT_PGC = OUT_PSSD + 2097152, OUT_PGDN = OUT_PGC + 73728, OUT_SLAT = OUT_PGDN + 1048576, OUT_SROPE = OUT_SLAT + 65536, OUT_SSC = OUT_SROPE + 8192,
                 OUT_SSSD = OUT_SSC + 294912, OUT_SGC = OUT_SSSD + 8388608, OUT_SGDN = OUT_SGC + 294912, OUT_END = OUT_SGDN + 4194304;
enum { I_XP = 0, I_XS, I_CLAT, I_CROPE, I_SSC, I_SSD, I_SGC, I_SGDN, I_PT, I_EG, I_EB, I_WIN, I_SCW, I_SCB, I_SDTB, I_SALOG, I_SD, I_SNW, I_QNW, I_WUQ, I_KVNW, I_WUK, I_WUV,
       I_GCW, I_GDTB, I_GALOG, I_GNW, I_WOUT, I_LNG, I_LNB, N_IN };
constexpr size_t MiB = 1u << 20;
constexpr size_t WS_CTL = 0, CTL_ZERO_BYTES = 1 * MiB;
constexpr size_t WS_WIN = 2 * MiB, WS_WOUT = 26 * MiB, WS_WUQ = 34 * MiB, WS_WUK = 36 * MiB, WS_WUV = 37 * MiB, WS_WABS = 38 * MiB, WS_ROPECS = 42 * MiB;
constexpr size_t WS_XF = 46 * MiB, WS_XN = 112 * MiB, WS_PROJ = 146 * MiB, WS_CQN = 334 * MiB, WS_CKVN = 347 * MiB, WS_KROPE = 356 * MiB, WS_Q = 358 * MiB, WS_KK = 383 * MiB;
constexpr size_t WS_VT = 407 * MiB, WS_QLAT = 423 * MiB, WS_CC = 424 * MiB, WS_ACUM = 432 * MiB, WS_YI = 433 * MiB, WS_HLOC = 497 * MiB, WS_YG = 561 * MiB, WS_SSQ = 593 * MiB;
constexpr size_t WS_GNW = 594 * MiB, WS_GQG = 610 * MiB, WS_GKDT = 626 * MiB, WS_GU = 642 * MiB, WS_GATT = 674 * MiB, WS_GEG = 682 * MiB, WS_PARTO = 683 * MiB, WS_PARTML = 699 * MiB;
constexpr size_t WS_MIX = 700 * MiB, WS_Y = 766 * MiB, WS_END = 832 * MiB;
static_assert(WS_WIN + (size_t)2 * INWP * DM * 2 <= WS_WOUT && WS_XF + (size_t)MT * DM * 4 <= WS_XN && WS_XN + (size_t)MP * DM * 2 <= WS_PROJ && WS_PROJ + (size_t)MP * INWP * 2 <= WS_CQN, "ws map");
static_assert(WS_CQN + (size_t)MP * 384 * 2 <= WS_CKVN && WS_CKVN + (size_t)MP * 256 * 2 <= WS_KROPE && WS_Q + (size_t)MP * 768 * 2 <= WS_KK && WS_MIX + (size_t)MP * MIXW * 2 <= WS_Y && WS_Y + (size_t)MT * DM * 4 <= WS_END, "ws map");
constexpr int CW_BAR = 4096;
constexpr int CW_Q = 16384;
constexpr int LDS_BYTES = 147456, MISC_OFF = 144 * 1024 - 256;
constexpr int NWAVES = 8, NTHR = 512;

#define LDS_WAIT() asm volatile("s_waitcnt lgkmcnt(0)" ::: "memory")
#define VM_WAIT() asm volatile("s_waitcnt vmcnt(0)" ::: "memory")
__device__ __forceinline__ float bflo(unsigned w) { return __uint_as_float(w << 16); }
__device__ __forceinline__ float bfhi(unsigned w) { return __uint_as_float(w & 0xffff0000u); }
__device__ __forceinline__ float bf2f(bf16 v) { return __uint_as_float((unsigned)v << 16); }
__device__ __forceinline__ unsigned pk2(float lo, float hi) { unsigned r; asm volatile("v_cvt_pk_bf16_f32 %0, %1, %2" : "=v"(r) : "v"(lo), "v"(hi)); return r; }
__device__ __forceinline__ bf16 f2bf(float f) { return (bf16)(pk2(f, 0.f) & 0xffffu); }
__device__ __forceinline__ float silu_f(float x) { return x / (1.f + __expf(-x)); }
__device__ __forceinline__ float sigmoid_f(float x) { return 1.f / (1.f + __expf(-x)); }
__device__ __forceinline__ float softplus_f(float x) { return x > 20.f ? x : log1pf(__expf(x)); }
__device__ __forceinline__ float wave_sum(float v) {
#pragma unroll
    for (int o = 1; o < 64; o <<= 1) v += __shfl_xor(v, o);
    return v;
}
__device__ __forceinline__ float wave_scan_incl(float v, int lane) {
#pragma unroll
    for (int o = 1; o < 64; o <<= 1) { const float t = __shfl_up(v, o); if (lane >= o) v += t; }
    return v;
}
__device__ __forceinline__ f32x4 mfma16(bf16x8 a, bf16x8 b, f32x4 c) { return __builtin_amdgcn_mfma_f32_16x16x32_bf16(a, b, c, 0, 0, 0); }
__device__ __forceinline__ f32x16 mfma32(bf16x8 a, bf16x8 b, f32x16 c) { return __builtin_amdgcn_mfma_f32_32x32x16_bf16(a, b, c, 0, 0, 0); }
__device__ __forceinline__ bf16x8 frag16(const bf16* base, int pitch, int row0, int k0, int lane) { return *(const bf16x8*)(base + (row0 + (lane & 15)) * pitch + k0 + 8 * (lane >> 4)); }
__device__ __forceinline__ bf16x8 frag16p(const bf16* base, int pitch, int row0, int k0, int lane) {
    const bf16* p = base + (row0 + (lane & 15)) * pitch + k0 + 4 * (lane >> 4);
    const bf16x4 lo = *(const bf16x4*)p, hi = *(const bf16x4*)(p + 16);
    return (bf16x8){lo[0], lo[1], lo[2], lo[3], hi[0], hi[1], hi[2], hi[3]};
}
__device__ __forceinline__ bf16x8 accpair(f32x4 a, f32x4 b) { u32x4 w; w.x = pk2(a[0], a[1]); w.y = pk2(a[2], a[3]); w.z = pk2(b[0], b[1]); w.w = pk2(b[2], b[3]); return __builtin_bit_cast(bf16x8, w); }

#define XB_TMO      128
#define XB_XCNT(j)  (256  + 64 * (j))
#define XB_XSUB(j)  (1280 + 64 * (j))
#define XB_XGEN(j)  (2304 + 64 * (j))
#define XB_TOP      3328
#define XB_TOPGEN   3392
#define XCD_BAR_WORDS 3456
#define XB_SPIN_CAP (1u << 18)

__device__ __forceinline__ unsigned xb_ld(unsigned* p)              { return __hip_atomic_load(p, __ATOMIC_RELAXED, __HIP_MEMORY_SCOPE_AGENT); }
__device__ __forceinline__ unsigned xb_add(unsigned* p, unsigned v) { return __hip_atomic_fetch_add(p, v, __ATOMIC_RELAXED, __HIP_MEMORY_SCOPE_AGENT); }
__device__ __forceinline__ unsigned xb_xcc_id() { return (unsigned)__builtin_amdgcn_s_getreg((3 << 11) | 20) & 0xFu; }
#define XB_SPIN(cond, bar) do { unsigned _sp = 0; while (cond) { __builtin_amdgcn_s_sleep(1); \
    if ((++_sp & 255u) == 0u) { if (xb_ld(&(bar)[XB_TMO])) break; if (_sp > XB_SPIN_CAP) { atomicAdd(&(bar)[XB_TMO], 1u); break; } } } } while (0)

struct XcdBarrier {
    unsigned* bar; unsigned x;
    volatile LAS unsigned* st;
};

__device__ __forceinline__ XcdBarrier xcd_barrier_post(unsigned* bar, volatile LAS unsigned* st) {
    XcdBarrier b; b.bar = bar; b.x = xb_xcc_id(); b.st = st;
    if (threadIdx.x == 0) (void)xb_add(&bar[XB_XCNT(b.x)], 1u);
    return b;
}
__device__ __forceinline__ void xcd_barrier_complete(unsigned* bar, unsigned x, unsigned& nloc, unsigned& nx) {
    const unsigned G = gridDim.x * gridDim.y * gridDim.z;
    unsigned sum, cnt, mine, sp = 0u;
    for (;;) {
        sum = 0u; cnt = 0u; mine = 0u;
#pragma unroll
        for (unsigned j = 0; j < 16; ++j) { const unsigned c = xb_ld(&bar[XB_XCNT(j)]); sum += c; cnt += (c > 0u) ? 1u : 0u; mine = (j == x) ? c : mine; }
        if (sum == G) break;
        __builtin_amdgcn_s_sleep(1);
        if ((++sp & 255u) == 0u) { if (xb_ld(&bar[XB_TMO])) break; if (sp > XB_SPIN_CAP) { atomicAdd(&bar[XB_TMO], 1u); break; } }
    }
    nloc = mine > 0u ? mine : 1u; nx = cnt > 0u ? cnt : 1u;
}

__device__ __forceinline__ void xcd_barrier(const XcdBarrier& b) {
    asm volatile("s_waitcnt vmcnt(0)" ::: "memory");
    __syncthreads();
    if (threadIdx.x == 0) {
        unsigned* bar = b.bar;
        __builtin_amdgcn_s_waitcnt(0);
        unsigned nloc = b.st[0], nx = b.st[1];
        if (nloc == 0u) { xcd_barrier_complete(bar, b.x, nloc, nx); b.st[0] = nloc; b.st[1] = nx; }
        const unsigned old = xb_add(&bar[XB_XSUB(b.x)], 1u);
        const unsigned gen = old / nloc;
        if (old + 1u == (gen + 1u) * nloc) {
            __builtin_amdgcn_fence(__ATOMIC_RELEASE, "agent");
            asm volatile("s_waitcnt vmcnt(0)" ::: "memory");
            const unsigned og = xb_add(&bar[XB_TOP], 1u);
            const unsigned tg = og / nx;
            if (og + 1u == (tg + 1u) * nx) xb_add(&bar[XB_TOPGEN], 1u);
            else XB_SPIN(xb_ld(&bar[XB_TOPGEN]) == tg, bar);
            __builtin_amdgcn_fence(__ATOMIC_ACQUIRE, "agent");
            xb_add(&bar[XB_XGEN(b.x)], 1u);
            asm volatile("s_waitcnt vmcnt(0)" ::: "memory");
        } else {
            XB_SPIN(xb_ld(&bar[XB_XGEN(b.x)]) == gen, bar);
            __builtin_amdgcn_fence(__ATOMIC_ACQUIRE, "agent");
            asm volatile("s_waitcnt vmcnt(0)" ::: "memory");
        }
    }
    __syncthreads();
}

struct KArgs { const float* in[N_IN]; float* out; unsigned char* ws; int ph_lo, ph_hi; };
#define WSP(T, off) ((T*)(ws + (off)))
#define CAS __attribute__((address_space(4)))
#define ENTER() const CAS KArgs* kp_ = (const CAS KArgs*)__builtin_amdgcn_kernarg_segment_ptr(); asm volatile("" : "+s"(kp_)); const CAS KArgs& a = *kp_; unsigned char* ws = a.ws; asm volatile("" : "+v"(tid)); const int lane = tid & 63, wave = __builtin_amdgcn_readfirstlane(tid >> 6); (void)lane; (void)wave

__device__ __forceinline__ int q_next(unsigned* ctr, volatile unsigned* slot, int tid) {
    __syncthreads();
    if (tid == 0) *slot = __hip_atomic_fetch_add(ctr, 1u, __ATOMIC_RELAXED, __HIP_MEMORY_SCOPE_AGENT);
    __syncthreads();
    return (int)*slot;
}

__device__ __forceinline__ void tr_item(const float* W, int K, int N, int Npad, bf16* WT, float* scr, int item, int lane) {
    const int nblk = Npad / 32, kb = item / nblk, nb = item % nblk, k0 = 64 * kb, n0 = 32 * nb;
    const int n = n0 + (lane & 31);
#pragma unroll 8
    for (int i = 0; i < 32; ++i) { const int kk = 2 * i + (lane >> 5); scr[kk * 33 + (lane & 31)] = (n < N) ? W[(size_t)(k0 + kk) * N + n] : 0.f; }
    LDS_WAIT(); asm volatile("" ::: "memory");
    const int c = lane & 7;
#pragma unroll
    for (int j = 0; j < 4; ++j) { const int nn = (lane >> 3) + 8 * j; const float* s = scr + (8 * c) * 33 + nn;
        u32x4 o; o.x = pk2(s[0 * 33], s[1 * 33]); o.y = pk2(s[2 * 33], s[3 * 33]); o.z = pk2(s[4 * 33], s[5 * 33]); o.w = pk2(s[6 * 33], s[7 * 33]);
        *(u32x4*)(WT + (size_t)(n0 + nn) * K + k0 + 8 * c) = o; }
    LDS_WAIT(); asm volatile("" ::: "memory");
}
__device__ __forceinline__ void ln_row(const float* xrow, const float* g, const float* b, float* of32, bf16* obf, int lane) {
    f32x4 v[4]; float s = 0.f;
#pragma unroll
    for (int j = 0; j < 4; ++j) { v[j] = *(const f32x4*)(xrow + 4 * lane + 256 * j); s += (v[j].x + v[j].y) + (v[j].z + v[j].w); }
    const float mean = wave_sum(s) * (1.f / DM); float s2 = 0.f;
#pragma unroll
    for (int j = 0; j < 4; ++j) { v[j] = v[j] - mean; s2 += (v[j].x * v[j].x + v[j].y * v[j].y) + (v[j].z * v[j].z + v[j].w * v[j].w); }
    const float rstd = 1.f / sqrtf(wave_sum(s2) * (1.f / DM) + LN_EPS);
#pragma unroll
    for (int j = 0; j < 4; ++j) { const f32x4 gg = *(const f32x4*)(g + 4 * lane + 256 * j), bb = *(const f32x4*)(b + 4 * lane + 256 * j); const f32x4 o = v[j] * rstd * gg + bb;
        if (of32) *(f32x4*)(of32 + 4 * lane + 256 * j) = o;
        if (obf) { u32x2 w; w.x = pk2(o.x, o.y); w.y = pk2(o.z, o.w); *(u32x2*)(obf + 4 * lane + 256 * j) = w; } }
}
__device__ __forceinline__ void ph_prologue(unsigned char* lds, int tid, int bid, int G) { ENTER();
    float* scr = (float*)(lds + wave * 8448);
    const int gw = bid * NWAVES + wave, NGW = G * NWAVES, gt = bid * NTHR + tid, NGT = G * NTHR;
    constexpr int IT_IN = 16 * 184, IT_OUT = 32 * 32, IT_UQ = 6 * 24, IT_UK = 4 * 16, IT_L = IT_IN + IT_OUT + IT_UQ + 2 * IT_UK;
    for (int it = gw; it < 2 * IT_L; it += NGW) {
        const int l = it / IT_L; int r = it % IT_L;
        if (r < IT_IN) { tr_item(a.in[I_WIN] + (size_t)l * DM * INW, DM, INW, INWP, WSP(bf16, WS_WIN) + (size_t)l * INWP * DM, scr, r, lane); continue; } r -= IT_IN;
        if (r < IT_OUT) { tr_item(a.in[I_WOUT] + (size_t)l * MIXW * DM, MIXW, DM, DM, WSP(bf16, WS_WOUT) + (size_t)l * DM * MIXW, scr, r, lane); continue; } r -= IT_OUT;
        if (r < IT_UQ) { tr_item(a.in[I_WUQ] + (size_t)l * 384 * 768, 384, 768, 768, WSP(bf16, WS_WUQ) + (size_t)l * 768 * 384, scr, r, lane); continue; } r -= IT_UQ;
        if (r < IT_UK) { tr_item(a.in[I_WUK] + (size_t)l * 256 * 512, 256, 512, 512, WSP(bf16, WS_WUK) + (size_t)l * 512 * 256, scr, r, lane); continue; } r -= IT_UK;
        tr_item(a.in[I_WUV] + (size_t)l * 256 * 512, 256, 512, 512, WSP(bf16, WS_WUV) + (size_t)l * 512 * 256, scr, r, lane);
    }
    for (int e = gt; e < 2 * 2048 * 384; e += NGT) {
        const int k = e % 384, n = (e / 384) % 2048, l = e / (384 * 2048), h = n >> 8, r = n & 255;
        const float* pq = a.in[I_WUQ] + ((size_t)l * 384 + k) * 768 + h * 96; const float* pk = a.in[I_WUK] + ((size_t)l * 256 + r) * 512 + h * 64;
        float s = 0.f;
#pragma unroll 4
        for (int d = 0; d < 64; d += 4) { const f32x4 x = *(const f32x4*)(pq + d), y = *(const f32x4*)(pk + d); s += x.x * y.x + x.y * y.y + x.z * y.z + x.w * y.w; }
        WSP(bf16, WS_WABS)[e] = f2bf(s);
    }
    for (int e = gt; e < MT * 16; e += NGT) {
        const int i = e & 15, m = e >> 4; const int pos = (m < NP) ? (m & (SEQ - 1)) : (PASTL + ((m - NP) & 3));
        const float inv = powf(10000.f, -(float)i * (1.f / 16.f)); const float ang = (float)pos * inv;
        float sn, cs; sincosf(ang, &sn, &cs);
        WSP(float, WS_ROPECS)[m * 32 + i] = cs; WSP(float, WS_ROPECS)[m * 32 + 16 + i] = sn;
    }
    for (int m = gw; m < MT; m += NGW) {
        const float* xr = (m < NP) ? a.in[I_XP] + (size_t)m * DM : a.in[I_XS] + (size_t)(m - NP) * DM;
        ln_row(xr, a.in[I_EG], a.in[I_EB], WSP(float, WS_XF) + (size_t)m * DM, WSP(bf16, WS_XN) + (size_t)m * DM, lane);
    }
}

__device__ __forceinline__ void e1_unit(int l, int unit, int tid) { ENTER();
    const bf16* PROJ = WSP(bf16, WS_PROJ); const float* RC = WSP(float, WS_ROPECS);
    for (int i = 0; i < 8; ++i) {
        const int m = unit * 64 + wave * 8 + i;
        const bf16* pr = PROJ + (size_t)m * INWP;
        const bool samp = m >= NP; const int sb = samp ? (m - NP) >> 2 : m >> 11, st = samp ? (m - NP) & 3 : m & (SEQ - 1);
        {
            const unsigned w0 = *(const unsigned*)(pr + O_CQ + 2 * lane), w1 = *(const unsigned*)(pr + O_CQ + 128 + 2 * lane), w2 = *(const unsigned*)(pr + O_CQ + 256 + 2 * lane);
            const float x0 = bflo(w0), x1 = bfhi(w0), x2 = bflo(w1), x3 = bfhi(w1), x4 = bflo(w2), x5 = bfhi(w2);
            const float ss = wave_sum(x0 * x0 + x1 * x1 + x2 * x2 + x3 * x3 + x4 * x4 + x5 * x5);
            const float r = 1.f / sqrtf(ss * (1.f / 384.f) + RMS_EPS);
            const float* nw = a.in[I_QNW] + l * 384 + 2 * lane; bf16* o = WSP(bf16, WS_CQN) + (size_t)m * 384 + 2 * lane;
            *(unsigned*)(o) = pk2(x0 * r * nw[0], x1 * r * nw[1]); *(unsigned*)(o + 128) = pk2(x2 * r * nw[128], x3 * r * nw[129]); *(unsigned*)(o + 256) = pk2(x4 * r * nw[256], x5 * r * nw[257]);
        }
        {
            const u32x2 w = *(const u32x2*)(pr + O_CKV + 4 * lane);
            const float x0 = bflo(w.x), x1 = bfhi(w.x), x2 = bflo(w.y), x3 = bfhi(w.y);
            const float ss = wave_sum(x0 * x0 + x1 * x1 + x2 * x2 + x3 * x3);
            const float r = 1.f / sqrtf(ss * (1.f / 256.f) + RMS_EPS);
            const f32x4 nw = *(const f32x4*)(a.in[I_KVNW] + l * 256 + 4 * lane);
            const f32x4 v = (f32x4){x0 * r * nw.x, x1 * r * nw.y, x2 * r * nw.z, x3 * r * nw.w};
            float* o = samp ? a.out + OUT_SLAT + ((size_t)l * NS + (m - NP)) * 256 : a.out + OUT_PLAT + ((size_t)l * NP + m) * 256;
            *(f32x4*)(o + 4 * lane) = v;
            u32x2 ww; ww.x = pk2(v.x, v.y); ww.y = pk2(v.z, v.w); *(u32x2*)(WSP(bf16, WS_CKVN) + (size_t)m * 256 + 4 * lane) = ww;
        }
        if (lane < 16) {
            const float x1 = bf2f(pr[O_KR + lane]), x2 = bf2f(pr[O_KR + 16 + lane]);
            const float c = RC[m * 32 + lane], s = RC[m * 32 + 16 + lane];
            const float o1 = x1 * c - x2 * s, o2 = x2 * c + x1 * s;
            float* o = samp ? a.out + OUT_SROPE + ((size_t)l * NS + (m - NP)) * 32 : a.out + OUT_PROPE + ((size_t)l * NP + m) * 32;
            o[lane] = o1; o[16 + lane] = o2;
            const bf16 b1 = f2bf(o1), b2 = f2bf(o2);
            bf16* kr = WSP(bf16, WS_KROPE) + (size_t)m * 32; kr[lane] = b1; kr[16 + lane] = b2;
            if (!samp) { bf16* kk = WSP(bf16, WS_KK) + (size_t)m * 768 + 64;
#pragma unroll
                for (int h = 0; h < 8; ++h) { kk[h * 96 + lane] = b1; kk[h * 96 + 16 + lane] = b2; } }
        }
        const int T = samp ? DSQ : SEQ;
        if (st >= T - 3) {
            const int j = st - (T - 3);
            float* o1 = samp ? a.out + OUT_SSC + ((size_t)(l * NSB + sb) * 3 + j) * 1536 : a.out + OUT_PSC + ((size_t)(l * NPB + sb) * 3 + j) * 1536;
            float* o2 = samp ? a.out + OUT_SGC + ((size_t)(l * NSB + sb) * 3 + j) * 1536 : a.out + OUT_PGC + ((size_t)(l * NPB + sb) * 3 + j) * 1536;
            for (int c = 2 * lane; c < 1536; c += 128) {
                const unsigned w1 = *(const unsigned*)(pr + O_XBC + c), w2 = *(const unsigned*)(pr + O_GQKV + c);
                o1[c] = bflo(w1); o1[c + 1] = bfhi(w1); o2[c] = bflo(w2); o2[c + 1] = bfhi(w2); }
        }
    }
}

template <int NR, bool SILU_BIAS>
__device__ __forceinline__ void conv_pair(const bf16* colp  , int r0, bool first, const float* wp  , const float* bp  , f32x2 (&y)[NR]) {
    f32x2 w[4];
#pragma unroll
    for (int j = 0; j < 4; ++j) w[j] = (f32x2){wp[j * 1536], wp[j * 1536 + 1]};
    const f32x2 bias = bp ? (f32x2){bp[0], bp[1]} : (f32x2){0.f, 0.f};
    f32x2 h[3];
#pragma unroll
    for (int j = 0; j < 3; ++j) { const int r = r0 - 3 + j; unsigned v = 0u; if (!(first && r < 0)) v = *(const unsigned*)(colp + (long)r * INWP); h[j] = (f32x2){bflo(v), bfhi(v)}; }
#pragma unroll
    for (int i = 0; i < NR; ++i) {
        const unsigned v = *(const unsigned*)(colp + (long)(r0 + i) * INWP); const f32x2 cur = (f32x2){bflo(v), bfhi(v)};
        f32x2 s = w[0] * h[0] + w[1] * h[1] + w[2] * h[2] + w[3] * cur + bias;
        y[i] = (f32x2){silu_f(s.x), silu_f(s.y)};
        h[0] = h[1]; h[1] = h[2]; h[2] = cur;
    }
}

__device__ __forceinline__ void ssd_s1_unit(int l, int unit, unsigned char* lds, int tid) { ENTER();
    const int g = unit & 1, c = (unit >> 1) & 15, b = unit >> 5, tok0 = b * SEQ + c * 128, q4 = lane >> 4, l15 = lane & 15;
    constexpr int PB = 136;
    const bf16* PROJ = WSP(bf16, WS_PROJ);
    bf16* Bs = (bf16*)lds; bf16* Cs = (bf16*)(lds + 34816); bf16* BT = (bf16*)(lds + 69632);
    bf16* Sc = (bf16*)lds; bf16* XT = (bf16*)(lds + 34816); bf16* XTw = (bf16*)(lds + 52224);
    float* dts = (float*)(lds + 104448); float* acs = dts + 1024; float* wds = acs + 1024; float* rds = wds + 1024;
    const float* cw = a.in[I_SCW] + (size_t)l * 4 * 1536; const float* cb = a.in[I_SCB] + (size_t)l * 1536;
    {
        const int h = 8 * g + wave; const float dtb = a.in[I_SDTB][l * 16 + h], A = -__expf(a.in[I_SALOG][l * 16 + h]);
        const float r0 = bf2f(PROJ[(size_t)(tok0 + 2 * lane) * INWP + O_DT + h]), r1 = bf2f(PROJ[(size_t)(tok0 + 2 * lane + 1) * INWP + O_DT + h]);
        const float d0 = softplus_f(r0 + dtb), d1 = softplus_f(r1 + dtb), a0 = d0 * A, a1 = d1 * A;
        const float incl = wave_scan_incl(a0 + a1, lane), last = __shfl(incl, 63), ac0 = incl - a1, ac1 = incl;
        const int o = wave * 128 + 2 * lane;
        dts[o] = d0; dts[o + 1] = d1; acs[o] = ac0; acs[o + 1] = ac1; wds[o] = __expf(last - ac0); wds[o + 1] = __expf(last - ac1); rds[o] = 1.f / d0; rds[o + 1] = 1.f / d1;
        float* ACUM = WSP(float, WS_ACUM); ACUM[(size_t)(tok0 + 2 * lane) * 16 + h] = ac0; ACUM[(size_t)(tok0 + 2 * lane + 1) * 16 + h] = ac1;
    }
    {
        const int cp = 2 * lane, r0 = 16 * wave;
        f32x2 y[16];
        const int chB = 1024 + g * 128 + cp;
        conv_pair<16, true>(PROJ + (size_t)tok0 * INWP + O_XBC + chB, r0, c == 0, cw + chB, cb + chB, y);
#pragma unroll
        for (int i = 0; i < 16; ++i) { const int s = r0 + i; *(unsigned*)(Bs + s * PB + cp) = pk2(y[i].x, y[i].y); BT[cp * PB + s] = f2bf(y[i].x); BT[(cp + 1) * PB + s] = f2bf(y[i].y); }
        const int chC = 1280 + g * 128 + cp;
        conv_pair<16, true>(PROJ + (size_t)tok0 * INWP + O_XBC + chC, r0, c == 0, cw + chC, cb + chC, y);
        bf16* CC = WSP(bf16, WS_CC);
#pragma unroll
        for (int i = 0; i < 16; ++i) { const int t = r0 + i; const unsigned w = pk2(y[i].x, y[i].y); *(unsigned*)(Cs + t * PB + cp) = w; *(unsigned*)(CC + (size_t)(tok0 + t) * 256 + g * 128 + cp) = w; }
    }
    __syncthreads();
    f32x4 gacc[8];
#pragma unroll
    for (int sb = 0; sb < 8; ++sb) { gacc[sb] = (f32x4){0.f, 0.f, 0.f, 0.f};
        if (sb <= wave) {
#pragma unroll
            for (int ks = 0; ks < 4; ++ks) gacc[sb] = mfma16(frag16(Bs, PB, 16 * sb, 32 * ks, lane), frag16(Cs, PB, 16 * wave, 32 * ks, lane), gacc[sb]); } }
    __syncthreads();
    float* YI = WSP(float, WS_YI); float* HLOC = WSP(float, WS_HLOC);
    for (int hh = 0; hh < 8; ++hh) {
        const int h = 8 * g + hh; const float Dh = a.in[I_SD][l * 16 + h];
        {
            const int cp = 2 * (tid & 31), r0 = 8 * (tid >> 5), ch = h * 64 + cp;
            f32x2 y[8];
            conv_pair<8, true>(PROJ + (size_t)tok0 * INWP + O_XBC + ch, r0, c == 0, cw + ch, cb + ch, y);
#pragma unroll
            for (int i = 0; i < 8; ++i) { const int t = r0 + i; const float dt = dts[hh * 128 + t], wd = wds[hh * 128 + t]; const float x0 = y[i].x * dt, x1 = y[i].y * dt;
                XT[cp * PB + t] = f2bf(x0); XT[(cp + 1) * PB + t] = f2bf(x1); XTw[cp * PB + t] = f2bf(x0 * wd); XTw[(cp + 1) * PB + t] = f2bf(x1 * wd); }
        }
        {
            const int t = 16 * wave + l15; const float at = acs[hh * 128 + t];
#pragma unroll
            for (int sb = 0; sb < 8; ++sb) { const int s0 = 16 * sb + 4 * q4; float v[4];
#pragma unroll
                for (int r = 0; r < 4; ++r) { const float e = __expf(fminf(at - acs[hh * 128 + s0 + r], 0.f)); v[r] = (sb <= wave && s0 + r <= t) ? gacc[sb][r] * e : 0.f; }
                u32x2 w; w.x = pk2(v[0], v[1]); w.y = pk2(v[2], v[3]); *(u32x2*)(Sc + t * PB + s0) = w; }
        }
        __syncthreads();
        {
            const int t = 16 * wave + l15; const float rd = rds[hh * 128 + t];
#pragma unroll
            for (int pb = 0; pb < 4; ++pb) { f32x4 acc = (f32x4){0.f, 0.f, 0.f, 0.f};
#pragma unroll
                for (int ks = 0; ks < 4; ++ks) if (2 * ks <= wave) acc = mfma16(frag16(XT, PB, 16 * pb, 32 * ks, lane), frag16(Sc, PB, 16 * wave, 32 * ks, lane), acc);
                const int p0 = 16 * pb + 4 * q4; f32x4 o;
#pragma unroll
                for (int r = 0; r < 4; ++r) o[r] = acc[r] + Dh * bf2f(XT[(p0 + r) * PB + t]) * rd;
                *(f32x4*)(YI + (size_t)(tok0 + t) * 1024 + h * 64 + p0) = o; }
        }
        {
            float* hl = HLOC + (size_t)((b * 16 + c) * 16 + h) * 8192;
#pragma unroll
            for (int pb = 0; pb < 4; ++pb) { f32x4 acc = (f32x4){0.f, 0.f, 0.f, 0.f};
#pragma unroll
                for (int ks = 0; ks < 4; ++ks) acc = mfma16(frag16(XTw, PB, 16 * pb, 32 * ks, lane), frag16(BT, PB, 16 * wave, 32 * ks, lane), acc);
#pragma unroll
                for (int r = 0; r < 4; ++r) hl[(16 * pb + 4 * q4 + r) * 128 + 16 * wave + l15] = acc[r]; }
        }
        __syncthreads();
    }
}

__device__ __forceinline__ void ssd_sample_unit(int l, int unit, unsigned char* lds, int tid) { ENTER();
    const int g = unit & 1, b = unit >> 1, m0 = NP + 4 * b;
    const bf16* PROJ = WSP(bf16, WS_PROJ);
    float* xs = (float*)lds; float* Bv = xs + 2048; float* Cv = Bv + 512; float* ygs = Cv + 512; float* cbm = ygs + 2048; float* dtv = cbm + 16; float* acv = dtv + 32; float* yst = acv + 32;
    for (int idx = tid; idx < 768; idx += NTHR) {
        int ch; float* dst; int ds;
        if (idx < 512) { ch = g * 512 + idx; dst = xs + idx; ds = 512; } else if (idx < 640) { ch = 1024 + g * 128 + (idx - 512); dst = Bv + (idx - 512); ds = 128; } else { ch = 1280 + g * 128 + (idx - 640); dst = Cv + (idx - 640); ds = 128; }
        float xp[7];
#pragma unroll
        for (int j = 0; j < 3; ++j) xp[j] = a.in[I_SSC][((size_t)(l * NSB + b) * 3 + j) * 1536 + ch];
#pragma unroll
        for (int t = 0; t < 4; ++t) xp[3 + t] = bf2f(PROJ[(size_t)(m0 + t) * INWP + O_XBC + ch]);
        const float bias = a.in[I_SCB][l * 1536 + ch]; float w[4];
#pragma unroll
        for (int j = 0; j < 4; ++j) w[j] = a.in[I_SCW][(size_t)(l * 4 + j) * 1536 + ch];
#pragma unroll
        for (int t = 0; t < 4; ++t) dst[t * ds] = silu_f(w[0] * xp[t] + w[1] * xp[t + 1] + w[2] * xp[t + 2] + w[3] * xp[t + 3] + bias);
    }
    if (tid < 32) { const int hh = tid >> 2, t = tid & 3, h = 8 * g + hh; const float dtb = a.in[I_SDTB][l * 16 + h], A = -__expf(a.in[I_SALOG][l * 16 + h]); float ac = 0.f, dt = 0.f;
        for (int j = 0; j < 4; ++j) { const float d = softplus_f(bf2f(PROJ[(size_t)(m0 + j) * INWP + O_DT + h]) + dtb); if (j <= t) { ac += d * A; dt = d; } }
        dtv[hh * 4 + t] = dt; acv[hh * 4 + t] = ac; }
    __syncthreads();
    {
#pragma unroll
        for (int k = 0; k < 2; ++k) { const int pr = 2 * wave + k, t = pr >> 2, s = pr & 3;
            const float v = wave_sum(Cv[t * 128 + lane] * Bv[s * 128 + lane] + Cv[t * 128 + 64 + lane] * Bv[s * 128 + 64 + lane]); if (lane == 0) cbm[pr] = v; }
    }
    __syncthreads();
    for (int hh = 0; hh < 8; ++hh) {
        const int h = 8 * g + hh, p = tid >> 3, n0 = (tid & 7) * 16;
        const float* hin = a.in[I_SSD] + ((size_t)((l * NSB + b) * 16 + h) * 64 + p) * 128 + n0;
        float* hout = a.out + OUT_SSSD + ((size_t)((l * NSB + b) * 16 + h) * 64 + p) * 128 + n0;
        float h0[16];
#pragma unroll
        for (int i = 0; i < 4; ++i) { const f32x4 v = *(const f32x4*)(hin + 4 * i); h0[4 * i] = v.x; h0[4 * i + 1] = v.y; h0[4 * i + 2] = v.z; h0[4 * i + 3] = v.w; }
        const float ac3 = acv[hh * 4 + 3];
#pragma unroll
        for (int t = 0; t < 4; ++t) { float s = 0.f;
#pragma unroll
            for (int i = 0; i < 16; ++i) s += Cv[t * 128 + n0 + i] * h0[i];
            s += __shfl_xor(s, 1); s += __shfl_xor(s, 2); s += __shfl_xor(s, 4);
            if ((tid & 7) == 0) yst[t * 64 + p] = s; }
        float hn[16]; const float e3 = __expf(ac3);
#pragma unroll
        for (int i = 0; i < 16; ++i) hn[i] = e3 * h0[i];
#pragma unroll
        for (int s = 0; s < 4; ++s) { const float cf = __expf(ac3 - acv[hh * 4 + s]) * dtv[hh * 4 + s] * xs[s * 512 + hh * 64 + p];
#pragma unroll
            for (int i = 0; i < 16; ++i) hn[i] += cf * Bv[s * 128 + n0 + i]; }
#pragma unroll
        for (int i = 0; i < 4; ++i) *(f32x4*)(hout + 4 * i) = (f32x4){hn[4 * i], hn[4 * i + 1], hn[4 * i + 2], hn[4 * i + 3]};
        __syncthreads();
        if (tid < 256) { const int t = tid >> 6, pp = tid & 63; const float at = acv[hh * 4 + t]; float y = __expf(at) * yst[t * 64 + pp] + a.in[I_SD][l * 16 + h] * xs[t * 512 + hh * 64 + pp];
            for (int s = 0; s <= t; ++s) y += cbm[t * 4 + s] * __expf(at - acv[hh * 4 + s]) * dtv[hh * 4 + s] * xs[s * 512 + hh * 64 + pp];
            const float z = bf2f(PROJ[(size_t)(m0 + t) * INWP + O_SSDZ + h * 64 + pp]);
            ygs[t * 512 + hh * 64 + pp] = y * silu_f(z); }
        __syncthreads();
    }
    if (wave < 4) { const int t = wave; float ss = 0.f;
#pragma unroll
        for (int j = 0; j < 8; ++j) { const float v = ygs[t * 512 + lane + 64 * j]; ss += v * v; }
        const float rs = 1.f / sqrtf(wave_sum(ss) * (1.f / 512.f) + RMS_EPS);
        bf16* mx = WSP(bf16, WS_MIX) + (size_t)(m0 + t) * MIXW + g * 512;
#pragma unroll
        for (int j = 0; j < 8; ++j) { const int cidx = lane + 64 * j; mx[cidx] = f2bf(ygs[t * 512 + cidx] * rs * a.in[I_SNW][l * 1024 + g * 512 + cidx]); } }
}

__device__ __forceinline__ void gdn_sample_unit(int l, int unit, unsigned char* lds, int tid) { ENTER();
    const int h = unit & 3, b = unit >> 2, m0 = NP + 4 * b;
    const bf16* PROJ = WSP(bf16, WS_PROJ);
    float* qv = (float*)lds; float* kv = qv + 512; float* vv = kv + 512; float* pa = vv + 512; float* pb = pa + 512; float* ot = pb + 512; float* bet = ot + 512; float* gex = bet + 4;
    if (tid < 384) { const int which = tid >> 7, d = tid & 127, ch = which * 512 + h * 128 + d; float xp[7];
#pragma unroll
        for (int j = 0; j < 3; ++j) xp[j] = a.in[I_SGC][((size_t)(l * NSB + b) * 3 + j) * 1536 + ch];
#pragma unroll
        for (int t = 0; t < 4; ++t) xp[3 + t] = bf2f(PROJ[(size_t)(m0 + t) * INWP + O_GQKV + ch]);
        float w[4];
#pragma unroll
        for (int j = 0; j < 4; ++j) w[j] = a.in[I_GCW][(size_t)(l * 4 + j) * 1536 + ch];
        float* dst = qv + which * 512 + d;
#pragma unroll
        for (int t = 0; t < 4; ++t) dst[t * 128] = silu_f(w[0] * xp[t] + w[1] * xp[t + 1] + w[2] * xp[t + 2] + w[3] * xp[t + 3]);
    } else if (tid < 392) { const int t = (tid - 384) & 3;
        if (tid < 388) bet[t] = sigmoid_f(bf2f(PROJ[(size_t)(m0 + t) * INWP + O_GB + h]));
        else gex[t] = __expf(-__expf(a.in[I_GALOG][l * 4 + h]) * softplus_f(bf2f(PROJ[(size_t)(m0 + t) * INWP + O_GA + h]) + a.in[I_GDTB][l * 4 + h])); }
    __syncthreads();
    { const int t = wave >> 1, which = wave & 1; float* arr = (which ? kv : qv) + t * 128; const float v0 = arr[lane], v1 = arr[64 + lane];
      const float sc = (1.f / sqrtf(wave_sum(v0 * v0 + v1 * v1) + L2_EPS)) * (which ? 1.f : 0.08838834764831845f); arr[lane] = v0 * sc; arr[64 + lane] = v1 * sc; }
    __syncthreads();
    const int e = tid & 127, dq = tid >> 7;
    const float* sin_ = a.in[I_SGDN] + ((size_t)((l * NSB + b) * 4 + h) * 128 + 32 * dq) * 128 + e;
    float S[32];
#pragma unroll
    for (int i = 0; i < 32; ++i) S[i] = sin_[(size_t)i * 128];
    for (int t = 0; t < 4; ++t) {
        float ks = 0.f;
#pragma unroll
        for (int i = 0; i < 32; ++i) ks += kv[t * 128 + 32 * dq + i] * S[i];
        pa[dq * 128 + e] = ks; __syncthreads();
        const float kS = (pa[e] + pa[128 + e]) + (pa[256 + e] + pa[384 + e]);
        const float bt = bet[t], ge = gex[t], ve = vv[t * 128 + e]; float os = 0.f;
#pragma unroll
        for (int i = 0; i < 32; ++i) { const float ki = kv[t * 128 + 32 * dq + i]; S[i] = ge * (S[i] - bt * ki * kS) + bt * ki * ve; os += qv[t * 128 + 32 * dq + i] * S[i]; }
        pb[dq * 128 + e] = os; __syncthreads();
        if (dq == 0) ot[t * 128 + e] = (pb[e] + pb[128 + e]) + (pb[256 + e] + pb[384 + e]);
    }
    __syncthreads();
    if (wave < 4) { const int t = wave; const float o0 = ot[t * 128 + lane], o1 = ot[t * 128 + 64 + lane];
        const float rs = 1.f / sqrtf(wave_sum(o0 * o0 + o1 * o1) * (1.f / 128.f) + RMS_EPS);
        const bf16* zr = PROJ + (size_t)(m0 + t) * INWP + O_GZ + h * 128; const float* nw = a.in[I_GNW] + l * 128;
        bf16* mx = WSP(bf16, WS_MIX) + (size_t)(m0 + t) * MIXW + 1536 + h * 128;
        mx[lane] = f2bf(o0 * rs * nw[lane] * silu_f(bf2f(zr[lane]))); mx[64 + lane] = f2bf(o1 * rs * nw[64 + lane] * silu_f(bf2f(zr[64 + lane]))); }
    float* so = a.out + OUT_SGDN + ((size_t)((l * NSB + b) * 4 + h) * 128 + 32 * dq) * 128 + e;
#pragma unroll
    for (int i = 0; i < 32; ++i) so[(size_t)i * 128] = S[i];
}

__device__ __forceinline__ void gdn_prep_unit(int l, int u, unsigned char* lds, int tid) { ENTER();
    const int h = u & 3, c = (u >> 2) & 31, b = u >> 7, tok0 = b * SEQ + c * 64, q4 = lane >> 4, l15 = lane & 15;
    const bf16* PROJ = WSP(bf16, WS_PROJ);
    bf16* Ks = (bf16*)lds; bf16* KBs = (bf16*)(lds + 17408); bf16* Qs = (bf16*)(lds + 34816); bf16* VBT = (bf16*)(lds + 52224); bf16* KBGT = (bf16*)(lds + 70656); bf16* KDTs = (bf16*)(lds + 89088);
    float* Am = (float*)(lds + 107520); bf16* Ts = (bf16*)(lds + 124928); float* gcs = (float*)(lds + 134144); float* bts = gcs + 64;
    if (wave == 0) {
        const float rb = bf2f(PROJ[(size_t)(tok0 + lane) * INWP + O_GB + h]), ra = bf2f(PROJ[(size_t)(tok0 + lane) * INWP + O_GA + h]);
        const float gt = -__expf(a.in[I_GALOG][l * 4 + h]) * softplus_f(ra + a.in[I_GDTB][l * 4 + h]);
        gcs[lane] = wave_scan_incl(gt, lane); bts[lane] = sigmoid_f(rb);
    }
    __syncthreads();
    {
        const int cp = 2 * lane, r0 = 8 * wave; const float* cw = a.in[I_GCW] + (size_t)l * 4 * 1536; const float glast = gcs[63];
        f32x2 q[8], k[8], v[8];
        conv_pair<8, false>(PROJ + (size_t)tok0 * INWP + O_GQKV + h * 128 + cp, r0, c == 0, cw + h * 128 + cp, nullptr, q);
        conv_pair<8, false>(PROJ + (size_t)tok0 * INWP + O_GQKV + 512 + h * 128 + cp, r0, c == 0, cw + 512 + h * 128 + cp, nullptr, k);
        conv_pair<8, false>(PROJ + (size_t)tok0 * INWP + O_GQKV + 1024 + h * 128 + cp, r0, c == 0, cw + 1024 + h * 128 + cp, nullptr, v);
        bf16* QG = WSP(bf16, WS_GQG) + (size_t)u * 8192;
#pragma unroll
        for (int i = 0; i < 8; ++i) { const int t = r0 + i;
            const float sq = 0.08838834764831845f / sqrtf(wave_sum(q[i].x * q[i].x + q[i].y * q[i].y) + L2_EPS), sk = 1.f / sqrtf(wave_sum(k[i].x * k[i].x + k[i].y * k[i].y) + L2_EPS);
            const float q0 = q[i].x * sq, q1 = q[i].y * sq, k0 = k[i].x * sk, k1 = k[i].y * sk, bt = bts[t], gc = gcs[t], eg = __expf(gc), ed = __expf(glast - gc);
            *(unsigned*)(Ks + t * 136 + cp) = pk2(k0, k1); *(unsigned*)(KBs + t * 136 + cp) = pk2(k0 * bt, k1 * bt); *(unsigned*)(Qs + t * 136 + cp) = pk2(q0, q1);
            VBT[cp * 72 + t] = f2bf(v[i].x * bt); VBT[(cp + 1) * 72 + t] = f2bf(v[i].y * bt);
            KBGT[cp * 72 + t] = f2bf(k0 * bt * eg); KBGT[(cp + 1) * 72 + t] = f2bf(k1 * bt * eg);
            KDTs[cp * 72 + t] = f2bf(k0 * ed); KDTs[(cp + 1) * 72 + t] = f2bf(k1 * ed);
            *(unsigned*)(QG + t * 128 + cp) = pk2(q0 * eg, q1 * eg); }
    }
    __syncthreads();
    bf16* ATT = WSP(bf16, WS_GATT) + (size_t)u * 4096;
    for (int item = wave; item < 26; item += 8) {
        if (item < 10) {
            const int tb = item >= 6 ? 3 : item >= 3 ? 2 : item >= 1 ? 1 : 0, sb = item - tb * (tb + 1) / 2;
            f32x4 acc = (f32x4){0.f, 0.f, 0.f, 0.f};
#pragma unroll
            for (int ks = 0; ks < 4; ++ks) acc = mfma16(frag16(KBs, 136, 16 * tb, 32 * ks, lane), frag16(Ks, 136, 16 * sb, 32 * ks, lane), acc);
            const int s = 16 * sb + l15; const float gs = gcs[s];
#pragma unroll
            for (int r = 0; r < 4; ++r) { const int t = 16 * tb + 4 * q4 + r; Am[t * 68 + s] = (s < t) ? acc[r] * __expf(fminf(gcs[t] - gs, 0.f)) : 0.f; }
        } else {
            const int j = item - 10, tb = j >> 2, sb = j & 3; f32x4 acc = (f32x4){0.f, 0.f, 0.f, 0.f};
            if (sb <= tb) {
#pragma unroll
                for (int ks = 0; ks < 4; ++ks) acc = mfma16(frag16(Ks, 136, 16 * sb, 32 * ks, lane), frag16(Qs, 136, 16 * tb, 32 * ks, lane), acc); }
            const int t = 16 * tb + l15, s0 = 16 * sb + 4 * q4; const float gt = gcs[t]; float vv[4];
#pragma unroll
            for (int r = 0; r < 4; ++r) vv[r] = (sb <= tb && s0 + r <= t) ? acc[r] * __expf(fminf(gt - gcs[s0 + r], 0.f)) : 0.f;
            u32x2 w; w.x = pk2(vv[0], vv[1]); w.y = pk2(vv[2], vv[3]); *(u32x2*)(ATT + t * 64 + s0) = w;
        }
    }
    __syncthreads();
#ifndef NOINV
    if (wave == 0) {
        float x[64]; int zo = 0; asm volatile("" : "+v"(zo)); const float* Amz = Am + zo;
#pragma unroll
        for (int i = 0; i < 64; ++i) { float acc = fmaxf(0.f, 1.f - fabsf((float)(i - lane)));
#pragma unroll
            for (int jj = 0; jj < (i + 3) / 4; ++jj) { const f32x4 av = *(const f32x4*)(Amz + i * 68 + 4 * jj);
#pragma unroll
                for (int e = 0; e < 4; ++e) if (4 * jj + e < i) acc -= av[e] * x[4 * jj + e]; }
            x[i] = acc; Ts[i * 72 + lane] = f2bf(acc); }
    }
#endif
    __syncthreads();
    {
        float* U = WSP(float, WS_GU) + (size_t)u * 8192; bf16* NW = WSP(bf16, WS_GNW) + (size_t)u * 8192;
#pragma unroll
        for (int tb = 0; tb < 4; ++tb) { f32x4 au = (f32x4){0.f, 0.f, 0.f, 0.f}, aw = au;
#pragma unroll
            for (int ks = 0; ks < 2; ++ks) { const bf16x8 bf = frag16(Ts, 72, 16 * tb, 32 * ks, lane); au = mfma16(frag16(VBT, 72, 16 * wave, 32 * ks, lane), bf, au); aw = mfma16(frag16(KBGT, 72, 16 * wave, 32 * ks, lane), bf, aw); }
            const int t = 16 * tb + l15, e0 = 16 * wave + 4 * q4;
            *(f32x4*)(U + t * 128 + e0) = au; u32x2 w; w.x = pk2(-aw[0], -aw[1]); w.y = pk2(-aw[2], -aw[3]); *(u32x2*)(NW + t * 128 + e0) = w; }
        bf16* KDT = WSP(bf16, WS_GKDT) + (size_t)u * 8192;
#pragma unroll
        for (int i = 0; i < 2; ++i) { const int id = tid + 512 * i, d = id >> 3, cc = id & 7; *(u32x4*)(KDT + d * 64 + 8 * cc) = *(const u32x4*)(KDTs + d * 72 + 8 * cc); }
        if (tid == 0) WSP(float, WS_GEG)[u] = __expf(gcs[63]);
    }
}

__device__ __forceinline__ void gdn_chain_unit(int l, int unit, unsigned char* lds, int tid) { ENTER();
    const int h = unit & 3, b = unit >> 2, q4 = lane >> 4, l15 = lane & 15, e0 = 16 * wave;
    const bf16* PROJ = WSP(bf16, WS_PROJ);
    bf16* NWs = (bf16*)lds; bf16* QGs = (bf16*)(lds + 17408); bf16* KDs = (bf16*)(lds + 34816); bf16* ATs = (bf16*)(lds + 53248); float* Os = (float*)(lds + 62464);
    f32x4 sacc[8];
#pragma unroll
    for (int i = 0; i < 8; ++i) sacc[i] = (f32x4){0.f, 0.f, 0.f, 0.f};
    for (int c = 0; c < 32; ++c) {
        const int u = (b * 32 + c) * 4 + h, tok0 = b * SEQ + c * 64;
        const bf16* NW = WSP(bf16, WS_GNW) + (size_t)u * 8192; const bf16* QG = WSP(bf16, WS_GQG) + (size_t)u * 8192; const bf16* KDT = WSP(bf16, WS_GKDT) + (size_t)u * 8192;
        const bf16* ATT = WSP(bf16, WS_GATT) + (size_t)u * 4096; const float* U = WSP(float, WS_GU) + (size_t)u * 8192;
#pragma unroll
        for (int i = 0; i < 2; ++i) { const int id = tid + 512 * i, row = id >> 4, cc = id & 15;
            *(u32x4*)(NWs + row * 136 + 8 * cc) = *(const u32x4*)(NW + row * 128 + 8 * cc); *(u32x4*)(QGs + row * 136 + 8 * cc) = *(const u32x4*)(QG + row * 128 + 8 * cc);
            const int d = id >> 3, c8 = id & 7; *(u32x4*)(KDs + d * 72 + 8 * c8) = *(const u32x4*)(KDT + d * 64 + 8 * c8); }
        { const int row = tid >> 3, c8 = tid & 7; *(u32x4*)(ATs + row * 72 + 8 * c8) = *(const u32x4*)(ATT + row * 64 + 8 * c8); }
        const float eg = WSP(float, WS_GEG)[u];
        __syncthreads();
        bf16x8 sf[4];
#pragma unroll
        for (int ks = 0; ks < 4; ++ks) sf[ks] = accpair(sacc[2 * ks], sacc[2 * ks + 1]);
        f32x4 vn[4];
#pragma unroll
        for (int tb = 0; tb < 4; ++tb) { f32x4 acc;
#pragma unroll
            for (int r = 0; r < 4; ++r) acc[r] = U[(16 * tb + 4 * q4 + r) * 128 + e0 + l15];
#pragma unroll
            for (int ks = 0; ks < 4; ++ks) acc = mfma16(frag16p(NWs, 136, 16 * tb, 32 * ks, lane), sf[ks], acc);
            vn[tb] = acc; }
        const bf16x8 vf0 = accpair(vn[0], vn[1]), vf1 = accpair(vn[2], vn[3]);
#pragma unroll
        for (int tb = 0; tb < 4; ++tb) { f32x4 acc = (f32x4){0.f, 0.f, 0.f, 0.f};
#pragma unroll
            for (int ks = 0; ks < 4; ++ks) acc = mfma16(frag16p(QGs, 136, 16 * tb, 32 * ks, lane), sf[ks], acc);
            acc = mfma16(frag16p(ATs, 72, 16 * tb, 0, lane), vf0, acc); acc = mfma16(frag16p(ATs, 72, 16 * tb, 32, lane), vf1, acc);
#pragma unroll
            for (int r = 0; r < 4; ++r) Os[(16 * tb + 4 * q4 + r) * 132 + e0 + l15] = acc[r]; }
#pragma unroll
        for (int db = 0; db < 8; ++db) { f32x4 acc = sacc[db] * eg;
            acc = mfma16(frag16p(KDs, 72, 16 * db, 0, lane), vf0, acc); acc = mfma16(frag16p(KDs, 72, 16 * db, 32, lane), vf1, acc); sacc[db] = acc; }
        __syncthreads();
        {
            const float nw0 = a.in[I_GNW][l * 128 + 2 * lane], nw1 = a.in[I_GNW][l * 128 + 2 * lane + 1];
#pragma unroll
            for (int i = 0; i < 8; ++i) { const int t = 8 * wave + i; const f32x2 o = *(const f32x2*)(Os + t * 132 + 2 * lane);
                const float rs = 1.f / sqrtf(wave_sum(o.x * o.x + o.y * o.y) * (1.f / 128.f) + RMS_EPS);
                const unsigned z = *(const unsigned*)(PROJ + (size_t)(tok0 + t) * INWP + O_GZ + h * 128 + 2 * lane);
                *(unsigned*)(WSP(bf16, WS_MIX) + (size_t)(tok0 + t) * MIXW + 1536 + h * 128 + 2 * lane) = pk2(o.x * rs * nw0 * silu_f(bflo(z)), o.y * rs * nw1 * silu_f(bfhi(z))); }
        }
        __syncthreads();
    }
    float* so = a.out + OUT_PGDN + (size_t)((l * NPB + b) * 4 + h) * 16384;
#pragma unroll
    for (int db = 0; db < 8; ++db)
#pragma unroll
        for (int r = 0; r < 4; ++r) so[(16 * db + 4 * q4 + r) * 128 + e0 + l15] = sacc[db][r];
}

__device__ __forceinline__ void ssd_chain_unit(int l, int unit, unsigned char* lds, int tid) { ENTER();
    const int h = unit & 15, b = unit >> 4, g = h >> 3, q4 = lane >> 4, l15 = lane & 15;
    const bf16* PROJ = WSP(bf16, WS_PROJ); const bf16* CC = WSP(bf16, WS_CC); const float* ACUM = WSP(float, WS_ACUM); const float* YI = WSP(float, WS_YI);
    bf16* YG = WSP(bf16, WS_YG); float* SSQ = WSP(float, WS_SSQ);
    bf16* Hs = (bf16*)lds; bf16* Cs = (bf16*)(lds + 17408);
    const int hp = tid >> 3, hn0 = (tid & 7) * 16;
    float H[16];
#pragma unroll
    for (int i = 0; i < 16; ++i) H[i] = 0.f;
    for (int c = 0; c < 16; ++c) {
        const int tok0 = b * SEQ + c * 128;
        { u32x4 w0, w1; w0.x = pk2(H[0], H[1]); w0.y = pk2(H[2], H[3]); w0.z = pk2(H[4], H[5]); w0.w = pk2(H[6], H[7]); w1.x = pk2(H[8], H[9]); w1.y = pk2(H[10], H[11]); w1.z = pk2(H[12], H[13]); w1.w = pk2(H[14], H[15]);
          *(u32x4*)(Hs + hp * 136 + hn0) = w0; *(u32x4*)(Hs + hp * 136 + hn0 + 8) = w1; }
#pragma unroll
        for (int i = 0; i < 4; ++i) { const int id = tid + 512 * i, row = id >> 4, cc = id & 15; *(u32x4*)(Cs + row * 136 + 8 * cc) = *(const u32x4*)(CC + (size_t)(tok0 + row) * 256 + g * 128 + 8 * cc); }
        __syncthreads();
        {
            const int t = 16 * wave + l15, tok = tok0 + t; const float ea = __expf(ACUM[(size_t)tok * 16 + h]); float ssq = 0.f;
#pragma unroll
            for (int pb = 0; pb < 4; ++pb) { f32x4 acc = (f32x4){0.f, 0.f, 0.f, 0.f};
#pragma unroll
                for (int ks = 0; ks < 4; ++ks) acc = mfma16(frag16(Hs, 136, 16 * pb, 32 * ks, lane), frag16(Cs, 136, 16 * wave, 32 * ks, lane), acc);
                const int p0 = 16 * pb + 4 * q4;
                const f32x4 yi = *(const f32x4*)(YI + (size_t)tok * 1024 + h * 64 + p0); const u32x2 z = *(const u32x2*)(PROJ + (size_t)tok * INWP + O_SSDZ + h * 64 + p0);
                const float y0 = (yi.x + ea * acc[0]) * silu_f(bflo(z.x)), y1 = (yi.y + ea * acc[1]) * silu_f(bfhi(z.x)), y2 = (yi.z + ea * acc[2]) * silu_f(bflo(z.y)), y3 = (yi.w + ea * acc[3]) * silu_f(bfhi(z.y));
                ssq += (y0 * y0 + y1 * y1) + (y2 * y2 + y3 * y3);
                u32x2 w; w.x = pk2(y0, y1); w.y = pk2(y2, y3); *(u32x2*)(YG + (size_t)tok * 1024 + h * 64 + p0) = w; }
            ssq += __shfl_xor(ssq, 16); ssq += __shfl_xor(ssq, 32);
            if (q4 == 0) SSQ[(size_t)tok * 16 + h] = ssq;
        }
        {
            const float dl = __expf(ACUM[(size_t)(tok0 + 127) * 16 + h]); const float* hl = WSP(float, WS_HLOC) + (size_t)((b * 16 + c) * 16 + h) * 8192 + hp * 128 + hn0;
#pragma unroll
            for (int i = 0; i < 4; ++i) { const f32x4 v = *(const f32x4*)(hl + 4 * i); H[4 * i] = dl * H[4 * i] + v.x; H[4 * i + 1] = dl * H[4 * i + 1] + v.y; H[4 * i + 2] = dl * H[4 * i + 2] + v.z; H[4 * i + 3] = dl * H[4 * i + 3] + v.w; }
        }
        __syncthreads();
    }
    float* ho = a.out + OUT_PSSD + (size_t)((l * NPB + b) * 16 + h) * 8192 + hp * 128 + hn0;
#pragma unroll
    for (int i = 0; i < 4; ++i) *(f32x4*)(ho + 4 * i) = (f32x4){H[4 * i], H[4 * i + 1], H[4 * i + 2], H[4 * i + 3]};
}

__device__ __forceinline__ void ssd_final_unit(int l, int unit, int tid) { ENTER();
    const bf16* YG = WSP(bf16, WS_YG); const float* SSQ = WSP(float, WS_SSQ); bf16* MIX = WSP(bf16, WS_MIX);
    for (int i = 0; i < 8; ++i) { const int m = unit * 64 + wave * 8 + i;
#pragma unroll
        for (int g = 0; g < 2; ++g) { float ss = 0.f;
#pragma unroll
            for (int j = 0; j < 8; ++j) ss += SSQ[(size_t)m * 16 + 8 * g + j];
            const float rs = 1.f / sqrtf(ss * (1.f / 512.f) + RMS_EPS);
            const u32x4 w = *(const u32x4*)(YG + (size_t)m * 1024 + g * 512 + 8 * lane);
            const f32x4 n0 = *(const f32x4*)(a.in[I_SNW] + l * 1024 + g * 512 + 8 * lane), n1 = *(const f32x4*)(a.in[I_SNW] + l * 1024 + g * 512 + 8 * lane + 4);
            u32x4 o; o.x = pk2(bflo(w.x) * rs * n0.x, bfhi(w.x) * rs * n0.y); o.y = pk2(bflo(w.y) * rs * n0.z, bfhi(w.y) * rs * n0.w);
            o.z = pk2(bflo(w.z) * rs * n1.x, bfhi(w.z) * rs * n1.y); o.w = pk2(bflo(w.w) * rs * n1.z, bfhi(w.w) * rs * n1.w);
            *(u32x4*)(MIX + (size_t)m * MIXW + g * 512 + 8 * lane) = o; } }
}

__device__ __forceinline__ void attn_unit(int l, int unit, unsigned char* lds, int tid) { ENTER();
    const int qb = 7 - (unit >> 6), bh = unit & 63, b = bh >> 3, h = bh & 7, r32 = lane & 31, hh = lane >> 5;
    const bf16* Q = WSP(bf16, WS_Q); const bf16* KK = WSP(bf16, WS_KK); const bf16* VT = WSP(bf16, WS_VT); const float* RC = WSP(float, WS_ROPECS);
    bf16* Ks = (bf16*)lds; bf16* VTs = (bf16*)(lds + 13312);
    const int qrow = 256 * qb + 32 * wave + r32, tok = b * SEQ + qrow;
    bf16x8 qf[6];
    {
        const bf16* qp = Q + (size_t)tok * 768 + h * 96 + 8 * hh;
#pragma unroll
        for (int ks = 0; ks < 4; ++ks) { const u32x4 w = *(const u32x4*)(qp + 16 * ks); u32x4 o;
            o.x = pk2(bflo(w.x) * ATT_SC, bfhi(w.x) * ATT_SC); o.y = pk2(bflo(w.y) * ATT_SC, bfhi(w.y) * ATT_SC); o.z = pk2(bflo(w.z) * ATT_SC, bfhi(w.z) * ATT_SC); o.w = pk2(bflo(w.w) * ATT_SC, bfhi(w.w) * ATT_SC);
            qf[ks] = __builtin_bit_cast(bf16x8, o); }
        const u32x4 w1 = *(const u32x4*)(qp + 64), w2 = *(const u32x4*)(qp + 80);
        const f32x4 c0 = *(const f32x4*)(RC + (size_t)tok * 32 + 8 * hh), c1 = *(const f32x4*)(RC + (size_t)tok * 32 + 8 * hh + 4), s0 = *(const f32x4*)(RC + (size_t)tok * 32 + 16 + 8 * hh), s1 = *(const f32x4*)(RC + (size_t)tok * 32 + 16 + 8 * hh + 4);
        float x1[8] = {bflo(w1.x), bfhi(w1.x), bflo(w1.y), bfhi(w1.y), bflo(w1.z), bfhi(w1.z), bflo(w1.w), bfhi(w1.w)};
        float x2[8] = {bflo(w2.x), bfhi(w2.x), bflo(w2.y), bfhi(w2.y), bflo(w2.z), bfhi(w2.z), bflo(w2.w), bfhi(w2.w)};
        float cc[8] = {c0.x, c0.y, c0.z, c0.w, c1.x, c1.y, c1.z, c1.w}, sn[8] = {s0.x, s0.y, s0.z, s0.w, s1.x, s1.y, s1.z, s1.w};
        float o1[8], o2[8];
#pragma unroll
        for (int i = 0; i < 8; ++i) { o1[i] = (x1[i] * cc[i] - x2[i] * sn[i]) * ATT_SC; o2[i] = (x2[i] * cc[i] + x1[i] * sn[i]) * ATT_SC; }
        u32x4 p1, p2; p1.x = pk2(o1[0], o1[1]); p1.y = pk2(o1[2], o1[3]); p1.z = pk2(o1[4], o1[5]); p1.w = pk2(o1[6], o1[7]); p2.x = pk2(o2[0], o2[1]); p2.y = pk2(o2[2], o2[3]); p2.z = pk2(o2[4], o2[5]); p2.w = pk2(o2[6], o2[7]);
        qf[4] = __builtin_bit_cast(bf16x8, p1); qf[5] = __builtin_bit_cast(bf16x8, p2);
    }
    f32x16 o0, o1;
#pragma unroll
    for (int r = 0; r < 16; ++r) { o0[r] = 0.f; o1[r] = 0.f; }
    float m = -1e30f, lsum = 0.f;
    const int KT = 4 * qb + 4;
    const int kr0 = tid / 12, kc0 = tid % 12, kr1 = (tid + 512) / 12, kc1 = (tid + 512) % 12, vr = tid >> 3, vc = tid & 7;
    const bf16* kbase = KK + (size_t)(b * SEQ) * 768 + h * 96; const bf16* vbase = VT + (size_t)(h * 64 + vr) * NP + b * SEQ + 8 * vc;
    u32x4 kreg0 = *(const u32x4*)(kbase + (size_t)kr0 * 768 + 8 * kc0), kreg1 = (u32x4){0u, 0u, 0u, 0u}, vreg = *(const u32x4*)(vbase);
    if (tid < 256) kreg1 = *(const u32x4*)(kbase + (size_t)kr1 * 768 + 8 * kc1);
    for (int kt = 0; kt < KT; ++kt) {
        const int key0 = 64 * kt;
        __syncthreads();
        *(u32x4*)(Ks + kr0 * 104 + 8 * kc0) = kreg0; if (tid < 256) *(u32x4*)(Ks + kr1 * 104 + 8 * kc1) = kreg1; *(u32x4*)(VTs + vr * 72 + 8 * vc) = vreg;
        if (kt + 1 < KT) { kreg0 = *(const u32x4*)(kbase + (size_t)(key0 + 64 + kr0) * 768 + 8 * kc0); if (tid < 256) kreg1 = *(const u32x4*)(kbase + (size_t)(key0 + 64 + kr1) * 768 + 8 * kc1); vreg = *(const u32x4*)(vbase + key0 + 64); }
        __syncthreads();
        if (key0 <= 256 * qb + 32 * wave + 31) {
            f32x16 s0, s1;
#pragma unroll
            for (int r = 0; r < 16; ++r) { s0[r] = 0.f; s1[r] = 0.f; }
#pragma unroll
            for (int ks = 0; ks < 6; ++ks) { const bf16x8 a0 = *(const bf16x8*)(Ks + r32 * 104 + 16 * ks + 8 * hh), a1 = *(const bf16x8*)(Ks + (32 + r32) * 104 + 16 * ks + 8 * hh);
                s0 = mfma32(a0, qf[ks], s0); s1 = mfma32(a1, qf[ks], s1); }
            if (key0 + 63 > 256 * qb + 32 * wave) {
#pragma unroll
                for (int r = 0; r < 16; ++r) { const int key = key0 + (r & 3) + 8 * (r >> 2) + 4 * hh; if (key > qrow) s0[r] = -1e30f; if (key + 32 > qrow) s1[r] = -1e30f; } }
            float mx = s0[0];
#pragma unroll
            for (int r = 1; r < 16; ++r) mx = fmaxf(mx, s0[r]);
#pragma unroll
            for (int r = 0; r < 16; ++r) mx = fmaxf(mx, s1[r]);
            mx = fmaxf(mx, __shfl_xor(mx, 32));
            const float mn = fmaxf(m, mx), alpha = __builtin_amdgcn_exp2f(m - mn); m = mn;
            float ps = 0.f;
#pragma unroll
            for (int r = 0; r < 16; ++r) { s0[r] = __builtin_amdgcn_exp2f(s0[r] - mn); s1[r] = __builtin_amdgcn_exp2f(s1[r] - mn); ps += s0[r] + s1[r]; }
            ps += __shfl_xor(ps, 32); lsum = lsum * alpha + ps;
#pragma unroll
            for (int r = 0; r < 16; ++r) { o0[r] *= alpha; o1[r] *= alpha; }
            bf16x8 pf[4];
#pragma unroll
            for (int s2 = 0; s2 < 2; ++s2) { u32x4 w;
                w.x = pk2(s0[8 * s2], s0[8 * s2 + 1]); w.y = pk2(s0[8 * s2 + 2], s0[8 * s2 + 3]); w.z = pk2(s0[8 * s2 + 4], s0[8 * s2 + 5]); w.w = pk2(s0[8 * s2 + 6], s0[8 * s2 + 7]); pf[s2] = __builtin_bit_cast(bf16x8, w);
                w.x = pk2(s1[8 * s2], s1[8 * s2 + 1]); w.y = pk2(s1[8 * s2 + 2], s1[8 * s2 + 3]); w.z = pk2(s1[8 * s2 + 4], s1[8 * s2 + 5]); w.w = pk2(s1[8 * s2 + 6], s1[8 * s2 + 7]); pf[2 + s2] = __builtin_bit_cast(bf16x8, w); }
#pragma unroll
            for (int kk = 0; kk < 4; ++kk) {
                const bf16* vp0 = VTs + r32 * 72 + 16 * kk + 4 * hh; const bf16* vp1 = vp0 + 32 * 72;
                const bf16x4 l0 = *(const bf16x4*)vp0, h0 = *(const bf16x4*)(vp0 + 8), l1 = *(const bf16x4*)vp1, h1 = *(const bf16x4*)(vp1 + 8);
                o0 = mfma32((bf16x8){l0[0], l0[1], l0[2], l0[3], h0[0], h0[1], h0[2], h0[3]}, pf[kk], o0);
                o1 = mfma32((bf16x8){l1[0], l1[1], l1[2], l1[3], h1[0], h1[1], h1[2], h1[3]}, pf[kk], o1); }
        }
    }
    {
        const float inv = 1.f / lsum; const bf16* gp = WSP(bf16, WS_PROJ) + (size_t)tok * INWP + O_GATE + h * 64; bf16* mp = WSP(bf16, WS_MIX) + (size_t)tok * MIXW + 1024 + h * 64;
#pragma unroll
        for (int rr = 0; rr < 4; ++rr) { const int d0 = 8 * rr + 4 * hh;
            { const u32x2 gz = *(const u32x2*)(gp + d0); u32x2 w; w.x = pk2(o0[4 * rr] * inv * silu_f(bflo(gz.x)), o0[4 * rr + 1] * inv * silu_f(bfhi(gz.x))); w.y = pk2(o0[4 * rr + 2] * inv * silu_f(bflo(gz.y)), o0[4 * rr + 3] * inv * silu_f(bfhi(gz.y))); *(u32x2*)(mp + d0) = w; }
            { const u32x2 gz = *(const u32x2*)(gp + 32 + d0); u32x2 w; w.x = pk2(o1[4 * rr] * inv * silu_f(bflo(gz.x)), o1[4 * rr + 1] * inv * silu_f(bfhi(gz.x))); w.y = pk2(o1[4 * rr + 2] * inv * silu_f(bflo(gz.y)), o1[4 * rr + 3] * inv * silu_f(bfhi(gz.y))); *(u32x2*)(mp + 32 + d0) = w; } }
    }
}

struct DecRegs { f32x4 L[2][4]; f32x4 R; };
__device__ __forceinline__ void dec_load(const CAS KArgs& a, unsigned char* ws, int l, int b, int sp, int j, int tid, DecRegs& d) {
    if (j < 16) {
        const int page = ((const int*)a.in[I_PT])[b * NPAGES + 8 * sp + (j >> 1)]; const int key0 = (j & 1) * 64;
        const float* lat = a.in[I_CLAT] + ((size_t)(l * NPHYS + page) * PAGE + key0) * 256; const float* rp = a.in[I_CROPE] + ((size_t)(l * NPHYS + page) * PAGE + key0) * 32;
#pragma unroll
        for (int g2 = 0; g2 < 2; ++g2) { const int gi = tid + 512 * g2, kq = gi >> 6, dq = gi & 63;
#pragma unroll
            for (int i = 0; i < 4; ++i) d.L[g2][i] = __builtin_nontemporal_load((const f32x4*)(lat + (size_t)(4 * kq + i) * 256 + 4 * dq)); }
        d.R = __builtin_nontemporal_load((const f32x4*)(rp + (size_t)(tid >> 3) * 32 + 4 * (tid & 7)));
    } else {
        const bf16* ck = WSP(bf16, WS_CKVN) + (size_t)(NP + 4 * b) * 256; const bf16* kr = WSP(bf16, WS_KROPE) + (size_t)(NP + 4 * b) * 32;
#pragma unroll
        for (int g2 = 0; g2 < 2; ++g2) { const int gi = tid + 512 * g2, kq = gi >> 6, dq = gi & 63;
#pragma unroll
            for (int i = 0; i < 4; ++i) { f32x4 v = (f32x4){0.f, 0.f, 0.f, 0.f}; if (kq == 0) { const u32x2 w = *(const u32x2*)(ck + i * 256 + 4 * dq); v = (f32x4){bflo(w.x), bfhi(w.x), bflo(w.y), bfhi(w.y)}; } d.L[g2][i] = v; } }
        f32x4 v = (f32x4){0.f, 0.f, 0.f, 0.f}; if ((tid >> 3) < 4) { const u32x2 w = *(const u32x2*)(kr + (tid >> 3) * 32 + 4 * (tid & 7)); v = (f32x4){bflo(w.x), bfhi(w.x), bflo(w.y), bfhi(w.y)}; } d.R = v;
    }
}
__device__ __forceinline__ void decode_unit(int l, int unit, unsigned char* lds, int tid) { ENTER();
    const int sp = unit & 15, b = unit >> 4, r32 = lane & 31, hh = lane >> 5;
    bf16* Qs = (bf16*)lds; bf16* Ks = (bf16*)(lds + 18944); bf16* VTs = (bf16*)(lds + 56832);
    {
        const int row = tid >> 4, t = row >> 3, hq = row & 7, c0 = (tid & 15) * 16;
        const bf16* src = WSP(bf16, WS_QLAT) + (size_t)(4 * b + t) * 2048 + hq * 256 + c0;
#pragma unroll
        for (int i = 0; i < 2; ++i) { const u32x4 w = *(const u32x4*)(src + 8 * i); u32x4 o;
            o.x = pk2(bflo(w.x) * ATT_SC, bfhi(w.x) * ATT_SC); o.y = pk2(bflo(w.y) * ATT_SC, bfhi(w.y) * ATT_SC); o.z = pk2(bflo(w.z) * ATT_SC, bfhi(w.z) * ATT_SC); o.w = pk2(bflo(w.w) * ATT_SC, bfhi(w.w) * ATT_SC);
            *(u32x4*)(Qs + row * 296 + c0 + 8 * i) = o; }
        const int i = tid & 15, tr = NP + 4 * b + t; const bf16* qr = WSP(bf16, WS_Q) + (size_t)tr * 768 + hq * 96 + 64; const float* RC = WSP(float, WS_ROPECS) + (size_t)tr * 32;
        const float x1 = bf2f(qr[i]), x2 = bf2f(qr[16 + i]), c = RC[i], s = RC[16 + i];
        Qs[row * 296 + 256 + i] = f2bf((x1 * c - x2 * s) * ATT_SC); Qs[row * 296 + 272 + i] = f2bf((x2 * c + x1 * s) * ATT_SC);
    }
    __syncthreads();
    bf16x8 qf[18];
#pragma unroll
    for (int ks = 0; ks < 18; ++ks) qf[ks] = *(const bf16x8*)(Qs + r32 * 296 + 16 * ks + 8 * hh);
    f32x16 oacc;
#pragma unroll
    for (int r = 0; r < 16; ++r) oacc[r] = 0.f;
    float m = -1e30f, lsum = 0.f;
    const int nt = 16 + (sp == 15 ? 1 : 0);
    DecRegs d; dec_load(a, ws, l, b, sp, 0, tid, d);
    for (int j = 0; j < nt; ++j) {
        __syncthreads();
#pragma unroll
        for (int g2 = 0; g2 < 2; ++g2) { const int gi = tid + 512 * g2, kq = gi >> 6, dq = gi & 63;
#pragma unroll
            for (int i = 0; i < 4; ++i) { u32x2 w; w.x = pk2(d.L[g2][i].x, d.L[g2][i].y); w.y = pk2(d.L[g2][i].z, d.L[g2][i].w); *(u32x2*)(Ks + (4 * kq + i) * 296 + 4 * dq) = w; }
            { u32x2 w; w.x = pk2(d.L[g2][0].x, d.L[g2][1].x); w.y = pk2(d.L[g2][2].x, d.L[g2][3].x); *(u32x2*)(VTs + (4 * dq + 0) * 72 + 4 * kq) = w; }
            { u32x2 w; w.x = pk2(d.L[g2][0].y, d.L[g2][1].y); w.y = pk2(d.L[g2][2].y, d.L[g2][3].y); *(u32x2*)(VTs + (4 * dq + 1) * 72 + 4 * kq) = w; }
            { u32x2 w; w.x = pk2(d.L[g2][0].z, d.L[g2][1].z); w.y = pk2(d.L[g2][2].z, d.L[g2][3].z); *(u32x2*)(VTs + (4 * dq + 2) * 72 + 4 * kq) = w; }
            { u32x2 w; w.x = pk2(d.L[g2][0].w, d.L[g2][1].w); w.y = pk2(d.L[g2][2].w, d.L[g2][3].w); *(u32x2*)(VTs + (4 * dq + 3) * 72 + 4 * kq) = w; } }
        { u32x2 w; w.x = pk2(d.R.x, d.R.y); w.y = pk2(d.R.z, d.R.w); *(u32x2*)(Ks + (tid >> 3) * 296 + 256 + 4 * (tid & 7)) = w; }
        if (j + 1 < nt) dec_load(a, ws, l, b, sp, j + 1, tid, d);
        __syncthreads();
        f32x16 s0, s1;
#pragma unroll
        for (int r = 0; r < 16; ++r) { s0[r] = 0.f; s1[r] = 0.f; }
#pragma unroll
        for (int ks = 0; ks < 18; ++ks) { const bf16x8 a0 = *(const bf16x8*)(Ks + r32 * 296 + 16 * ks + 8 * hh), a1 = *(const bf16x8*)(Ks + (32 + r32) * 296 + 16 * ks + 8 * hh);
            s0 = mfma32(a0, qf[ks], s0); s1 = mfma32(a1, qf[ks], s1); }
        if (j == 16) { const int tq = r32 >> 3;
#pragma unroll
            for (int r = 0; r < 16; ++r) { const int kl = (r & 3) + 8 * (r >> 2) + 4 * hh; if (!(kl < 4 && kl <= tq)) s0[r] = -1e30f; s1[r] = -1e30f; } }
        float mx = s0[0];
#pragma unroll
        for (int r = 1; r < 16; ++r) mx = fmaxf(mx, s0[r]);
#pragma unroll
        for (int r = 0; r < 16; ++r) mx = fmaxf(mx, s1[r]);
        mx = fmaxf(mx, __shfl_xor(mx, 32));
        const float mn = fmaxf(m, mx), alpha = __builtin_amdgcn_exp2f(m - mn); m = mn;
        float ps = 0.f;
#pragma unroll
        for (int r = 0; r < 16; ++r) { s0[r] = __builtin_amdgcn_exp2f(s0[r] - mn); s1[r] = __builtin_amdgcn_exp2f(s1[r] - mn); ps += s0[r] + s1[r]; }
        ps += __shfl_xor(ps, 32); lsum = lsum * alpha + ps;
#pragma unroll
        for (int r = 0; r < 16; ++r) oacc[r] *= alpha;
        bf16x8 pf[4];
#pragma unroll
        for (int s2 = 0; s2 < 2; ++s2) { u32x4 w;
            w.x = pk2(s0[8 * s2], s0[8 * s2 + 1]); w.y = pk2(s0[8 * s2 + 2], s0[8 * s2 + 3]); w.z = pk2(s0[8 * s2 + 4], s0[8 * s2 + 5]); w.w = pk2(s0[8 * s2 + 6], s0[8 * s2 + 7]); pf[s2] = __builtin_bit_cast(bf16x8, w);
            w.x = pk2(s1[8 * s2], s1[8 * s2 + 1]); w.y = pk2(s1[8 * s2 + 2], s1[8 * s2 + 3]); w.z = pk2(s1[8 * s2 + 4], s1[8 * s2 + 5]); w.w = pk2(s1[8 * s2 + 6], s1[8 * s2 + 7]); pf[2 + s2] = __builtin_bit_cast(bf16x8, w); }
#pragma unroll
        for (int kk = 0; kk < 4; ++kk) { const bf16* vp = VTs + (32 * wave + r32) * 72 + 16 * kk + 4 * hh; const bf16x4 lo = *(const bf16x4*)vp, hi = *(const bf16x4*)(vp + 8);
            oacc = mfma32((bf16x8){lo[0], lo[1], lo[2], lo[3], hi[0], hi[1], hi[2], hi[3]}, pf[kk], oacc); }
    }
    float* po = WSP(float, WS_PARTO) + ((size_t)(b * 16 + sp) * 32 + r32) * 256 + 32 * wave + 4 * hh;
#pragma unroll
    for (int rr = 0; rr < 4; ++rr) *(f32x4*)(po + 8 * rr) = (f32x4){oacc[4 * rr], oacc[4 * rr + 1], oacc[4 * rr + 2], oacc[4 * rr + 3]};
    if (wave == 0 && hh == 0) { float* pm = WSP(float, WS_PARTML) + ((size_t)(b * 16 + sp) * 32 + r32) * 2; pm[0] = m; pm[1] = lsum; }
}
__device__ __forceinline__ void combine_unit(int l, int b, unsigned char* lds, int tid) { ENTER();
    float* olat = (float*)lds; float* wts = olat + 8192;
    const float* PO = WSP(float, WS_PARTO) + (size_t)b * 16 * 32 * 256; const float* PM = WSP(float, WS_PARTML) + (size_t)b * 16 * 32 * 2;
    if (tid < 32) { float M = -1e30f;
        for (int sp = 0; sp < 16; ++sp) M = fmaxf(M, PM[(sp * 32 + tid) * 2]);
        float L = 0.f;
        for (int sp = 0; sp < 16; ++sp) { const float w = __builtin_amdgcn_exp2f(PM[(sp * 32 + tid) * 2] - M); L += PM[(sp * 32 + tid) * 2 + 1] * w; wts[tid * 16 + sp] = w; }
        const float il = 1.f / L;
        for (int sp = 0; sp < 16; ++sp) wts[tid * 16 + sp] *= il; }
    __syncthreads();
    { const int d = tid & 255, qh = tid >> 8;
        for (int qi = 0; qi < 16; ++qi) { const int q = 16 * qh + qi; float acc = 0.f;
#pragma unroll
            for (int sp = 0; sp < 16; ++sp) acc += PO[((size_t)sp * 32 + q) * 256 + d] * wts[q * 16 + sp];
            olat[q * 256 + d] = acc; } }
    __syncthreads();
    { const int dv = tid & 63, rq = tid >> 6;
#pragma unroll
        for (int j = 0; j < 4; ++j) { const int row = rq + 8 * j, t = row >> 3, hq = row & 7; const float* wv = a.in[I_WUV] + (size_t)l * 256 * 512 + hq * 64 + dv; float acc = 0.f;
#pragma unroll 8
            for (int r = 0; r < 256; ++r) acc += olat[row * 256 + r] * wv[(size_t)r * 512];
            const int tr = NP + 4 * b + t; const float gz = bf2f(WSP(bf16, WS_PROJ)[(size_t)tr * INWP + O_GATE + hq * 64 + dv]);
            WSP(bf16, WS_MIX)[(size_t)tr * MIXW + 1024 + hq * 64 + dv] = f2bf(acc * silu_f(gz)); } }
}


__device__ __forceinline__ void tiny_out_unit(int l, int tile, unsigned char* lds, int tid) { ENTER();
    __syncthreads();
    const bf16* WoT = WSP(bf16, WS_WOUT) + (size_t)l * DM * MIXW;
    const int r0 = NP + 16 * (tile >> 5), c0 = 32 * (tile & 31), q4 = lane >> 4, l15 = lane & 15;
    const bf16* ap = WSP(bf16, WS_MIX) + (size_t)(r0 + l15) * MIXW + 256 * wave + 8 * q4; const bf16* bp = WoT + (size_t)(c0 + l15) * MIXW + 256 * wave + 8 * q4;
    f32x4 acc0 = (f32x4){0.f, 0.f, 0.f, 0.f}, acc1 = acc0;
#pragma unroll
    for (int ks = 0; ks < 8; ++ks) { const bf16x8 af = *(const bf16x8*)(ap + 32 * ks); acc0 = mfma16(af, *(const bf16x8*)(bp + 32 * ks), acc0); acc1 = mfma16(af, *(const bf16x8*)(bp + (size_t)16 * MIXW + 32 * ks), acc1); }
    float* part = (float*)lds;
#pragma unroll
    for (int r = 0; r < 4; ++r) { part[(wave * 16 + 4 * q4 + r) * 32 + l15] = acc0[r]; part[(wave * 16 + 4 * q4 + r) * 32 + 16 + l15] = acc1[r]; }
    __syncthreads();
    const int row = tid >> 5, col = tid & 31; float s = 0.f;
#pragma unroll
    for (int w = 0; w < 8; ++w) s += part[(w * 16 + row) * 32 + col];
    const size_t o = (size_t)(r0 + row) * DM + c0 + col; WSP(float, WS_Y)[o] = s + ALPHA * WSP(float, WS_XF)[o];
}
__device__ __forceinline__ void ln_phase(int l, int tid, int bid, int G) { ENTER();
    const float* lg = a.in[I_LNG] + l * DM; const float* lb = a.in[I_LNB] + l * DM;
    for (int m = bid * NWAVES + wave; m < MT; m += G * NWAVES) {
        const float* yr = WSP(float, WS_Y) + (size_t)m * DM;
        if (l == 0) ln_row(yr, lg, lb, WSP(float, WS_XF) + (size_t)m * DM, WSP(bf16, WS_XN) + (size_t)m * DM, lane);
        else ln_row(yr, lg, lb, (m < NP) ? a.out + OUT_YP + (size_t)m * DM : a.out + OUT_YS + (size_t)(m - NP) * DM, nullptr, lane);
    }
}

constexpr int NPH = 15;
#ifndef PHM
#define PHM 0xFFFF
#endif
#ifndef UM
#define UM 0xFFFF
#endif
__global__ void __launch_bounds__(NTHR, 2) hymba_fwd(KArgs a_unused) {
    extern __shared__ __attribute__((aligned(16))) unsigned char lds[];
    const int tid = threadIdx.x, lane = tid & 63, wave = __builtin_amdgcn_readfirstlane(tid >> 6), bid = blockIdx.x, G = gridDim.x;
    const CAS KArgs* kp_ = (const CAS KArgs*)__builtin_amdgcn_kernarg_segment_ptr(); const CAS KArgs& a = *kp_; unsigned char* ws = a.ws;
#define FRESH() asm volatile("" : "+s"(ws))
    volatile unsigned* MISC = (volatile unsigned*)(lds + MISC_OFF);
    if (tid < 64) MISC[tid] = 0u;
    __syncthreads();
    unsigned* ctl = (unsigned*)(a.ws + WS_CTL);
    const int lo = a.ph_lo, hi = a.ph_hi;
    XcdBarrier bar; bar.bar = ctl + CW_BAR; bar.x = 0; bar.st = nullptr;
    if (hi - lo > 1) bar = xcd_barrier_post(ctl + CW_BAR, (volatile LAS unsigned*)(lds + MISC_OFF + 32));
    volatile unsigned* slot = MISC + 16;
#define IN(k) (lo <= (k) && (k) < hi)
#define SEAM(k) do { if (IN(k) && IN((k) + 1)) xcd_barrier(bar); } while (0)
    if (IN(0) && (PHM & 1)) { ph_prologue(lds, tid, bid, G); }
    SEAM(0);
    for (int l = 0; l < 2; ++l) {
        const int P = 1 + 7 * l;
        if (IN(P) && (PHM & 2)) { FRESH();
            pg8::Gemm g{WSP(bf16, WS_XN), WSP(bf16, WS_WIN) + (size_t)l * INWP * DM, MP, INWP, DM, DM, DM}; pg8::StaticOrder S; S.init(MP, INWP, G, bid);
            pg8::EpiBf16 E{WSP(bf16, WS_PROJ), INWP, 0};
            pg8::gemm_phase<pg8::EpiBf16, pg8::StaticOrder, true, true>((PG8_LAS unsigned char*)lds, g, S, E);
        }
        SEAM(P);
        if (IN(P + 1) && (PHM & 4)) {
            unsigned* ctr = ctl + CW_Q + 64 * (2 * l);
            for (;;) { int u = q_next(ctr, slot, tid);
                if (u < 256) { if (UM & 1) ssd_s1_unit(l, u, lds, tid); continue; } u -= 256;
                if (u < 1024) { if (UM & 2) gdn_prep_unit(l, u, lds, tid); continue; } u -= 1024;
                if (u < 64) { if (UM & 4) ssd_sample_unit(l, u, lds, tid); continue; } u -= 64;
                if (u < 128) { if (UM & 8) gdn_sample_unit(l, u, lds, tid); continue; } u -= 128;
                if (u < 258) { if (UM & 16) e1_unit(l, u, tid); continue; }
                break; }
        }
        SEAM(P + 1);
        if (IN(P + 2) && (PHM & 8)) { FRESH();
            { pg8::Gemm g{WSP(bf16, WS_CQN), WSP(bf16, WS_WUQ) + (size_t)l * 768 * 384, MP, 768, 384, 384, 384}; pg8::StaticOrder S; S.init(MP, 768, G, bid);
              pg8::EpiBf16 E{WSP(bf16, WS_Q), 768, 0}; pg8::gemm_phase<pg8::EpiBf16, pg8::StaticOrder, true, true>((PG8_LAS unsigned char*)lds, g, S, E); }
            { pg8::Gemm g{WSP(bf16, WS_CKVN), WSP(bf16, WS_WUK) + (size_t)l * 512 * 256, NP, 512, 256, 256, 256}; pg8::StaticOrder S; S.init(NP, 512, G, (bid + G - 195 % G) % G);
              pg8::EpiBf16 E{WSP(bf16, WS_KK), 768, 1}; pg8::gemm_phase<pg8::EpiBf16, pg8::StaticOrder, true, true>((PG8_LAS unsigned char*)lds, g, S, E); }
            { pg8::Gemm g{WSP(bf16, WS_WUV) + (size_t)l * 512 * 256, WSP(bf16, WS_CKVN), 512, NP, 256, 256, 256}; pg8::StaticOrder S; S.init(512, NP, G, (bid + G - 67 % G) % G);
              pg8::EpiBf16 E{WSP(bf16, WS_VT), NP, 0}; pg8::gemm_phase<pg8::EpiBf16, pg8::StaticOrder, true, true>((PG8_LAS unsigned char*)lds, g, S, E); }
            { pg8::Gemm g{WSP(bf16, WS_CQN) + (size_t)NP * 384, WSP(bf16, WS_WABS) + (size_t)l * 2048 * 384, 256, 2048, 384, 384, 384}; pg8::StaticOrder S; S.init(256, 2048, G, (bid + G - 195 % G) % G);
              pg8::EpiBf16 E{WSP(bf16, WS_QLAT), 2048, 0}; pg8::gemm_phase<pg8::EpiBf16, pg8::StaticOrder, true, true>((PG8_LAS unsigned char*)lds, g, S, E); }
        }
        SEAM(P + 2);
        if (IN(P + 3) && (PHM & 16)) {
            unsigned* ctr = ctl + CW_Q + 64 * (2 * l + 1);
            for (;;) { int u = q_next(ctr, slot, tid);
                if (u < 32) { if (UM & 32) gdn_chain_unit(l, u, lds, tid); continue; } u -= 32;
                if (u < 128) { if (UM & 64) ssd_chain_unit(l, u, lds, tid); continue; } u -= 128;
                if (u < 1024) { if (u & 1) { if (UM & 128) decode_unit(l, u >> 1, lds, tid); } else if (UM & 256) attn_unit(l, u >> 1, lds, tid); continue; }
                break; }
        }
        SEAM(P + 3);
        if (IN(P + 4) && (PHM & 32)) {
            for (int u = bid; u < 288; u += G) { if (u < 32) { __syncthreads(); combine_unit(l, u, lds, tid); } else ssd_final_unit(l, u - 32, tid); }
        }
        SEAM(P + 4);
        if (IN(P + 5) && (PHM & 64)) { FRESH();
            const bf16* WoT = WSP(bf16, WS_WOUT) + (size_t)l * DM * MIXW;
            { pg8::Gemm g{WSP(bf16, WS_MIX), WoT, NP, DM, MIXW, MIXW, MIXW}; pg8::StaticOrder S; S.init(NP, DM, G, bid);
              pg8::EpiF32Res E{WSP(float, WS_Y), WSP(float, WS_XF), DM, ALPHA}; pg8::gemm_phase<pg8::EpiF32Res, pg8::StaticOrder, false, true>((PG8_LAS unsigned char*)lds, g, S, E); }
            for (int tile = bid; tile < 256; tile += G) tiny_out_unit(l, tile, lds, tid);
        }
        SEAM(P + 5);
        if (IN(P + 6) && (PHM & 128)) { FRESH();
            ln_phase(l, tid, bid, G);
        }
        if (l == 0) SEAM(P + 6);
    }
#undef IN
#undef SEAM
}

#ifndef MK_ONE_LAUNCH
#define MK_ONE_LAUNCH 1
#endif
extern "C" void kernel_launch(void* const* d_in, const int* in_sizes, int n_in, void* d_out, int out_size, void* d_ws, size_t ws_size, hipStream_t stream) {
    static int grid = 0;
    if (grid == 0) {
        if (n_in != N_IN || (size_t)out_size != OUT_END || ws_size < WS_END) { fprintf(stderr, "kernel_launch: unexpected shapes: n_in %d out %d ws %zu\n", n_in, out_size, ws_size); grid = -1; return; }
        int dev = 0, cus = 0;
        if (hipGetDevice(&dev) != hipSuccess || hipDeviceGetAttribute(&cus, hipDeviceAttributeMultiprocessorCount, dev) != hipSuccess) { grid = -1; return; }
        if (hipFuncSetAttribute((const void*)hymba_fwd, hipFuncAttributeMaxDynamicSharedMemorySize, LDS_BYTES) != hipSuccess) { fprintf(stderr, "kernel_launch: hipFuncSetAttribute failed\n"); grid = -1; return; }
        int per_cu = 0; (void)hipOccupancyMaxActiveBlocksPerMultiprocessor(&per_cu, (const void*)hymba_fwd, NTHR, LDS_BYTES); (void)hipGetLastError();
        grid = cus > 256 ? 256 : cus;
    }
    if (grid < 0) return;
    (void)hipMemsetAsync((char*)d_ws + WS_CTL, 0, CTL_ZERO_BYTES, stream);
    KArgs a{};
    for (int i = 0; i < N_IN; ++i) a.in[i] = (const float*)d_in[i];
    a.out = (float*)d_out; a.ws = (unsigned char*)d_ws;
#if MK_ONE_LAUNCH
    a.ph_lo = 0; a.ph_hi = NPH;
    hipLaunchKernelGGL(hymba_fwd, dim3(grid), dim3(NTHR), LDS_BYTES, stream, a);
#else
    for (int p = 0; p < NPH; ++p) { a.ph_lo = p; a.ph_hi = p + 1; hipLaunchKernelGGL(hymba_fwd, dim3(grid), dim3(NTHR), LDS_BYTES, stream, a); }
#endif
}
```

```cpp
#include <hip/hip_runtime.h>
#include <cstdio>
#include <cstdint>

#define LAS __attribute__((address_space(3)))
#define GAS __attribute__((address_space(1)))
typedef unsigned short bf16;
typedef short bf16x8 __attribute__((ext_vector_type(8)));
typedef short bf16x4 __attribute__((ext_vector_type(4)));
typedef float f32x4 __attribute__((ext_vector_type(4)));
typedef float f32x2 __attribute__((ext_vector_type(2)));
typedef float f32x16 __attribute__((ext_vector_type(16)));
typedef unsigned u32x4 __attribute__((ext_vector_type(4)));
typedef unsigned u32x2 __attribute__((ext_vector_type(2)));

namespace pg8 {
#define PG8_LAS __attribute__((address_space(3)))
typedef unsigned short bf16_t;
constexpr int BM = 256, BK = 64, HALF = 128, HTB = HALF * BK * 2, STAGE_BYTES = 8 * HTB, NXCD = 8, WGM = 8;
__host__ __device__ __forceinline__ int lds_byte(int r, int c) { const int st = (r >> 4) * 2 + (c >> 5), rr = r & 15, cc = c & 31, ob = rr * 64 + cc * 2; return st * 1024 + (ob ^ (((ob >> 9) & 1) << 5)); }
__host__ __device__ __forceinline__ void stage_rc(int b, int& R, int& C) { const int st = b / 1024, sb = b % 1024, swz = sb ^ (((sb >> 9) & 1) << 5); R = (st >> 1) * 16 + swz / 64; C = (st & 1) * 32 + (swz % 64) / 2; }
__host__ __device__ __forceinline__ int perm32(int rho) { const int n = rho >> 4, i = rho & 15; return 8 * (i >> 2) + 4 * n + (i & 3); }
struct Unit { int pm, pn; };
struct Gemm { const bf16_t* A; const bf16_t* Bt; int M, N, K, lda, ldb; };
struct StaticOrder {
    int nM, nN, nwg, G, c;
    __host__ __device__ void init(int M, int N, int G_, int c_) { nM = M / BM; nN = N / BM; nwg = nM * nN; G = G_; c = c_; }
    __host__ __device__ bool next(int i, Unit& u) const {
        const long L = (long)i * G + c; if (L >= nwg) return false;
        int wgid = (int)L; { const int q = nwg / NXCD, r = nwg % NXCD, xcd = wgid % NXCD, off = wgid / NXCD; wgid = (xcd < r ? xcd * (q + 1) : r * (q + 1) + (xcd - r) * q) + off; }
        const int nig = WGM * nN, gid = wgid / nig, fm = gid * WGM, gsz = (nM - fm) < WGM ? (nM - fm) : WGM;
        u.pm = fm + ((wgid % nig) % gsz); u.pn = (wgid % nig) / gsz; return true;
    }
    __device__ __forceinline__ void a_ready(const Unit&) const {}
    __device__ __forceinline__ void done(const Unit&) const {}
};
__device__ __forceinline__ unsigned cvt_pk_bf16(float lo, float hi) { unsigned r; asm volatile("v_cvt_pk_bf16_f32 %0, %1, %2" : "=v"(r) : "v"(lo), "v"(hi)); return r; }
struct EpiBf16 {
    static constexpr bool PERM = true, AFTER_DRAIN = false;
    bf16_t* O; int ldc; int remap;
    __device__ __forceinline__ void operator()(const f32x4 (&acc)[2][2][4][2], const Unit& u, int wr, int wc, int fr, int fq) const {
        const int row0 = u.pm * BM + wr * 64 + fr, colb = u.pn * BM + wc * 32 + 8 * fq;
#pragma unroll
        for (int ai = 0; ai < 2; ++ai)
#pragma unroll
            for (int m = 0; m < 4; ++m) { bf16_t* rowp = O + (size_t)(row0 + ai * HALF + m * 16) * ldc;
#pragma unroll
                for (int bj = 0; bj < 2; ++bj) { int c = colb + bj * HALF; if (remap) c = (c >> 6) * 96 + (c & 63);
                    const f32x4 v0 = acc[ai][bj][m][0], v1 = acc[ai][bj][m][1];
                    u32x4 w; w.x = cvt_pk_bf16(v0[0], v0[1]); w.y = cvt_pk_bf16(v0[2], v0[3]); w.z = cvt_pk_bf16(v1[0], v1[1]); w.w = cvt_pk_bf16(v1[2], v1[3]);
                    *(u32x4*)(rowp + c) = w; } }
    }
};
struct EpiF32Res {
    static constexpr bool PERM = false, AFTER_DRAIN = false;
    float* Y; const float* X; int ldc; float alpha;
    __device__ __forceinline__ void operator()(const f32x4 (&acc)[2][2][4][2], const Unit& u, int wr, int wc, int fr, int fq) const {
        const int row0 = u.pm * BM + wr * 64 + fr, col0 = u.pn * BM + wc * 32 + 4 * fq;
#pragma unroll
        for (int ai = 0; ai < 2; ++ai)
#pragma unroll
            for (int m = 0; m < 4; ++m) { const size_t ro = (size_t)(row0 + ai * HALF + m * 16) * ldc + col0;
#pragma unroll
                for (int bj = 0; bj < 2; ++bj)
#pragma unroll
                    for (int n = 0; n < 2; ++n) { const f32x4 x = *(const f32x4*)(X + ro + bj * HALF + n * 16); *(f32x4*)(Y + ro + bj * HALF + n * 16) = acc[ai][bj][m][n] + x * alpha; } }
    }
};
template <class Epi, class Sched, bool ALIGN_EPI = false, bool SP2 = false>
__device__ __forceinline__ void gemm_phase(PG8_LAS unsigned char* lds, const Gemm g, const Sched& S, const Epi& E) {
    int tid_ = threadIdx.x; asm volatile("" : "+v"(tid_));
    const int tid = tid_, wid = __builtin_amdgcn_readfirstlane(tid >> 6), lane = tid & 63, wr = wid >> 2, wc = wid & 3, fr = lane & 15, fq = lane >> 4;
    const int K = g.K, nt = K / BK;
    unsigned voffA[2], voffB[2];
#pragma unroll
    for (int i = 0; i < 2; ++i) { int R, C; stage_rc(tid * 16 + i * 8192, R, C); const int Rb = Epi::PERM ? ((R & ~31) + perm32(R & 31)) : R;
        voffA[i] = (unsigned)(R * g.lda + C) * 2u; voffB[i] = (unsigned)(Rb * g.ldb + C) * 2u; }
    const size_t kstep = (size_t)(BK * 2);
    const size_t hstepA = (size_t)HALF * g.lda * 2, hstepB = (size_t)HALF * g.ldb * 2;
    const size_t tstepA = 2 * hstepA, tstepB = 2 * hstepB;
    const unsigned ldsw = (unsigned)wid * 1024u;
    const int aoff = lds_byte(wr * 64 + fr, fq * 8), boff = lds_byte(wc * 32 + fr, fq * 8);
#define PG8_SA(b, h) (((b) * 2 + (h)) * HTB)
#define PG8_SB(b, h) ((4 + (b) * 2 + (h)) * HTB)
#define PG8_STAGE(bufoff, gbase, voff) do { _Pragma("unroll") for (int _i = 0; _i < 2; ++_i) \
        __builtin_amdgcn_global_load_lds((const unsigned*)((const char*)(gbase) + (voff)[_i]), (PG8_LAS unsigned*)(lds + (bufoff) + ldsw + _i * 8192), 16, 0, 0); } while (0)
#define PG8_LDA(dst, b, h) do { _Pragma("unroll") for (int m = 0; m < 4; ++m) _Pragma("unroll") for (int k = 0; k < 2; ++k) dst[m][k] = *(const PG8_LAS bf16x8*)(lds + PG8_SA(b, h) + aoff + m * 2048 + k * 1024); } while (0)
#define PG8_LDB(dst, b, h) do { _Pragma("unroll") for (int n = 0; n < 2; ++n) _Pragma("unroll") for (int k = 0; k < 2; ++k) dst[n][k] = *(const PG8_LAS bf16x8*)(lds + PG8_SB(b, h) + boff + n * 2048 + k * 1024); } while (0)
#define PG8_MMA(ai, bj, At, Bt) do { __builtin_amdgcn_s_setprio(1); _Pragma("unroll") for (int m = 0; m < 4; ++m) _Pragma("unroll") for (int n = 0; n < 2; ++n) _Pragma("unroll") for (int k = 0; k < 2; ++k) \
        acc[ai][bj][m][n] = __builtin_amdgcn_mfma_f32_16x16x32_bf16(Bt[n][k], At[m][k], acc[ai][bj][m][n], 0, 0, 0); __builtin_amdgcn_s_setprio(0); } while (0)
#define PG8_WAIT_V(n) asm volatile("s_waitcnt vmcnt(" #n ")" ::: "memory")
#define PG8_WAIT_L(n) asm volatile("s_waitcnt lgkmcnt(" #n ")" ::: "memory")
#define PG8_BAR __builtin_amdgcn_s_barrier()
#define PG8_SCHED __builtin_amdgcn_sched_barrier(0)
    Unit cur, nxt; int ui = 0;
    if (!S.next(0, cur)) return;
    f32x4 acc[2][2][4][2];
#pragma unroll
    for (int a = 0; a < 2; ++a)
#pragma unroll
        for (int b = 0; b < 2; ++b)
#pragma unroll
            for (int m = 0; m < 4; ++m)
#pragma unroll
                for (int n = 0; n < 2; ++n) acc[a][b][m][n] = (f32x4){0.f, 0.f, 0.f, 0.f};
    bf16x8 At[4][2], B0[2][2], B1[2][2];
    const char* cA = (const char*)g.A + (size_t)cur.pm * tstepA; const char* cB = (const char*)g.Bt + (size_t)cur.pn * tstepB;
    S.a_ready(cur);
    if constexpr (SP2) {
        PG8_STAGE(PG8_SB(0, 0), cB, voffB); PG8_STAGE(PG8_SB(0, 1), cB + hstepB, voffB); PG8_STAGE(PG8_SA(0, 0), cA, voffA); PG8_STAGE(PG8_SA(0, 1), cA + hstepA, voffA);
        if (wr == 1) PG8_BAR;
        PG8_WAIT_V(2); PG8_BAR;
        PG8_STAGE(PG8_SB(1, 0), cB + kstep, voffB); PG8_STAGE(PG8_SA(1, 0), cA + kstep, voffA); PG8_STAGE(PG8_SB(1, 1), cB + hstepB + kstep, voffB);
        PG8_WAIT_V(6); PG8_BAR;
    } else {
        PG8_STAGE(PG8_SB(0, 0), cB, voffB); PG8_STAGE(PG8_SA(0, 0), cA, voffA); PG8_STAGE(PG8_SB(0, 1), cB + hstepB, voffB); PG8_STAGE(PG8_SA(0, 1), cA + hstepA, voffA);
        if (wr == 1) PG8_BAR;
        PG8_WAIT_V(4); PG8_BAR;
        PG8_STAGE(PG8_SB(1, 0), cB + kstep, voffB); PG8_STAGE(PG8_SA(1, 0), cA + kstep, voffA); PG8_STAGE(PG8_SB(1, 1), cB + hstepB + kstep, voffB);
        PG8_WAIT_V(6); PG8_BAR;
    }
    for (;;) {
        const bool has_next = S.next(ui + 1, nxt);
        const char* nA = has_next ? (const char*)g.A + (size_t)nxt.pm * tstepA : cA; const char* nB = has_next ? (const char*)g.Bt + (size_t)nxt.pn * tstepB : cB;
        for (int t = 0; t < nt; t += 2) {
            const bool last = (t == nt - 2);
            const char* a1 = cA + (size_t)(t + 1) * kstep;
            const char* a2 = last ? nA : cA + (size_t)(t + 2) * kstep; const char* b2 = last ? nB : cB + (size_t)(t + 2) * kstep;
            const char* a3 = a2 + kstep; const char* b3 = b2 + kstep;
            if (last && has_next) S.a_ready(nxt);
            if constexpr (SP2) {
            PG8_LDB(B0, 0, 0); PG8_LDB(B1, 0, 1); PG8_SCHED; PG8_LDA(At, 0, 0); PG8_STAGE(PG8_SA(1, 1), a1 + hstepA, voffA);
            PG8_WAIT_V(8); PG8_WAIT_L(0); PG8_BAR; PG8_MMA(0, 0, At, B0); PG8_MMA(0, 1, At, B1); PG8_BAR; PG8_SCHED;
            PG8_LDA(At, 0, 1); PG8_STAGE(PG8_SB(0, 0), b2, voffB); PG8_STAGE(PG8_SB(0, 1), b2 + hstepB, voffB); PG8_STAGE(PG8_SA(0, 0), a2, voffA);
            PG8_WAIT_V(8); PG8_WAIT_L(0); PG8_BAR; PG8_MMA(1, 0, At, B0); PG8_MMA(1, 1, At, B1); PG8_BAR; PG8_SCHED;
            PG8_LDB(B0, 1, 0); PG8_LDB(B1, 1, 1); PG8_SCHED; PG8_LDA(At, 1, 0); PG8_STAGE(PG8_SA(0, 1), a2 + hstepA, voffA);
            PG8_WAIT_V(8); PG8_WAIT_L(0); PG8_BAR; PG8_MMA(0, 0, At, B0); PG8_MMA(0, 1, At, B1); PG8_BAR; PG8_SCHED;
            PG8_LDA(At, 1, 1); PG8_STAGE(PG8_SB(1, 0), b3, voffB); PG8_STAGE(PG8_SB(1, 1), b3 + hstepB, voffB); PG8_STAGE(PG8_SA(1, 0), a3, voffA);
            PG8_WAIT_V(8); PG8_WAIT_L(0); PG8_BAR; PG8_MMA(1, 0, At, B0); PG8_MMA(1, 1, At, B1); PG8_BAR; PG8_SCHED;
            } else {
            PG8_LDB(B0, 0, 0); PG8_SCHED; PG8_LDA(At, 0, 0); PG8_STAGE(PG8_SA(1, 1), a1 + hstepA, voffA);
            PG8_WAIT_L(8); PG8_BAR; PG8_WAIT_L(0); PG8_MMA(0, 0, At, B0); PG8_BAR; PG8_SCHED;
            PG8_LDB(B1, 0, 1); PG8_STAGE(PG8_SB(0, 0), b2, voffB);
            PG8_BAR; PG8_WAIT_L(0); PG8_MMA(0, 1, At, B1); PG8_BAR;
            PG8_LDA(At, 0, 1); PG8_STAGE(PG8_SA(0, 0), a2, voffA);
            PG8_BAR; PG8_WAIT_L(0); PG8_MMA(1, 0, At, B0); PG8_BAR; PG8_SCHED;
            PG8_STAGE(PG8_SB(0, 1), b2 + hstepB, voffB);
            PG8_WAIT_V(6); PG8_BAR; PG8_MMA(1, 1, At, B1); PG8_BAR;
            PG8_LDB(B0, 1, 0); PG8_SCHED; PG8_LDA(At, 1, 0); PG8_STAGE(PG8_SA(0, 1), a2 + hstepA, voffA);
            PG8_WAIT_L(8); PG8_BAR; PG8_WAIT_L(0); PG8_MMA(0, 0, At, B0); PG8_BAR; PG8_SCHED;
            PG8_LDB(B1, 1, 1); PG8_STAGE(PG8_SB(1, 0), b3, voffB);
            PG8_BAR; PG8_WAIT_L(0); PG8_MMA(0, 1, At, B1); PG8_BAR;
            PG8_LDA(At, 1, 1); PG8_STAGE(PG8_SA(1, 0), a3, voffA);
            PG8_BAR; PG8_WAIT_L(0); PG8_MMA(1, 0, At, B0); PG8_BAR; PG8_SCHED;
            PG8_STAGE(PG8_SB(1, 1), b3 + hstepB, voffB);
            PG8_WAIT_V(6); PG8_BAR; PG8_MMA(1, 1, At, B1); PG8_BAR;
            }
        }
        if constexpr (ALIGN_EPI) { if (wr == 0) PG8_BAR; }
        if constexpr (!Epi::AFTER_DRAIN) { E(acc, cur, wr, wc, fr, fq); S.done(cur); }
        if (!has_next) break;
#pragma unroll
        for (int a = 0; a < 2; ++a)
#pragma unroll
            for (int b = 0; b < 2; ++b)
#pragma unroll
                for (int m = 0; m < 4; ++m)
#pragma unroll
                    for (int n = 0; n < 2; ++n) acc[a][b][m][n] = (f32x4){0.f, 0.f, 0.f, 0.f};
        cur = nxt; cA = nA; cB = nB; ++ui;
        if constexpr (ALIGN_EPI) { if (wr == 1) PG8_BAR; }
    }
    PG8_WAIT_V(0);
    if constexpr (!ALIGN_EPI) { if (wr == 0) PG8_BAR; }
    PG8_BAR;
    if constexpr (Epi::AFTER_DRAIN) { E.fused(acc, cur, wr, wc, fr, fq, lds, wid, lane); S.done(cur); }
#undef PG8_SA
#undef PG8_SB
#undef PG8_STAGE
#undef PG8_LDA
#undef PG8_LDB
#undef PG8_MMA
#undef PG8_WAIT_V
#undef PG8_WAIT_L
#undef PG8_BAR
#undef PG8_SCHED
}
}

constexpr int DM = 1024, NPB = 8, SEQ = 2048, NP = NPB * SEQ, NSB = 32, DSQ = 4, NS = NSB * DSQ, MT = NP + NS, MP = 16640;
constexpr int PASTL = 16384, PAGE = 128, NPAGES = 128, NPHYS = 5120;
constexpr int INW = 5816, INWP = 5888, MIXW = 2048;
constexpr int O_SSDZ = 0, O_XBC = 1024, O_DT = 2560, O_CQ = 2576, O_CKV = 2960, O_KR = 3216, O_GATE = 3248, O_GQKV = 3760, O_GZ = 5296, O_GB = 5808, O_GA = 5812;
constexpr float LN_EPS = 1e-5f, RMS_EPS = 1e-6f, L2_EPS = 1e-6f, ALPHA = 1.41421356237309515f;
constexpr float LOG2E = 1.4426950408889634f;
constexpr float ATT_SC = 0.10206207261596575f * LOG2E;
constexpr size_t OUT_YP = 0, OUT_YS = OUT_YP + 16777216, OUT_PLAT = OUT_YS + 131072, OUT_PROPE = OUT_PLAT + 8388608, OUT_PSC = OUT_PROPE + 1048576, OUT_PSSD = OUT_PSC + 73728,
                 OUT_PGC = OUT_PSSD + 2097152, OUT_PGDN = OUT_PGC + 73728, OUT_SLAT = OUT_PGDN + 1048576, OUT_SROPE = OUT_SLAT + 65536, OUT_SSC = OUT_SROPE + 8192,
                 OUT_SSSD = OUT_SSC + 294912, OUT_SGC = OUT_SSSD + 8388608, OUT_SGDN = OUT_SGC + 294912, OUT_END = OUT_SGDN + 4194304;
enum { I_XP = 0, I_XS, I_CLAT, I_CROPE, I_SSC, I_SSD, I_SGC, I_SGDN, I_PT, I_EG, I_EB, I_WIN, I_SCW, I_SCB, I_SDTB, I_SALOG, I_SD, I_SNW, I_QNW, I_WUQ, I_KVNW, I_WUK, I_WUV,
       I_GCW, I_GDTB, I_GALOG, I_GNW, I_WOUT, I_LNG, I_LNB, N_IN };
constexpr size_t MiB = 1u << 20;
constexpr size_t WS_CTL = 0, CTL_ZERO_BYTES = 1 * MiB;
constexpr size_t WS_WIN = 2 * MiB, WS_WOUT = 26 * MiB, WS_WUQ = 34 * MiB, WS_WUK = 36 * MiB, WS_WUV = 37 * MiB, WS_WABS = 38 * MiB, WS_ROPECS = 42 * MiB;
constexpr size_t WS_XF = 46 * MiB, WS_XN = 112 * MiB, WS_PROJ = 146 * MiB, WS_CQN = 334 * MiB, WS_CKVN = 347 * MiB, WS_KROPE = 356 * MiB, WS_Q = 358 * MiB, WS_KK = 383 * MiB;
constexpr size_t WS_VT = 407 * MiB, WS_QLAT = 423 * MiB, WS_CC = 424 * MiB, WS_ACUM = 432 * MiB, WS_YI = 433 * MiB, WS_HLOC = 497 * MiB, WS_YG = 561 * MiB, WS_SSQ = 593 * MiB;
constexpr size_t WS_GNW = 594 * MiB, WS_GQG = 610 * MiB, WS_GKDT = 626 * MiB, WS_GU = 642 * MiB, WS_GATT = 674 * MiB, WS_GEG = 682 * MiB, WS_PARTO = 683 * MiB, WS_PARTML = 699 * MiB;
constexpr size_t WS_MIX = 700 * MiB, WS_Y = 766 * MiB, WS_END = 832 * MiB;
static_assert(WS_WIN + (size_t)2 * INWP * DM * 2 <= WS_WOUT && WS_XF + (size_t)MT * DM * 4 <= WS_XN && WS_XN + (size_t)MP * DM * 2 <= WS_PROJ && WS_PROJ + (size_t)MP * INWP * 2 <= WS_CQN, "ws map");
static_assert(WS_CQN + (size_t)MP * 384 * 2 <= WS_CKVN && WS_CKVN + (size_t)MP * 256 * 2 <= WS_KROPE && WS_Q + (size_t)MP * 768 * 2 <= WS_KK && WS_MIX + (size_t)MP * MIXW * 2 <= WS_Y && WS_Y + (size_t)MT * DM * 4 <= WS_END, "ws map");
constexpr int CW_BAR = 4096;
constexpr int CW_Q = 16384;
constexpr int LDS_BYTES = 147456, MISC_OFF = 144 * 1024 - 256;
constexpr int NWAVES = 8, NTHR = 512;

#define LDS_WAIT() asm volatile("s_waitcnt lgkmcnt(0)" ::: "memory")
#define VM_WAIT() asm volatile("s_waitcnt vmcnt(0)" ::: "memory")
__device__ __forceinline__ float bflo(unsigned w) { return __uint_as_float(w << 16); }
__device__ __forceinline__ float bfhi(unsigned w) { return __uint_as_float(w & 0xffff0000u); }
__device__ __forceinline__ float bf2f(bf16 v) { return __uint_as_float((unsigned)v << 16); }
__device__ __forceinline__ unsigned pk2(float lo, float hi) { unsigned r; asm volatile("v_cvt_pk_bf16_f32 %0, %1, %2" : "=v"(r) : "v"(lo), "v"(hi)); return r; }
__device__ __forceinline__ bf16 f2bf(float f) { return (bf16)(pk2(f, 0.f) & 0xffffu); }
__device__ __forceinline__ float silu_f(float x) { return x / (1.f + __expf(-x)); }
__device__ __forceinline__ float sigmoid_f(float x) { return 1.f / (1.f + __expf(-x)); }
__device__ __forceinline__ float softplus_f(float x) { return x > 20.f ? x : log1pf(__expf(x)); }
__device__ __forceinline__ float wave_sum(float v) {
#pragma unroll
    for (int o = 1; o < 64; o <<= 1) v += __shfl_xor(v, o);
    return v;
}
__device__ __forceinline__ float wave_scan_incl(float v, int lane) {
#pragma unroll
    for (int o = 1; o < 64; o <<= 1) { const float t = __shfl_up(v, o); if (lane >= o) v += t; }
    return v;
}
__device__ __forceinline__ f32x4 mfma16(bf16x8 a, bf16x8 b, f32x4 c) { return __builtin_amdgcn_mfma_f32_16x16x32_bf16(a, b, c, 0, 0, 0); }
__device__ __forceinline__ f32x16 mfma32(bf16x8 a, bf16x8 b, f32x16 c) { return __builtin_amdgcn_mfma_f32_32x32x16_bf16(a, b, c, 0, 0, 0); }
__device__ __forceinline__ bf16x8 frag16(const bf16* base, int pitch, int row0, int k0, int lane) { return *(const bf16x8*)(base + (row0 + (lane & 15)) * pitch + k0 + 8 * (lane >> 4)); }
__device__ __forceinline__ bf16x8 frag16p(const bf16* base, int pitch, int row0, int k0, int lane) {
    const bf16* p = base + (row0 + (lane & 15)) * pitch + k0 + 4 * (lane >> 4);
    const bf16x4 lo = *(const bf16x4*)p, hi = *(const bf16x4*)(p + 16);
    return (bf16x8){lo[0], lo[1], lo[2], lo[3], hi[0], hi[1], hi[2], hi[3]};
}
__device__ __forceinline__ bf16x8 accpair(f32x4 a, f32x4 b) { u32x4 w; w.x = pk2(a[0], a[1]); w.y = pk2(a[2], a[3]); w.z = pk2(b[0], b[1]); w.w = pk2(b[2], b[3]); return __builtin_bit_cast(bf16x8, w); }

#define XB_TMO      128
#define XB_XCNT(j)  (256  + 64 * (j))
#define XB_XSUB(j)  (1280 + 64 * (j))
#define XB_XGEN(j)  (2304 + 64 * (j))
#define XB_TOP      3328
#define XB_TOPGEN   3392
#define XCD_BAR_WORDS 3456
#define XB_SPIN_CAP (1u << 18)

__device__ __forceinline__ unsigned xb_ld(unsigned* p)              { return __hip_atomic_load(p, __ATOMIC_RELAXED, __HIP_MEMORY_SCOPE_AGENT); }
__device__ __forceinline__ unsigned xb_add(unsigned* p, unsigned v) { return __hip_atomic_fetch_add(p, v, __ATOMIC_RELAXED, __HIP_MEMORY_SCOPE_AGENT); }
__device__ __forceinline__ unsigned xb_xcc_id() { return (unsigned)__builtin_amdgcn_s_getreg((3 << 11) | 20) & 0xFu; }
#define XB_SPIN(cond, bar) do { unsigned _sp = 0; while (cond) { __builtin_amdgcn_s_sleep(1); \
    if ((++_sp & 255u) == 0u) { if (xb_ld(&(bar)[XB_TMO])) break; if (_sp > XB_SPIN_CAP) { atomicAdd(&(bar)[XB_TMO], 1u); break; } } } } while (0)

struct XcdBarrier {
    unsigned* bar; unsigned x;
    volatile LAS unsigned* st;
};

__device__ __forceinline__ XcdBarrier xcd_barrier_post(unsigned* bar, volatile LAS unsigned* st) {
    XcdBarrier b; b.bar = bar; b.x = xb_xcc_id(); b.st = st;
    if (threadIdx.x == 0) (void)xb_add(&bar[XB_XCNT(b.x)], 1u);
    return b;
}
__device__ __forceinline__ void xcd_barrier_complete(unsigned* bar, unsigned x, unsigned& nloc, unsigned& nx) {
    const unsigned G = gridDim.x * gridDim.y * gridDim.z;
    unsigned sum, cnt, mine, sp = 0u;
    for (;;) {
        sum = 0u; cnt = 0u; mine = 0u;
#pragma unroll
        for (unsigned j = 0; j < 16; ++j) { const unsigned c = xb_ld(&bar[XB_XCNT(j)]); sum += c; cnt += (c > 0u) ? 1u : 0u; mine = (j == x) ? c : mine; }
        if (sum == G) break;
        __builtin_amdgcn_s_sleep(1);
        if ((++sp & 255u) == 0u) { if (xb_ld(&bar[XB_TMO])) break; if (sp > XB_SPIN_CAP) { atomicAdd(&bar[XB_TMO], 1u); break; } }
    }
    nloc = mine > 0u ? mine : 1u; nx = cnt > 0u ? cnt : 1u;
}

__device__ __forceinline__ void xcd_barrier(const XcdBarrier& b) {
    asm volatile("s_waitcnt vmcnt(0)" ::: "memory");
    __syncthreads();
    if (threadIdx.x == 0) {
        unsigned* bar = b.bar;
        __builtin_amdgcn_s_waitcnt(0);
        unsigned nloc = b.st[0], nx = b.st[1];
        if (nloc == 0u) { xcd_barrier_complete(bar, b.x, nloc, nx); b.st[0] = nloc; b.st[1] = nx; }
        const unsigned old = xb_add(&bar[XB_XSUB(b.x)], 1u);
        const unsigned gen = old / nloc;
        if (old + 1u == (gen + 1u) * nloc) {
            __builtin_amdgcn_fence(__ATOMIC_RELEASE, "agent");
            asm volatile("s_waitcnt vmcnt(0)" ::: "memory");
            const unsigned og = xb_add(&bar[XB_TOP], 1u);
            const unsigned tg = og / nx;
            if (og + 1u == (tg + 1u) * nx) xb_add(&bar[XB_TOPGEN], 1u);
            else XB_SPIN(xb_ld(&bar[XB_TOPGEN]) == tg, bar);
            __builtin_amdgcn_fence(__ATOMIC_ACQUIRE, "agent");
            xb_add(&bar[XB_XGEN(b.x)], 1u);
            asm volatile("s_waitcnt vmcnt(0)" ::: "memory");
        } else {
            XB_SPIN(xb_ld(&bar[XB_XGEN(b.x)]) == gen, bar);
            __builtin_amdgcn_fence(__ATOMIC_ACQUIRE, "agent");
            asm volatile("s_waitcnt vmcnt(0)" ::: "memory");
        }
    }
    __syncthreads();
}

struct KArgs { const float* in[N_IN]; float* out; unsigned char* ws; int ph_lo, ph_hi; };
#define WSP(T, off) ((T*)(ws + (off)))
#define CAS __attribute__((address_space(4)))
#define ENTER() const CAS KArgs* kp_ = (const CAS KArgs*)__builtin_amdgcn_kernarg_segment_ptr(); asm volatile("" : "+s"(kp_)); const CAS KArgs& a = *kp_; unsigned char* ws = a.ws; asm volatile("" : "+v"(tid)); const int lane = tid & 63, wave = __builtin_amdgcn_readfirstlane(tid >> 6); (void)lane; (void)wave

__device__ __forceinline__ int q_next(unsigned* ctr, volatile unsigned* slot, int tid) {
    __syncthreads();
    if (tid == 0) *slot = __hip_atomic_fetch_add(ctr, 1u, __ATOMIC_RELAXED, __HIP_MEMORY_SCOPE_AGENT);
    __syncthreads();
    return __builtin_amdgcn_readfirstlane((int)*slot);
}

__device__ __forceinline__ void tr_item(const float* W, int K, int N, int Npad, bf16* WT, float* scr, int item, int lane) {
    const int nblk = Npad / 32, kb = item / nblk, nb = item % nblk, k0 = 64 * kb, n0 = 32 * nb;
    const int n = n0 + (lane & 31);
#pragma unroll 8
    for (int i = 0; i < 32; ++i) { const int kk = 2 * i + (lane >> 5); scr[kk * 33 + (lane & 31)] = (n < N) ? W[(size_t)(k0 + kk) * N + n] : 0.f; }
    LDS_WAIT(); asm volatile("" ::: "memory");
    const int c = lane & 7;
#pragma unroll
    for (int j = 0; j < 4; ++j) { const int nn = (lane >> 3) + 8 * j; const float* s = scr + (8 * c) * 33 + nn;
        u32x4 o; o.x = pk2(s[0 * 33], s[1 * 33]); o.y = pk2(s[2 * 33], s[3 * 33]); o.z = pk2(s[4 * 33], s[5 * 33]); o.w = pk2(s[6 * 33], s[7 * 33]);
        *(u32x4*)(WT + (size_t)(n0 + nn) * K + k0 + 8 * c) = o; }
    LDS_WAIT(); asm volatile("" ::: "memory");
}
__device__ __forceinline__ void ln_row(const float* xrow, const float* g, const float* b, float* of32, bf16* obf, int lane) {
    f32x4 v[4]; float s = 0.f;
#pragma unroll
    for (int j = 0; j < 4; ++j) { v[j] = *(const f32x4*)(xrow + 4 * lane + 256 * j); s += (v[j].x + v[j].y) + (v[j].z + v[j].w); }
    const float mean = wave_sum(s) * (1.f / DM); float s2 = 0.f;
#pragma unroll
    for (int j = 0; j < 4; ++j) { v[j] = v[j] - mean; s2 += (v[j].x * v[j].x + v[j].y * v[j].y) + (v[j].z * v[j].z + v[j].w * v[j].w); }
    const float rstd = 1.f / sqrtf(wave_sum(s2) * (1.f / DM) + LN_EPS);
#pragma unroll
    for (int j = 0; j < 4; ++j) { const f32x4 gg = *(const f32x4*)(g + 4 * lane + 256 * j), bb = *(const f32x4*)(b + 4 * lane + 256 * j); const f32x4 o = v[j] * rstd * gg + bb;
        if (of32) *(f32x4*)(of32 + 4 * lane + 256 * j) = o;
        if (obf) { u32x2 w; w.x = pk2(o.x, o.y); w.y = pk2(o.z, o.w); *(u32x2*)(obf + 4 * lane + 256 * j) = w; } }
}
__device__ __forceinline__ void ph_prologue(unsigned char* lds, int tid, int bid, int G) { ENTER();
    float* scr = (float*)(lds + wave * 8448);
    const int gw = bid * NWAVES + wave, NGW = G * NWAVES, gt = bid * NTHR + tid, NGT = G * NTHR;
    constexpr int IT_IN = 16 * 184, IT_OUT = 32 * 32, IT_UQ = 6 * 24, IT_UK = 4 * 16, IT_L = IT_IN + IT_OUT + IT_UQ + 2 * IT_UK;
    for (int it = gw; it < 2 * IT_L; it += NGW) {
        const int l = it / IT_L; int r = it % IT_L;
        if (r < IT_IN) { tr_item(a.in[I_WIN] + (size_t)l * DM * INW, DM, INW, INWP, WSP(bf16, WS_WIN) + (size_t)l * INWP * DM, scr, r, lane); continue; } r -= IT_IN;
        if (r < IT_OUT) { tr_item(a.in[I_WOUT] + (size_t)l * MIXW * DM, MIXW, DM, DM, WSP(bf16, WS_WOUT) + (size_t)l * DM * MIXW, scr, r, lane); continue; } r -= IT_OUT;
        if (r < IT_UQ) { tr_item(a.in[I_WUQ] + (size_t)l * 384 * 768, 384, 768, 768, WSP(bf16, WS_WUQ) + (size_t)l * 768 * 384, scr, r, lane); continue; } r -= IT_UQ;
        if (r < IT_UK) { tr_item(a.in[I_WUK] + (size_t)l * 256 * 512, 256, 512, 512, WSP(bf16, WS_WUK) + (size_t)l * 512 * 256, scr, r, lane); continue; } r -= IT_UK;
        tr_item(a.in[I_WUV] + (size_t)l * 256 * 512, 256, 512, 512, WSP(bf16, WS_WUV) + (size_t)l * 512 * 256, scr, r, lane);
    }
    for (int e = gt; e < 2 * 2048 * 384; e += NGT) {
        const int k = e % 384, n = (e / 384) % 2048, l = e / (384 * 2048), h = n >> 8, r = n & 255;
        const float* pq = a.in[I_WUQ] + ((size_t)l * 384 + k) * 768 + h * 96; const float* pk = a.in[I_WUK] + ((size_t)l * 256 + r) * 512 + h * 64;
        float s = 0.f;
#pragma unroll 4
        for (int d = 0; d < 64; d += 4) { const f32x4 x = *(const f32x4*)(pq + d), y = *(const f32x4*)(pk + d); s += x.x * y.x + x.y * y.y + x.z * y.z + x.w * y.w; }
        WSP(bf16, WS_WABS)[e] = f2bf(s);
    }
    for (int e = gt; e < MT * 16; e += NGT) {
        const int i = e & 15, m = e >> 4; const int pos = (m < NP) ? (m & (SEQ - 1)) : (PASTL + ((m - NP) & 3));
        const float inv = powf(10000.f, -(float)i * (1.f / 16.f)); const float ang = (float)pos * inv;
        float sn, cs; sincosf(ang, &sn, &cs);
        WSP(float, WS_ROPECS)[m * 32 + i] = cs; WSP(float, WS_ROPECS)[m * 32 + 16 + i] = sn;
    }
    for (int m = gw; m < MT; m += NGW) {
        const float* xr = (m < NP) ? a.in[I_XP] + (size_t)m * DM : a.in[I_XS] + (size_t)(m - NP) * DM;
        ln_row(xr, a.in[I_EG], a.in[I_EB], WSP(float, WS_XF) + (size_t)m * DM, WSP(bf16, WS_XN) + (size_t)m * DM, lane);
    }
}

__device__ __forceinline__ void e1_unit(int l, int unit, int tid) { ENTER();
    const bf16* PROJ = WSP(bf16, WS_PROJ); const float* RC = WSP(float, WS_ROPECS);
    for (int i = 0; i < 8; ++i) {
        const int m = unit * 64 + wave * 8 + i;
        const bf16* pr = PROJ + (size_t)m * INWP;
        const bool samp = m >= NP; const int sb = samp ? (m - NP) >> 2 : m >> 11, st = samp ? (m - NP) & 3 : m & (SEQ - 1);
        {
            const unsigned w0 = *(const unsigned*)(pr + O_CQ + 2 * lane), w1 = *(const unsigned*)(pr + O_CQ + 128 + 2 * lane), w2 = *(const unsigned*)(pr + O_CQ + 256 + 2 * lane);
            const float x0 = bflo(w0), x1 = bfhi(w0), x2 = bflo(w1), x3 = bfhi(w1), x4 = bflo(w2), x5 = bfhi(w2);
            const float ss = wave_sum(x0 * x0 + x1 * x1 + x2 * x2 + x3 * x3 + x4 * x4 + x5 * x5);
            const float r = 1.f / sqrtf(ss * (1.f / 384.f) + RMS_EPS);
            const float* nw = a.in[I_QNW] + l * 384 + 2 * lane; bf16* o = WSP(bf16, WS_CQN) + (size_t)m * 384 + 2 * lane;
            *(unsigned*)(o) = pk2(x0 * r * nw[0], x1 * r * nw[1]); *(unsigned*)(o + 128) = pk2(x2 * r * nw[128], x3 * r * nw[129]); *(unsigned*)(o + 256) = pk2(x4 * r * nw[256], x5 * r * nw[257]);
        }
        {
            const u32x2 w = *(const u32x2*)(pr + O_CKV + 4 * lane);
            const float x0 = bflo(w.x), x1 = bfhi(w.x), x2 = bflo(w.y), x3 = bfhi(w.y);
            const float ss = wave_sum(x0 * x0 + x1 * x1 + x2 * x2 + x3 * x3);
            const float r = 1.f / sqrtf(ss * (1.f / 256.f) + RMS_EPS);
            const f32x4 nw = *(const f32x4*)(a.in[I_KVNW] + l * 256 + 4 * lane);
            const f32x4 v = (f32x4){x0 * r * nw.x, x1 * r * nw.y, x2 * r * nw.z, x3 * r * nw.w};
            float* o = samp ? a.out + OUT_SLAT + ((size_t)l * NS + (m - NP)) * 256 : a.out + OUT_PLAT + ((size_t)l * NP + m) * 256;
            *(f32x4*)(o + 4 * lane) = v;
            u32x2 ww; ww.x = pk2(v.x, v.y); ww.y = pk2(v.z, v.w); *(u32x2*)(WSP(bf16, WS_CKVN) + (size_t)m * 256 + 4 * lane) = ww;
        }
        if (lane < 16) {
            const float x1 = bf2f(pr[O_KR + lane]), x2 = bf2f(pr[O_KR + 16 + lane]);
            const float c = RC[m * 32 + lane], s = RC[m * 32 + 16 + lane];
            const float o1 = x1 * c - x2 * s, o2 = x2 * c + x1 * s;
            float* o = samp ? a.out + OUT_SROPE + ((size_t)l * NS + (m - NP)) * 32 : a.out + OUT_PROPE + ((size_t)l * NP + m) * 32;
            o[lane] = o1; o[16 + lane] = o2;
            const bf16 b1 = f2bf(o1), b2 = f2bf(o2);
            bf16* kr = WSP(bf16, WS_KROPE) + (size_t)m * 32; kr[lane] = b1; kr[16 + lane] = b2;
            if (!samp) { bf16* kk = WSP(bf16, WS_KK) + (size_t)m * 768 + 64;
#pragma unroll
                for (int h = 0; h < 8; ++h) { kk[h * 96 + lane] = b1; kk[h * 96 + 16 + lane] = b2; } }
        }
        const int T = samp ? DSQ : SEQ;
        if (st >= T - 3) {
            const int j = st - (T - 3);
            float* o1 = samp ? a.out + OUT_SSC + ((size_t)(l * NSB + sb) * 3 + j) * 1536 : a.out + OUT_PSC + ((size_t)(l * NPB + sb) * 3 + j) * 1536;
            float* o2 = samp ? a.out + OUT_SGC + ((size_t)(l * NSB + sb) * 3 + j) * 1536 : a.out + OUT_PGC + ((size_t)(l * NPB + sb) * 3 + j) * 1536;
            for (int c = 2 * lane; c < 1536; c += 128) {
                const unsigned w1 = *(const unsigned*)(pr + O_XBC + c), w2 = *(const unsigned*)(pr + O_GQKV + c);
                o1[c] = bflo(w1); o1[c + 1] = bfhi(w1); o2[c] = bflo(w2); o2[c + 1] = bfhi(w2); }
        }
    }
}

template <int NR, bool SILU_BIAS>
__device__ __forceinline__ void conv_pair(const bf16* colp  , int r0, bool first, const float* wp  , const float* bp  , f32x2 (&y)[NR]) {
    f32x2 w[4];
#pragma unroll
    for (int j = 0; j < 4; ++j) w[j] = (f32x2){wp[j * 1536], wp[j * 1536 + 1]};
    const f32x2 bias = bp ? (f32x2){bp[0], bp[1]} : (f32x2){0.f, 0.f};
    f32x2 h[3];
#pragma unroll
    for (int j = 0; j < 3; ++j) { const int r = r0 - 3 + j; unsigned v = 0u; if (!(first && r < 0)) v = *(const unsigned*)(colp + (long)r * INWP); h[j] = (f32x2){bflo(v), bfhi(v)}; }
#pragma unroll
    for (int i = 0; i < NR; ++i) {
        const unsigned v = *(const unsigned*)(colp + (long)(r0 + i) * INWP); const f32x2 cur = (f32x2){bflo(v), bfhi(v)};
        f32x2 s = w[0] * h[0] + w[1] * h[1] + w[2] * h[2] + w[3] * cur + bias;
        y[i] = (f32x2){silu_f(s.x), silu_f(s.y)};
        h[0] = h[1]; h[1] = h[2]; h[2] = cur;
    }
}

__device__ __forceinline__ void ssd_s1_unit(int l, int unit, unsigned char* lds, int tid) { ENTER();
    const int g = unit & 1, c = (unit >> 1) & 15, b = unit >> 5, tok0 = b * SEQ + c * 128, q4 = lane >> 4, l15 = lane & 15;
    constexpr int PB = 136;
    const bf16* PROJ = WSP(bf16, WS_PROJ);
    bf16* Bs = (bf16*)lds; bf16* Cs = (bf16*)(lds + 34816); bf16* BT = (bf16*)(lds + 69632);
    bf16* Sc = (bf16*)lds; bf16* XT = (bf16*)(lds + 34816); bf16* XTw = (bf16*)(lds + 52224);
    float* dts = (float*)(lds + 104448); float* acs = dts + 1024; float* wds = acs + 1024; float* rds = wds + 1024;
    const float* cw = a.in[I_SCW] + (size_t)l * 4 * 1536; const float* cb = a.in[I_SCB] + (size_t)l * 1536;
    {
        const int h = 8 * g + wave; const float dtb = a.in[I_SDTB][l * 16 + h], A = -__expf(a.in[I_SALOG][l * 16 + h]);
        const float r0 = bf2f(PROJ[(size_t)(tok0 + 2 * lane) * INWP + O_DT + h]), r1 = bf2f(PROJ[(size_t)(tok0 + 2 * lane + 1) * INWP + O_DT + h]);
        const float d0 = softplus_f(r0 + dtb), d1 = softplus_f(r1 + dtb), a0 = d0 * A, a1 = d1 * A;
        const float incl = wave_scan_incl(a0 + a1, lane), last = __shfl(incl, 63), ac0 = incl - a1, ac1 = incl;
        const int o = wave * 128 + 2 * lane;
        dts[o] = d0; dts[o + 1] = d1; acs[o] = ac0; acs[o + 1] = ac1; wds[o] = __expf(last - ac0); wds[o + 1] = __expf(last - ac1); rds[o] = 1.f / d0; rds[o + 1] = 1.f / d1;
        float* ACUM = WSP(float, WS_ACUM); ACUM[(size_t)(tok0 + 2 * lane) * 16 + h] = ac0; ACUM[(size_t)(tok0 + 2 * lane + 1) * 16 + h] = ac1;
    }
    {
        const int cp = 2 * lane, r0 = 16 * wave;
        f32x2 y[16];
        const int chB = 1024 + g * 128 + cp;
        conv_pair<16, true>(PROJ + (size_t)tok0 * INWP + O_XBC + chB, r0, c == 0, cw + chB, cb + chB, y);
#pragma unroll
        for (int i = 0; i < 16; ++i) { const int s = r0 + i; *(unsigned*)(Bs + s * PB + cp) = pk2(y[i].x, y[i].y); BT[cp * PB + s] = f2bf(y[i].x); BT[(cp + 1) * PB + s] = f2bf(y[i].y); }
        const int chC = 1280 + g * 128 + cp;
        conv_pair<16, true>(PROJ + (size_t)tok0 * INWP + O_XBC + chC, r0, c == 0, cw + chC, cb + chC, y);
        bf16* CC = WSP(bf16, WS_CC);
#pragma unroll
        for (int i = 0; i < 16; ++i) { const int t = r0 + i; const unsigned w = pk2(y[i].x, y[i].y); *(unsigned*)(Cs + t * PB + cp) = w; *(unsigned*)(CC + (size_t)(tok0 + t) * 256 + g * 128 + cp) = w; }
    }
    __syncthreads();
    f32x4 gacc[8];
#pragma unroll
    for (int sb = 0; sb < 8; ++sb) { gacc[sb] = (f32x4){0.f, 0.f, 0.f, 0.f};
        if (sb <= wave) {
#pragma unroll
            for (int ks = 0; ks < 4; ++ks) gacc[sb] = mfma16(frag16(Bs, PB, 16 * sb, 32 * ks, lane), frag16(Cs, PB, 16 * wave, 32 * ks, lane), gacc[sb]); } }
    __syncthreads();
    float* YI = WSP(float, WS_YI); float* HLOC = WSP(float, WS_HLOC);
    for (int hh = 0; hh < 8; ++hh) {
        const int h = 8 * g + hh; const float Dh = a.in[I_SD][l * 16 + h];
        {
            const int cp = 2 * (tid & 31), r0 = 8 * (tid >> 5), ch = h * 64 + cp;
            f32x2 y[8];
            conv_pair<8, true>(PROJ + (size_t)tok0 * INWP + O_XBC + ch, r0, c == 0, cw + ch, cb + ch, y);
#pragma unroll
            for (int i = 0; i < 8; ++i) { const int t = r0 + i; const float dt = dts[hh * 128 + t], wd = wds[hh * 128 + t]; const float x0 = y[i].x * dt, x1 = y[i].y * dt;
                XT[cp * PB + t] = f2bf(x0); XT[(cp + 1) * PB + t] = f2bf(x1); XTw[cp * PB + t] = f2bf(x0 * wd); XTw[(cp + 1) * PB + t] = f2bf(x1 * wd); }
        }
        {
            const int t = 16 * wave + l15; const float at = acs[hh * 128 + t];
#pragma unroll
            for (int sb = 0; sb < 8; ++sb) { const int s0 = 16 * sb + 4 * q4; float v[4];
#pragma unroll
                for (int r = 0; r < 4; ++r) { const float e = __expf(fminf(at - acs[hh * 128 + s0 + r], 0.f)); v[r] = (sb <= wave && s0 + r <= t) ? gacc[sb][r] * e : 0.f; }
                u32x2 w; w.x = pk2(v[0], v[1]); w.y = pk2(v[2], v[3]); *(u32x2*)(Sc + t * PB + s0) = w; }
        }
        __syncthreads();
        {
            const int t = 16 * wave + l15; const float rd = rds[hh * 128 + t];
#pragma unroll
            for (int pb = 0; pb < 4; ++pb) { f32x4 acc = (f32x4){0.f, 0.f, 0.f, 0.f};
#pragma unroll
                for (int ks = 0; ks < 4; ++ks) if (2 * ks <= wave) acc = mfma16(frag16(XT, PB, 16 * pb, 32 * ks, lane), frag16(Sc, PB, 16 * wave, 32 * ks, lane), acc);
                const int p0 = 16 * pb + 4 * q4; f32x4 o;
#pragma unroll
                for (int r = 0; r < 4; ++r) o[r] = acc[r] + Dh * bf2f(XT[(p0 + r) * PB + t]) * rd;
                *(f32x4*)(YI + (size_t)(tok0 + t) * 1024 + h * 64 + p0) = o; }
        }
        {
            float* hl = HLOC + (size_t)((b * 16 + c) * 16 + h) * 8192;
#pragma unroll
            for (int pb = 0; pb < 4; ++pb) { f32x4 acc = (f32x4){0.f, 0.f, 0.f, 0.f};
#pragma unroll
                for (int ks = 0; ks < 4; ++ks) acc = mfma16(frag16(XTw, PB, 16 * pb, 32 * ks, lane), frag16(BT, PB, 16 * wave, 32 * ks, lane), acc);
#pragma unroll
                for (int r = 0; r < 4; ++r) hl[(16 * pb + 4 * q4 + r) * 128 + 16 * wave + l15] = acc[r]; }
        }
        __syncthreads();
    }
}

__device__ __forceinline__ void ssd_sample_unit(int l, int unit, unsigned char* lds, int tid) { ENTER();
    const int g = unit & 1, b = unit >> 1, m0 = NP + 4 * b;
    const bf16* PROJ = WSP(bf16, WS_PROJ);
    float* xs = (float*)lds; float* Bv = xs + 2048; float* Cv = Bv + 512; float* ygs = Cv + 512; float* cbm = ygs + 2048; float* dtv = cbm + 16; float* acv = dtv + 32; float* yst = acv + 32;
    for (int idx = tid; idx < 768; idx += NTHR) {
        int ch; float* dst; int ds;
        if (idx < 512) { ch = g * 512 + idx; dst = xs + idx; ds = 512; } else if (idx < 640) { ch = 1024 + g * 128 + (idx - 512); dst = Bv + (idx - 512); ds = 128; } else { ch = 1280 + g * 128 + (idx - 640); dst = Cv + (idx - 640); ds = 128; }
        float xp[7];
#pragma unroll
        for (int j = 0; j < 3; ++j) xp[j] = a.in[I_SSC][((size_t)(l * NSB + b) * 3 + j) * 1536 + ch];
#pragma unroll
        for (int t = 0; t < 4; ++t) xp[3 + t] = bf2f(PROJ[(size_t)(m0 + t) * INWP + O_XBC + ch]);
        const float bias = a.in[I_SCB][l * 1536 + ch]; float w[4];
#pragma unroll
        for (int j = 0; j < 4; ++j) w[j] = a.in[I_SCW][(size_t)(l * 4 + j) * 1536 + ch];
#pragma unroll
        for (int t = 0; t < 4; ++t) dst[t * ds] = silu_f(w[0] * xp[t] + w[1] * xp[t + 1] + w[2] * xp[t + 2] + w[3] * xp[t + 3] + bias);
    }
    if (tid < 32) { const int hh = tid >> 2, t = tid & 3, h = 8 * g + hh; const float dtb = a.in[I_SDTB][l * 16 + h], A = -__expf(a.in[I_SALOG][l * 16 + h]); float ac = 0.f, dt = 0.f;
        for (int j = 0; j < 4; ++j) { const float d = softplus_f(bf2f(PROJ[(size_t)(m0 + j) * INWP + O_DT + h]) + dtb); if (j <= t) { ac += d * A; dt = d; } }
        dtv[hh * 4 + t] = dt; acv[hh * 4 + t] = ac; }
    __syncthreads();
    {
#pragma unroll
        for (int k = 0; k < 2; ++k) { const int pr = 2 * wave + k, t = pr >> 2, s = pr & 3;
            const float v = wave_sum(Cv[t * 128 + lane] * Bv[s * 128 + lane] + Cv[t * 128 + 64 + lane] * Bv[s * 128 + 64 + lane]); if (lane == 0) cbm[pr] = v; }
    }
    __syncthreads();
    for (int hh = 0; hh < 8; ++hh) {
        const int h = 8 * g + hh, p = tid >> 3, n0 = (tid & 7) * 16;
        const float* hin = a.in[I_SSD] + ((size_t)((l * NSB + b) * 16 + h) * 64 + p) * 128 + n0;
        float* hout = a.out + OUT_SSSD + ((size_t)((l * NSB + b) * 16 + h) * 64 + p) * 128 + n0;
        float h0[16];
#pragma unroll
        for (int i = 0; i < 4; ++i) { const f32x4 v = *(const f32x4*)(hin + 4 * i); h0[4 * i] = v.x; h0[4 * i + 1] = v.y; h0[4 * i + 2] = v.z; h0[4 * i + 3] = v.w; }
        const float ac3 = acv[hh * 4 + 3];
#pragma unroll
        for (int t = 0; t < 4; ++t) { float s = 0.f;
#pragma unroll
            for (int i = 0; i < 16; ++i) s += Cv[t * 128 + n0 + i] * h0[i];
            s += __shfl_xor(s, 1); s += __shfl_xor(s, 2); s += __shfl_xor(s, 4);
            if ((tid & 7) == 0) yst[t * 64 + p] = s; }
        float hn[16]; const float e3 = __expf(ac3);
#pragma unroll
        for (int i = 0; i < 16; ++i) hn[i] = e3 * h0[i];
#pragma unroll
        for (int s = 0; s < 4; ++s) { const float cf = __expf(ac3 - acv[hh * 4 + s]) * dtv[hh * 4 + s] * xs[s * 512 + hh * 64 + p];
#pragma unroll
            for (int i = 0; i < 16; ++i) hn[i] += cf * Bv[s * 128 + n0 + i]; }
#pragma unroll
        for (int i = 0; i < 4; ++i) *(f32x4*)(hout + 4 * i) = (f32x4){hn[4 * i], hn[4 * i + 1], hn[4 * i + 2], hn[4 * i + 3]};
        __syncthreads();
        if (tid < 256) { const int t = tid >> 6, pp = tid & 63; const float at = acv[hh * 4 + t]; float y = __expf(at) * yst[t * 64 + pp] + a.in[I_SD][l * 16 + h] * xs[t * 512 + hh * 64 + pp];
            for (int s = 0; s <= t; ++s) y += cbm[t * 4 + s] * __expf(at - acv[hh * 4 + s]) * dtv[hh * 4 + s] * xs[s * 512 + hh * 64 + pp];
            const float z = bf2f(PROJ[(size_t)(m0 + t) * INWP + O_SSDZ + h * 64 + pp]);
            ygs[t * 512 + hh * 64 + pp] = y * silu_f(z); }
        __syncthreads();
    }
    if (wave < 4) { const int t = wave; float ss = 0.f;
#pragma unroll
        for (int j = 0; j < 8; ++j) { const float v = ygs[t * 512 + lane + 64 * j]; ss += v * v; }
        const float rs = 1.f / sqrtf(wave_sum(ss) * (1.f / 512.f) + RMS_EPS);
        bf16* mx = WSP(bf16, WS_MIX) + (size_t)(m0 + t) * MIXW + g * 512;
#pragma unroll
        for (int j = 0; j < 8; ++j) { const int cidx = lane + 64 * j; mx[cidx] = f2bf(ygs[t * 512 + cidx] * rs * a.in[I_SNW][l * 1024 + g * 512 + cidx]); } }
}

__device__ __forceinline__ void gdn_sample_unit(int l, int unit, unsigned char* lds, int tid) { ENTER();
    const int h = unit & 3, b = unit >> 2, m0 = NP + 4 * b;
    const bf16* PROJ = WSP(bf16, WS_PROJ);
    float* qv = (float*)lds; float* kv = qv + 512; float* vv = kv + 512; float* pa = vv + 512; float* pb = pa + 512; float* ot = pb + 512; float* bet = ot + 512; float* gex = bet + 4;
    if (tid < 384) { const int which = tid >> 7, d = tid & 127, ch = which * 512 + h * 128 + d; float xp[7];
#pragma unroll
        for (int j = 0; j < 3; ++j) xp[j] = a.in[I_SGC][((size_t)(l * NSB + b) * 3 + j) * 1536 + ch];
#pragma unroll
        for (int t = 0; t < 4; ++t) xp[3 + t] = bf2f(PROJ[(size_t)(m0 + t) * INWP + O_GQKV + ch]);
        float w[4];
#pragma unroll
        for (int j = 0; j < 4; ++j) w[j] = a.in[I_GCW][(size_t)(l * 4 + j) * 1536 + ch];
        float* dst = qv + which * 512 + d;
#pragma unroll
        for (int t = 0; t < 4; ++t) dst[t * 128] = silu_f(w[0] * xp[t] + w[1] * xp[t + 1] + w[2] * xp[t + 2] + w[3] * xp[t + 3]);
    } else if (tid < 392) { const int t = (tid - 384) & 3;
        if (tid < 388) bet[t] = sigmoid_f(bf2f(PROJ[(size_t)(m0 + t) * INWP + O_GB + h]));
        else gex[t] = __expf(-__expf(a.in[I_GALOG][l * 4 + h]) * softplus_f(bf2f(PROJ[(size_t)(m0 + t) * INWP + O_GA + h]) + a.in[I_GDTB][l * 4 + h])); }
    __syncthreads();
    { const int t = wave >> 1, which = wave & 1; float* arr = (which ? kv : qv) + t * 128; const float v0 = arr[lane], v1 = arr[64 + lane];
      const float sc = (1.f / sqrtf(wave_sum(v0 * v0 + v1 * v1) + L2_EPS)) * (which ? 1.f : 0.08838834764831845f); arr[lane] = v0 * sc; arr[64 + lane] = v1 * sc; }
    __syncthreads();
    const int e = tid & 127, dq = tid >> 7;
    const float* sin_ = a.in[I_SGDN] + ((size_t)((l * NSB + b) * 4 + h) * 128 + 32 * dq) * 128 + e;
    float S[32];
#pragma unroll
    for (int i = 0; i < 32; ++i) S[i] = sin_[(size_t)i * 128];
    for (int t = 0; t < 4; ++t) {
        float ks = 0.f;
#pragma unroll
        for (int i = 0; i < 32; ++i) ks += kv[t * 128 + 32 * dq + i] * S[i];
        pa[dq * 128 + e] = ks; __syncthreads();
        const float kS = (pa[e] + pa[128 + e]) + (pa[256 + e] + pa[384 + e]);
        const float bt = bet[t], ge = gex[t], ve = vv[t * 128 + e]; float os = 0.f;
#pragma unroll
        for (int i = 0; i < 32; ++i) { const float ki = kv[t * 128 + 32 * dq + i]; S[i] = ge * (S[i] - bt * ki * kS) + bt * ki * ve; os += qv[t * 128 + 32 * dq + i] * S[i]; }
        pb[dq * 128 + e] = os; __syncthreads();
        if (dq == 0) ot[t * 128 + e] = (pb[e] + pb[128 + e]) + (pb[256 + e] + pb[384 + e]);
    }
    __syncthreads();
    if (wave < 4) { const int t = wave; const float o0 = ot[t * 128 + lane], o1 = ot[t * 128 + 64 + lane];
        const float rs = 1.f / sqrtf(wave_sum(o0 * o0 + o1 * o1) * (1.f / 128.f) + RMS_EPS);
        const bf16* zr = PROJ + (size_t)(m0 + t) * INWP + O_GZ + h * 128; const float* nw = a.in[I_GNW] + l * 128;
        bf16* mx = WSP(bf16, WS_MIX) + (size_t)(m0 + t) * MIXW + 1536 + h * 128;
        mx[lane] = f2bf(o0 * rs * nw[lane] * silu_f(bf2f(zr[lane]))); mx[64 + lane] = f2bf(o1 * rs * nw[64 + lane] * silu_f(bf2f(zr[64 + lane]))); }
    float* so = a.out + OUT_SGDN + ((size_t)((l * NSB + b) * 4 + h) * 128 + 32 * dq) * 128 + e;
#pragma unroll
    for (int i = 0; i < 32; ++i) so[(size_t)i * 128] = S[i];
}

__device__ __forceinline__ void gdn_prep_unit(int l, int u, unsigned char* lds, int tid) { ENTER();
    const int h = u & 3, c = (u >> 2) & 31, b = u >> 7, tok0 = b * SEQ + c * 64, q4 = lane >> 4, l15 = lane & 15;
    const bf16* PROJ = WSP(bf16, WS_PROJ);
    bf16* Ks = (bf16*)lds; bf16* KBs = (bf16*)(lds + 17408); bf16* Qs = (bf16*)(lds + 34816); bf16* VBT = (bf16*)(lds + 52224); bf16* KBGT = (bf16*)(lds + 70656); bf16* KDTs = (bf16*)(lds + 89088);
    float* Am = (float*)(lds + 107520); bf16* Ts = (bf16*)(lds + 124928); float* gcs = (float*)(lds + 134144); float* bts = gcs + 64;
    if (wave == 0) {
        const float rb = bf2f(PROJ[(size_t)(tok0 + lane) * INWP + O_GB + h]), ra = bf2f(PROJ[(size_t)(tok0 + lane) * INWP + O_GA + h]);
        const float gt = -__expf(a.in[I_GALOG][l * 4 + h]) * softplus_f(ra + a.in[I_GDTB][l * 4 + h]);
        gcs[lane] = wave_scan_incl(gt, lane); bts[lane] = sigmoid_f(rb);
    }
    __syncthreads();
    {
        const int cp = 2 * lane, r0 = 8 * wave; const float* cw = a.in[I_GCW] + (size_t)l * 4 * 1536; const float glast = gcs[63];
        f32x2 q[8], k[8], v[8];
        conv_pair<8, false>(PROJ + (size_t)tok0 * INWP + O_GQKV + h * 128 + cp, r0, c == 0, cw + h * 128 + cp, nullptr, q);
        conv_pair<8, false>(PROJ + (size_t)tok0 * INWP + O_GQKV + 512 + h * 128 + cp, r0, c == 0, cw + 512 + h * 128 + cp, nullptr, k);
        conv_pair<8, false>(PROJ + (size_t)tok0 * INWP + O_GQKV + 1024 + h * 128 + cp, r0, c == 0, cw + 1024 + h * 128 + cp, nullptr, v);
        bf16* QG = WSP(bf16, WS_GQG) + (size_t)u * 8192;
#pragma unroll
        for (int i = 0; i < 8; ++i) { const int t = r0 + i;
            const float sq = 0.08838834764831845f / sqrtf(wave_sum(q[i].x * q[i].x + q[i].y * q[i].y) + L2_EPS), sk = 1.f / sqrtf(wave_sum(k[i].x * k[i].x + k[i].y * k[i].y) + L2_EPS);
            const float q0 = q[i].x * sq, q1 = q[i].y * sq, k0 = k[i].x * sk, k1 = k[i].y * sk, bt = bts[t], gc = gcs[t], eg = __expf(gc), ed = __expf(glast - gc);
            *(unsigned*)(Ks + t * 136 + cp) = pk2(k0, k1); *(unsigned*)(KBs + t * 136 + cp) = pk2(k0 * bt, k1 * bt); *(unsigned*)(Qs + t * 136 + cp) = pk2(q0, q1);
            VBT[cp * 72 + t] = f2bf(v[i].x * bt); VBT[(cp + 1) * 72 + t] = f2bf(v[i].y * bt);
            KBGT[cp * 72 + t] = f2bf(k0 * bt * eg); KBGT[(cp + 1) * 72 + t] = f2bf(k1 * bt * eg);
            KDTs[cp * 72 + t] = f2bf(k0 * ed); KDTs[(cp + 1) * 72 + t] = f2bf(k1 * ed);
            *(unsigned*)(QG + t * 128 + cp) = pk2(q0 * eg, q1 * eg); }
    }
    __syncthreads();
    bf16* ATT = WSP(bf16, WS_GATT) + (size_t)u * 4096;
    for (int item = wave; item < 26; item += 8) {
        if (item < 10) {
            const int tb = item >= 6 ? 3 : item >= 3 ? 2 : item >= 1 ? 1 : 0, sb = item - tb * (tb + 1) / 2;
            f32x4 acc = (f32x4){0.f, 0.f, 0.f, 0.f};
#pragma unroll
            for (int ks = 0; ks < 4; ++ks) acc = mfma16(frag16(KBs, 136, 16 * tb, 32 * ks, lane), frag16(Ks, 136, 16 * sb, 32 * ks, lane), acc);
            const int s = 16 * sb + l15; const float gs = gcs[s];
#pragma unroll
            for (int r = 0; r < 4; ++r) { const int t = 16 * tb + 4 * q4 + r; Am[t * 68 + s] = (s < t) ? acc[r] * __expf(fminf(gcs[t] - gs, 0.f)) : 0.f; }
        } else {
            const int j = item - 10, tb = j >> 2, sb = j & 3; f32x4 acc = (f32x4){0.f, 0.f, 0.f, 0.f};
            if (sb <= tb) {
#pragma unroll
                for (int ks = 0; ks < 4; ++ks) acc = mfma16(frag16(Ks, 136, 16 * sb, 32 * ks, lane), frag16(Qs, 136, 16 * tb, 32 * ks, lane), acc); }
            const int t = 16 * tb + l15, s0 = 16 * sb + 4 * q4; const float gt = gcs[t]; float vv[4];
#pragma unroll
            for (int r = 0; r < 4; ++r) vv[r] = (sb <= tb && s0 + r <= t) ? acc[r] * __expf(fminf(gt - gcs[s0 + r], 0.f)) : 0.f;
            u32x2 w; w.x = pk2(vv[0], vv[1]); w.y = pk2(vv[2], vv[3]); *(u32x2*)(ATT + t * 64 + s0) = w;
        }
    }
    __syncthreads();
#ifndef NOINV
    if (wave == 0) {
        float x[64]; int zo = 0; asm volatile("" : "+v"(zo)); const float* Amz = Am + zo;
#pragma unroll
        for (int i = 0; i < 64; ++i) { float acc = fmaxf(0.f, 1.f - fabsf((float)(i - lane)));
#pragma unroll
            for (int jj = 0; jj < (i + 3) / 4; ++jj) { const f32x4 av = *(const f32x4*)(Amz + i * 68 + 4 * jj);
#pragma unroll
                for (int e = 0; e < 4; ++e) if (4 * jj + e < i) acc -= av[e] * x[4 * jj + e]; }
            x[i] = acc; Ts[i * 72 + lane] = f2bf(acc); }
    }
#endif
    __syncthreads();
    {
        float* U = WSP(float, WS_GU) + (size_t)u * 8192; bf16* NW = WSP(bf16, WS_GNW) + (size_t)u * 8192;
#pragma unroll
        for (int tb = 0; tb < 4; ++tb) { f32x4 au = (f32x4){0.f, 0.f, 0.f, 0.f}, aw = au;
#pragma unroll
            for (int ks = 0; ks < 2; ++ks) { const bf16x8 bf = frag16(Ts, 72, 16 * tb, 32 * ks, lane); au = mfma16(frag16(VBT, 72, 16 * wave, 32 * ks, lane), bf, au); aw = mfma16(frag16(KBGT, 72, 16 * wave, 32 * ks, lane), bf, aw); }
            const int t = 16 * tb + l15, e0 = 16 * wave + 4 * q4;
            *(f32x4*)(U + t * 128 + e0) = au; u32x2 w; w.x = pk2(-aw[0], -aw[1]); w.y = pk2(-aw[2], -aw[3]); *(u32x2*)(NW + t * 128 + e0) = w; }
        bf16* KDT = WSP(bf16, WS_GKDT) + (size_t)u * 8192;
#pragma unroll
        for (int i = 0; i < 2; ++i) { const int id = tid + 512 * i, d = id >> 3, cc = id & 7; *(u32x4*)(KDT + d * 64 + 8 * cc) = *(const u32x4*)(KDTs + d * 72 + 8 * cc); }
        if (tid == 0) WSP(float, WS_GEG)[u] = __expf(gcs[63]);
    }
}

__device__ __forceinline__ void gdn_chain_unit(int l, int unit, unsigned char* lds, int tid) { ENTER();
    const int h = unit & 3, b = unit >> 2, q4 = lane >> 4, l15 = lane & 15, e0 = 16 * wave;
    const bf16* PROJ = WSP(bf16, WS_PROJ);
    bf16* NWs = (bf16*)lds; bf16* QGs = (bf16*)(lds + 17408); bf16* KDs = (bf16*)(lds + 34816); bf16* ATs = (bf16*)(lds + 53248); float* Os = (float*)(lds + 62464);
    f32x4 sacc[8];
#pragma unroll
    for (int i = 0; i < 8; ++i) sacc[i] = (f32x4){0.f, 0.f, 0.f, 0.f};
    for (int c = 0; c < 32; ++c) {
        const int u = (b * 32 + c) * 4 + h, tok0 = b * SEQ + c * 64;
        const bf16* NW = WSP(bf16, WS_GNW) + (size_t)u * 8192; const bf16* QG = WSP(bf16, WS_GQG) + (size_t)u * 8192; const bf16* KDT = WSP(bf16, WS_GKDT) + (size_t)u * 8192;
        const bf16* ATT = WSP(bf16, WS_GATT) + (size_t)u * 4096; const float* U = WSP(float, WS_GU) + (size_t)u * 8192;
#pragma unroll
        for (int i = 0; i < 2; ++i) { const int id = tid + 512 * i, row = id >> 4, cc = id & 15;
            *(u32x4*)(NWs + row * 136 + 8 * cc) = *(const u32x4*)(NW + row * 128 + 8 * cc); *(u32x4*)(QGs + row * 136 + 8 * cc) = *(const u32x4*)(QG + row * 128 + 8 * cc);
            const int d = id >> 3, c8 = id & 7; *(u32x4*)(KDs + d * 72 + 8 * c8) = *(const u32x4*)(KDT + d * 64 + 8 * c8); }
        { const int row = tid >> 3, c8 = tid & 7; *(u32x4*)(ATs + row * 72 + 8 * c8) = *(const u32x4*)(ATT + row * 64 + 8 * c8); }
        const float eg = WSP(float, WS_GEG)[u];
        __syncthreads();
        bf16x8 sf[4];
#pragma unroll
        for (int ks = 0; ks < 4; ++ks) sf[ks] = accpair(sacc[2 * ks], sacc[2 * ks + 1]);
        f32x4 vn[4];
#pragma unroll
        for (int tb = 0; tb < 4; ++tb) { f32x4 acc;
#pragma unroll
            for (int r = 0; r < 4; ++r) acc[r] = U[(16 * tb + 4 * q4 + r) * 128 + e0 + l15];
#pragma unroll
            for (int ks = 0; ks < 4; ++ks) acc = mfma16(frag16p(NWs, 136, 16 * tb, 32 * ks, lane), sf[ks], acc);
            vn[tb] = acc; }
        const bf16x8 vf0 = accpair(vn[0], vn[1]), vf1 = accpair(vn[2], vn[3]);
#pragma unroll
        for (int tb = 0; tb < 4; ++tb) { f32x4 acc = (f32x4){0.f, 0.f, 0.f, 0.f};
#pragma unroll
            for (int ks = 0; ks < 4; ++ks) acc = mfma16(frag16p(QGs, 136, 16 * tb, 32 * ks, lane), sf[ks], acc);
            acc = mfma16(frag16p(ATs, 72, 16 * tb, 0, lane), vf0, acc); acc = mfma16(frag16p(ATs, 72, 16 * tb, 32, lane), vf1, acc);
#pragma unroll
            for (int r = 0; r < 4; ++r) Os[(16 * tb + 4 * q4 + r) * 132 + e0 + l15] = acc[r]; }
#pragma unroll
        for (int db = 0; db < 8; ++db) { f32x4 acc = sacc[db] * eg;
            acc = mfma16(frag16p(KDs, 72, 16 * db, 0, lane), vf0, acc); acc = mfma16(frag16p(KDs, 72, 16 * db, 32, lane), vf1, acc); sacc[db] = acc; }
        __syncthreads();
        {
            const float nw0 = a.in[I_GNW][l * 128 + 2 * lane], nw1 = a.in[I_GNW][l * 128 + 2 * lane + 1];
#pragma unroll
            for (int i = 0; i < 8; ++i) { const int t = 8 * wave + i; const f32x2 o = *(const f32x2*)(Os + t * 132 + 2 * lane);
                const float rs = 1.f / sqrtf(wave_sum(o.x * o.x + o.y * o.y) * (1.f / 128.f) + RMS_EPS);
                const unsigned z = *(const unsigned*)(PROJ + (size_t)(tok0 + t) * INWP + O_GZ + h * 128 + 2 * lane);
                *(unsigned*)(WSP(bf16, WS_MIX) + (size_t)(tok0 + t) * MIXW + 1536 + h * 128 + 2 * lane) = pk2(o.x * rs * nw0 * silu_f(bflo(z)), o.y * rs * nw1 * silu_f(bfhi(z))); }
        }
        __syncthreads();
    }
    float* so = a.out + OUT_PGDN + (size_t)((l * NPB + b) * 4 + h) * 16384;
#pragma unroll
    for (int db = 0; db < 8; ++db)
#pragma unroll
        for (int r = 0; r < 4; ++r) so[(16 * db + 4 * q4 + r) * 128 + e0 + l15] = sacc[db][r];
}

__device__ __forceinline__ void ssd_chain_unit(int l, int unit, unsigned char* lds, int tid) { ENTER();
    const int h = unit & 15, b = unit >> 4, g = h >> 3, q4 = lane >> 4, l15 = lane & 15;
    const bf16* PROJ = WSP(bf16, WS_PROJ); const bf16* CC = WSP(bf16, WS_CC); const float* ACUM = WSP(float, WS_ACUM); const float* YI = WSP(float, WS_YI);
    bf16* YG = WSP(bf16, WS_YG); float* SSQ = WSP(float, WS_SSQ);
    bf16* Hs = (bf16*)lds; bf16* Cs = (bf16*)(lds + 17408);
    const int hp = tid >> 3, hn0 = (tid & 7) * 16;
    float H[16];
#pragma unroll
    for (int i = 0; i < 16; ++i) H[i] = 0.f;
    for (int c = 0; c < 16; ++c) {
        const int tok0 = b * SEQ + c * 128;
        { u32x4 w0, w1; w0.x = pk2(H[0], H[1]); w0.y = pk2(H[2], H[3]); w0.z = pk2(H[4], H[5]); w0.w = pk2(H[6], H[7]); w1.x = pk2(H[8], H[9]); w1.y = pk2(H[10], H[11]); w1.z = pk2(H[12], H[13]); w1.w = pk2(H[14], H[15]);
          *(u32x4*)(Hs + hp * 136 + hn0) = w0; *(u32x4*)(Hs + hp * 136 + hn0 + 8) = w1; }
#pragma unroll
        for (int i = 0; i < 4; ++i) { const int id = tid + 512 * i, row = id >> 4, cc = id & 15; *(u32x4*)(Cs + row * 136 + 8 * cc) = *(const u32x4*)(CC + (size_t)(tok0 + row) * 256 + g * 128 + 8 * cc); }
        __syncthreads();
        {
            const int t = 16 * wave + l15, tok = tok0 + t; const float ea = __expf(ACUM[(size_t)tok * 16 + h]); float ssq = 0.f;
#pragma unroll
            for (int pb = 0; pb < 4; ++pb) { f32x4 acc = (f32x4){0.f, 0.f, 0.f, 0.f};
#pragma unroll
                for (int ks = 0; ks < 4; ++ks) acc = mfma16(frag16(Hs, 136, 16 * pb, 32 * ks, lane), frag16(Cs, 136, 16 * wave, 32 * ks, lane), acc);
                const int p0 = 16 * pb + 4 * q4;
                const f32x4 yi = *(const f32x4*)(YI + (size_t)tok * 1024 + h * 64 + p0); const u32x2 z = *(const u32x2*)(PROJ + (size_t)tok * INWP + O_SSDZ + h * 64 + p0);
                const float y0 = (yi.x + ea * acc[0]) * silu_f(bflo(z.x)), y1 = (yi.y + ea * acc[1]) * silu_f(bfhi(z.x)), y2 = (yi.z + ea * acc[2]) * silu_f(bflo(z.y)), y3 = (yi.w + ea * acc[3]) * silu_f(bfhi(z.y));
                ssq += (y0 * y0 + y1 * y1) + (y2 * y2 + y3 * y3);
                u32x2 w; w.x = pk2(y0, y1); w.y = pk2(y2, y3); *(u32x2*)(YG + (size_t)tok * 1024 + h * 64 + p0) = w; }
            ssq += __shfl_xor(ssq, 16); ssq += __shfl_xor(ssq, 32);
            if (q4 == 0) SSQ[(size_t)tok * 16 + h] = ssq;
        }
        {
            const float dl = __expf(ACUM[(size_t)(tok0 + 127) * 16 + h]); const float* hl = WSP(float, WS_HLOC) + (size_t)((b * 16 + c) * 16 + h) * 8192 + hp * 128 + hn0;
#pragma unroll
            for (int i = 0; i < 4; ++i) { const f32x4 v = *(const f32x4*)(hl + 4 * i); H[4 * i] = dl * H[4 * i] + v.x; H[4 * i + 1] = dl * H[4 * i + 1] + v.y; H[4 * i + 2] = dl * H[4 * i + 2] + v.z; H[4 * i + 3] = dl * H[4 * i + 3] + v.w; }
        }
        __syncthreads();
    }
    float* ho = a.out + OUT_PSSD + (size_t)((l * NPB + b) * 16 + h) * 8192 + hp * 128 + hn0;
#pragma unroll
    for (int i = 0; i < 4; ++i) *(f32x4*)(ho + 4 * i) = (f32x4){H[4 * i], H[4 * i + 1], H[4 * i + 2], H[4 * i + 3]};
}

__device__ __forceinline__ void ssd_final_unit(int l, int unit, int tid) { ENTER();
    const bf16* YG = WSP(bf16, WS_YG); const float* SSQ = WSP(float, WS_SSQ); bf16* MIX = WSP(bf16, WS_MIX);
    for (int i = 0; i < 8; ++i) { const int m = unit * 64 + wave * 8 + i;
#pragma unroll
        for (int g = 0; g < 2; ++g) { float ss = 0.f;
#pragma unroll
            for (int j = 0; j < 8; ++j) ss += SSQ[(size_t)m * 16 + 8 * g + j];
            const float rs = 1.f / sqrtf(ss * (1.f / 512.f) + RMS_EPS);
            const u32x4 w = *(const u32x4*)(YG + (size_t)m * 1024 + g * 512 + 8 * lane);
            const f32x4 n0 = *(const f32x4*)(a.in[I_SNW] + l * 1024 + g * 512 + 8 * lane), n1 = *(const f32x4*)(a.in[I_SNW] + l * 1024 + g * 512 + 8 * lane + 4);
            u32x4 o; o.x = pk2(bflo(w.x) * rs * n0.x, bfhi(w.x) * rs * n0.y); o.y = pk2(bflo(w.y) * rs * n0.z, bfhi(w.y) * rs * n0.w);
            o.z = pk2(bflo(w.z) * rs * n1.x, bfhi(w.z) * rs * n1.y); o.w = pk2(bflo(w.w) * rs * n1.z, bfhi(w.w) * rs * n1.w);
            *(u32x4*)(MIX + (size_t)m * MIXW + g * 512 + 8 * lane) = o; } }
}

__device__ __forceinline__ void attn_unit(int l, int unit, unsigned char* lds, int tid) { ENTER();
    const int qb = 7 - (unit >> 6), bh = unit & 63, b = bh >> 3, h = bh & 7, r32 = lane & 31, hh = lane >> 5;
    const bf16* Q = WSP(bf16, WS_Q); const bf16* KK = WSP(bf16, WS_KK); const bf16* VT = WSP(bf16, WS_VT); const float* RC = WSP(float, WS_ROPECS);
    bf16* Ks = (bf16*)lds; bf16* VTs = (bf16*)(lds + 13312);
    const int qrow = 256 * qb + 32 * wave + r32, tok = b * SEQ + qrow;
    bf16x8 qf[6];
    {
        const bf16* qp = Q + (size_t)tok * 768 + h * 96 + 8 * hh;
#pragma unroll
        for (int ks = 0; ks < 4; ++ks) { const u32x4 w = *(const u32x4*)(qp + 16 * ks); u32x4 o;
            o.x = pk2(bflo(w.x) * ATT_SC, bfhi(w.x) * ATT_SC); o.y = pk2(bflo(w.y) * ATT_SC, bfhi(w.y) * ATT_SC); o.z = pk2(bflo(w.z) * ATT_SC, bfhi(w.z) * ATT_SC); o.w = pk2(bflo(w.w) * ATT_SC, bfhi(w.w) * ATT_SC);
            qf[ks] = __builtin_bit_cast(bf16x8, o); }
        const u32x4 w1 = *(const u32x4*)(qp + 64), w2 = *(const u32x4*)(qp + 80);
        const f32x4 c0 = *(const f32x4*)(RC + (size_t)tok * 32 + 8 * hh), c1 = *(const f32x4*)(RC + (size_t)tok * 32 + 8 * hh + 4), s0 = *(const f32x4*)(RC + (size_t)tok * 32 + 16 + 8 * hh), s1 = *(const f32x4*)(RC + (size_t)tok * 32 + 16 + 8 * hh + 4);
        float x1[8] = {bflo(w1.x), bfhi(w1.x), bflo(w1.y), bfhi(w1.y), bflo(w1.z), bfhi(w1.z), bflo(w1.w), bfhi(w1.w)};
        float x2[8] = {bflo(w2.x), bfhi(w2.x), bflo(w2.y), bfhi(w2.y), bflo(w2.z), bfhi(w2.z), bflo(w2.w), bfhi(w2.w)};
        float cc[8] = {c0.x, c0.y, c0.z, c0.w, c1.x, c1.y, c1.z, c1.w}, sn[8] = {s0.x, s0.y, s0.z, s0.w, s1.x, s1.y, s1.z, s1.w};
        float o1[8], o2[8];
#pragma unroll
        for (int i = 0; i < 8; ++i) { o1[i] = (x1[i] * cc[i] - x2[i] * sn[i]) * ATT_SC; o2[i] = (x2[i] * cc[i] + x1[i] * sn[i]) * ATT_SC; }
        u32x4 p1, p2; p1.x = pk2(o1[0], o1[1]); p1.y = pk2(o1[2], o1[3]); p1.z = pk2(o1[4], o1[5]); p1.w = pk2(o1[6], o1[7]); p2.x = pk2(o2[0], o2[1]); p2.y = pk2(o2[2], o2[3]); p2.z = pk2(o2[4], o2[5]); p2.w = pk2(o2[6], o2[7]);
        qf[4] = __builtin_bit_cast(bf16x8, p1); qf[5] = __builtin_bit_cast(bf16x8, p2);
    }
    f32x16 o0, o1;
#pragma unroll
    for (int r = 0; r < 16; ++r) { o0[r] = 0.f; o1[r] = 0.f; }
    float m = -1e30f, lsum = 0.f;
    const int KT = 4 * qb + 4;
    const int kr0 = tid / 12, kc0 = tid % 12, kr1 = (tid + 512) / 12, kc1 = (tid + 512) % 12, vr = tid >> 3, vc = tid & 7;
    const bf16* kbase = KK + (size_t)(b * SEQ) * 768 + h * 96; const bf16* vbase = VT + (size_t)(h * 64 + vr) * NP + b * SEQ + 8 * vc;
    u32x4 kreg0 = *(const u32x4*)(kbase + (size_t)kr0 * 768 + 8 * kc0), kreg1 = (u32x4){0u, 0u, 0u, 0u}, vreg = *(const u32x4*)(vbase);
    if (tid < 256) kreg1 = *(const u32x4*)(kbase + (size_t)kr1 * 768 + 8 * kc1);
    for (int kt = 0; kt < KT; ++kt) {
        const int key0 = 64 * kt;
        __syncthreads();
        *(u32x4*)(Ks + kr0 * 104 + 8 * kc0) = kreg0; if (tid < 256) *(u32x4*)(Ks + kr1 * 104 + 8 * kc1) = kreg1; *(u32x4*)(VTs + vr * 72 + 8 * vc) = vreg;
        if (kt + 1 < KT) { kreg0 = *(const u32x4*)(kbase + (size_t)(key0 + 64 + kr0) * 768 + 8 * kc0); if (tid < 256) kreg1 = *(const u32x4*)(kbase + (size_t)(key0 + 64 + kr1) * 768 + 8 * kc1); vreg = *(const u32x4*)(vbase + key0 + 64); }
        __syncthreads();
        if (key0 <= 256 * qb + 32 * wave + 31) {
            f32x16 s0, s1;
#pragma unroll
            for (int r = 0; r < 16; ++r) { s0[r] = 0.f; s1[r] = 0.f; }
#pragma unroll
            for (int ks = 0; ks < 6; ++ks) { const bf16x8 a0 = *(const bf16x8*)(Ks + r32 * 104 + 16 * ks + 8 * hh), a1 = *(const bf16x8*)(Ks + (32 + r32) * 104 + 16 * ks + 8 * hh);
                s0 = mfma32(a0, qf[ks], s0); s1 = mfma32(a1, qf[ks], s1); }
            if (key0 + 63 > 256 * qb + 32 * wave) {
#pragma unroll
                for (int r = 0; r < 16; ++r) { const int key = key0 + (r & 3) + 8 * (r >> 2) + 4 * hh; if (key > qrow) s0[r] = -1e30f; if (key + 32 > qrow) s1[r] = -1e30f; } }
            float mx = s0[0];
#pragma unroll
            for (int r = 1; r < 16; ++r) mx = fmaxf(mx, s0[r]);
#pragma unroll
            for (int r = 0; r < 16; ++r) mx = fmaxf(mx, s1[r]);
            mx = fmaxf(mx, __shfl_xor(mx, 32));
            const float mn = fmaxf(m, mx), alpha = __builtin_amdgcn_exp2f(m - mn); m = mn;
            float ps = 0.f;
#pragma unroll
            for (int r = 0; r < 16; ++r) { s0[r] = __builtin_amdgcn_exp2f(s0[r] - mn); s1[r] = __builtin_amdgcn_exp2f(s1[r] - mn); ps += s0[r] + s1[r]; }
            ps += __shfl_xor(ps, 32); lsum = lsum * alpha + ps;
#pragma unroll
            for (int r = 0; r < 16; ++r) { o0[r] *= alpha; o1[r] *= alpha; }
            bf16x8 pf[4];
#pragma unroll
            for (int s2 = 0; s2 < 2; ++s2) { u32x4 w;
                w.x = pk2(s0[8 * s2], s0[8 * s2 + 1]); w.y = pk2(s0[8 * s2 + 2], s0[8 * s2 + 3]); w.z = pk2(s0[8 * s2 + 4], s0[8 * s2 + 5]); w.w = pk2(s0[8 * s2 + 6], s0[8 * s2 + 7]); pf[s2] = __builtin_bit_cast(bf16x8, w);
                w.x = pk2(s1[8 * s2], s1[8 * s2 + 1]); w.y = pk2(s1[8 * s2 + 2], s1[8 * s2 + 3]); w.z = pk2(s1[8 * s2 + 4], s1[8 * s2 + 5]); w.w = pk2(s1[8 * s2 + 6], s1[8 * s2 + 7]); pf[2 + s2] = __builtin_bit_cast(bf16x8, w); }
#pragma unroll
            for (int kk = 0; kk < 4; ++kk) {
                const bf16* vp0 = VTs + r32 * 72 + 16 * kk + 4 * hh; const bf16* vp1 = vp0 + 32 * 72;
                const bf16x4 l0 = *(const bf16x4*)vp0, h0 = *(const bf16x4*)(vp0 + 8), l1 = *(const bf16x4*)vp1, h1 = *(const bf16x4*)(vp1 + 8);
                o0 = mfma32((bf16x8){l0[0], l0[1], l0[2], l0[3], h0[0], h0[1], h0[2], h0[3]}, pf[kk], o0);
                o1 = mfma32((bf16x8){l1[0], l1[1], l1[2], l1[3], h1[0], h1[1], h1[2], h1[3]}, pf[kk], o1); }
        }
    }
    {
        const float inv = 1.f / lsum; const bf16* gp = WSP(bf16, WS_PROJ) + (size_t)tok * INWP + O_GATE + h * 64; bf16* mp = WSP(bf16, WS_MIX) + (size_t)tok * MIXW + 1024 + h * 64;
#pragma unroll
        for (int rr = 0; rr < 4; ++rr) { const int d0 = 8 * rr + 4 * hh;
            { const u32x2 gz = *(const u32x2*)(gp + d0); u32x2 w; w.x = pk2(o0[4 * rr] * inv * silu_f(bflo(gz.x)), o0[4 * rr + 1] * inv * silu_f(bfhi(gz.x))); w.y = pk2(o0[4 * rr + 2] * inv * silu_f(bflo(gz.y)), o0[4 * rr + 3] * inv * silu_f(bfhi(gz.y))); *(u32x2*)(mp + d0) = w; }
            { const u32x2 gz = *(const u32x2*)(gp + 32 + d0); u32x2 w; w.x = pk2(o1[4 * rr] * inv * silu_f(bflo(gz.x)), o1[4 * rr + 1] * inv * silu_f(bfhi(gz.x))); w.y = pk2(o1[4 * rr + 2] * inv * silu_f(bflo(gz.y)), o1[4 * rr + 3] * inv * silu_f(bfhi(gz.y))); *(u32x2*)(mp + 32 + d0) = w; } }
    }
}

struct DecRegs { f32x4 L[2][4]; f32x4 R; };
__device__ __forceinline__ void dec_load(const CAS KArgs& a, unsigned char* ws, int l, int b, int sp, int j, int tid, DecRegs& d) {
    if (j < 16) {
        const int page = ((const int*)a.in[I_PT])[b * NPAGES + 8 * sp + (j >> 1)]; const int key0 = (j & 1) * 64;
        const float* lat = a.in[I_CLAT] + ((size_t)(l * NPHYS + page) * PAGE + key0) * 256; const float* rp = a.in[I_CROPE] + ((size_t)(l * NPHYS + page) * PAGE + key0) * 32;
#pragma unroll
        for (int g2 = 0; g2 < 2; ++g2) { const int gi = tid + 512 * g2, kq = gi >> 6, dq = gi & 63;
#pragma unroll
            for (int i = 0; i < 4; ++i) d.L[g2][i] = __builtin_nontemporal_load((const f32x4*)(lat + (size_t)(4 * kq + i) * 256 + 4 * dq)); }
        d.R = __builtin_nontemporal_load((const f32x4*)(rp + (size_t)(tid >> 3) * 32 + 4 * (tid & 7)));
    } else {
        const bf16* ck = WSP(bf16, WS_CKVN) + (size_t)(NP + 4 * b) * 256; const bf16* kr = WSP(bf16, WS_KROPE) + (size_t)(NP + 4 * b) * 32;
#pragma unroll
        for (int g2 = 0; g2 < 2; ++g2) { const int gi = tid + 512 * g2, kq = gi >> 6, dq = gi & 63;
#pragma unroll
            for (int i = 0; i < 4; ++i) { f32x4 v = (f32x4){0.f, 0.f, 0.f, 0.f}; if (kq == 0) { const u32x2 w = *(const u32x2*)(ck + i * 256 + 4 * dq); v = (f32x4){bflo(w.x), bfhi(w.x), bflo(w.y), bfhi(w.y)}; } d.L[g2][i] = v; } }
        f32x4 v = (f32x4){0.f, 0.f, 0.f, 0.f}; if ((tid >> 3) < 4) { const u32x2 w = *(const u32x2*)(kr + (tid >> 3) * 32 + 4 * (tid & 7)); v = (f32x4){bflo(w.x), bfhi(w.x), bflo(w.y), bfhi(w.y)}; } d.R = v;
    }
}
__device__ __forceinline__ void decode_unit(int l, int unit, unsigned char* lds, int tid) { ENTER();
    const int sp = unit & 15, b = unit >> 4, r32 = lane & 31, hh = lane >> 5;
    bf16* Qs = (bf16*)lds; bf16* Ks = (bf16*)(lds + 18944); bf16* VTs = (bf16*)(lds + 56832);
    {
        const int row = tid >> 4, t = row >> 3, hq = row & 7, c0 = (tid & 15) * 16;
        const bf16* src = WSP(bf16, WS_QLAT) + (size_t)(4 * b + t) * 2048 + hq * 256 + c0;
#pragma unroll
        for (int i = 0; i < 2; ++i) { const u32x4 w = *(const u32x4*)(src + 8 * i); u32x4 o;
            o.x = pk2(bflo(w.x) * ATT_SC, bfhi(w.x) * ATT_SC); o.y = pk2(bflo(w.y) * ATT_SC, bfhi(w.y) * ATT_SC); o.z = pk2(bflo(w.z) * ATT_SC, bfhi(w.z) * ATT_SC); o.w = pk2(bflo(w.w) * ATT_SC, bfhi(w.w) * ATT_SC);
            *(u32x4*)(Qs + row * 296 + c0 + 8 * i) = o; }
        const int i = tid & 15, tr = NP + 4 * b + t; const bf16* qr = WSP(bf16, WS_Q) + (size_t)tr * 768 + hq * 96 + 64; const float* RC = WSP(float, WS_ROPECS) + (size_t)tr * 32;
        const float x1 = bf2f(qr[i]), x2 = bf2f(qr[16 + i]), c = RC[i], s = RC[16 + i];
        Qs[row * 296 + 256 + i] = f2bf((x1 * c - x2 * s) * ATT_SC); Qs[row * 296 + 272 + i] = f2bf((x2 * c + x1 * s) * ATT_SC);
    }
    __syncthreads();
    bf16x8 qf[18];
#pragma unroll
    for (int ks = 0; ks < 18; ++ks) qf[ks] = *(const bf16x8*)(Qs + r32 * 296 + 16 * ks + 8 * hh);
    f32x16 oacc;
#pragma unroll
    for (int r = 0; r < 16; ++r) oacc[r] = 0.f;
    float m = -1e30f, lsum = 0.f;
    const int nt = 16 + (sp == 15 ? 1 : 0);
    DecRegs d; dec_load(a, ws, l, b, sp, 0, tid, d);
    for (int j = 0; j < nt; ++j) {
        __syncthreads();
#pragma unroll
        for (int g2 = 0; g2 < 2; ++g2) { const int gi = tid + 512 * g2, kq = gi >> 6, dq = gi & 63;
#pragma unroll
            for (int i = 0; i < 4; ++i) { u32x2 w; w.x = pk2(d.L[g2][i].x, d.L[g2][i].y); w.y = pk2(d.L[g2][i].z, d.L[g2][i].w); *(u32x2*)(Ks + (4 * kq + i) * 296 + 4 * dq) = w; }
            { u32x2 w; w.x = pk2(d.L[g2][0].x, d.L[g2][1].x); w.y = pk2(d.L[g2][2].x, d.L[g2][3].x); *(u32x2*)(VTs + (4 * dq + 0) * 72 + 4 * kq) = w; }
            { u32x2 w; w.x = pk2(d.L[g2][0].y, d.L[g2][1].y); w.y = pk2(d.L[g2][2].y, d.L[g2][3].y); *(u32x2*)(VTs + (4 * dq + 1) * 72 + 4 * kq) = w; }
            { u32x2 w; w.x = pk2(d.L[g2][0].z, d.L[g2][1].z); w.y = pk2(d.L[g2][2].z, d.L[g2][3].z); *(u32x2*)(VTs + (4 * dq + 2) * 72 + 4 * kq) = w; }
            { u32x2 w; w.x = pk2(d.L[g2][0].w, d.L[g2][1].w); w.y = pk2(d.L[g2][2].w, d.L[g2][3].w); *(u32x2*)(VTs + (4 * dq + 3) * 72 + 4 * kq) = w; } }
        { u32x2 w; w.x = pk2(d.R.x, d.R.y); w.y = pk2(d.R.z, d.R.w); *(u32x2*)(Ks + (tid >> 3) * 296 + 256 + 4 * (tid & 7)) = w; }
        if (j + 1 < nt) dec_load(a, ws, l, b, sp, j + 1, tid, d);
        __syncthreads();
        f32x16 s0, s1;
#pragma unroll
        for (int r = 0; r < 16; ++r) { s0[r] = 0.f; s1[r] = 0.f; }
#pragma unroll
        for (int ks = 0; ks < 18; ++ks) { const bf16x8 a0 = *(const bf16x8*)(Ks + r32 * 296 + 16 * ks + 8 * hh), a1 = *(const bf16x8*)(Ks + (32 + r32) * 296 + 16 * ks + 8 * hh);
            s0 = mfma32(a0, qf[ks], s0); s1 = mfma32(a1, qf[ks], s1); }
        if (j == 16) { const int tq = r32 >> 3;
#pragma unroll
            for (int r = 0; r < 16; ++r) { const int kl = (r & 3) + 8 * (r >> 2) + 4 * hh; if (!(kl < 4 && kl <= tq)) s0[r] = -1e30f; s1[r] = -1e30f; } }
        float mx = s0[0];
#pragma unroll
        for (int r = 1; r < 16; ++r) mx = fmaxf(mx, s0[r]);
#pragma unroll
        for (int r = 0; r < 16; ++r) mx = fmaxf(mx, s1[r]);
        mx = fmaxf(mx, __shfl_xor(mx, 32));
        const float mn = fmaxf(m, mx), alpha = __builtin_amdgcn_exp2f(m - mn); m = mn;
        float ps = 0.f;
#pragma unroll
        for (int r = 0; r < 16; ++r) { s0[r] = __builtin_amdgcn_exp2f(s0[r] - mn); s1[r] = __builtin_amdgcn_exp2f(s1[r] - mn); ps += s0[r] + s1[r]; }
        ps += __shfl_xor(ps, 32); lsum = lsum * alpha + ps;
#pragma unroll
        for (int r = 0; r < 16; ++r) oacc[r] *= alpha;
        bf16x8 pf[4];
#pragma unroll
        for (int s2 = 0; s2 < 2; ++s2) { u32x4 w;
            w.x = pk2(s0[8 * s2], s0[8 * s2 + 1]); w.y = pk2(s0[8 * s2 + 2], s0[8 * s2 + 3]); w.z = pk2(s0[8 * s2 + 4], s0[8 * s2 + 5]); w.w = pk2(s0[8 * s2 + 6], s0[8 * s2 + 7]); pf[s2] = __builtin_bit_cast(bf16x8, w);
            w.x = pk2(s1[8 * s2], s1[8 * s2 + 1]); w.y = pk2(s1[8 * s2 + 2], s1[8 * s2 + 3]); w.z = pk2(s1[8 * s2 + 4], s1[8 * s2 + 5]); w.w = pk2(s1[8 * s2 + 6], s1[8 * s2 + 7]); pf[2 + s2] = __builtin_bit_cast(bf16x8, w); }
#pragma unroll
        for (int kk = 0; kk < 4; ++kk) { const bf16* vp = VTs + (32 * wave + r32) * 72 + 16 * kk + 4 * hh; const bf16x4 lo = *(const bf16x4*)vp, hi = *(const bf16x4*)(vp + 8);
            oacc = mfma32((bf16x8){lo[0], lo[1], lo[2], lo[3], hi[0], hi[1], hi[2], hi[3]}, pf[kk], oacc); }
    }
    float* po = WSP(float, WS_PARTO) + ((size_t)(b * 16 + sp) * 32 + r32) * 256 + 32 * wave + 4 * hh;
#pragma unroll
    for (int rr = 0; rr < 4; ++rr) *(f32x4*)(po + 8 * rr) = (f32x4){oacc[4 * rr], oacc[4 * rr + 1], oacc[4 * rr + 2], oacc[4 * rr + 3]};
    if (wave == 0 && hh == 0) { float* pm = WSP(float, WS_PARTML) + ((size_t)(b * 16 + sp) * 32 + r32) * 2; pm[0] = m; pm[1] = lsum; }
}
__device__ __forceinline__ void combine_unit(int l, int b, unsigned char* lds, int tid) { ENTER();
    float* olat = (float*)lds; float* wts = olat + 8192;
    const float* PO = WSP(float, WS_PARTO) + (size_t)b * 16 * 32 * 256; const float* PM = WSP(float, WS_PARTML) + (size_t)b * 16 * 32 * 2;
    if (tid < 32) { float M = -1e30f;
        for (int sp = 0; sp < 16; ++sp) M = fmaxf(M, PM[(sp * 32 + tid) * 2]);
        float L = 0.f;
        for (int sp = 0; sp < 16; ++sp) { const float w = __builtin_amdgcn_exp2f(PM[(sp * 32 + tid) * 2] - M); L += PM[(sp * 32 + tid) * 2 + 1] * w; wts[tid * 16 + sp] = w; }
        const float il = 1.f / L;
        for (int sp = 0; sp < 16; ++sp) wts[tid * 16 + sp] *= il; }
    __syncthreads();
    { const int d = tid & 255, qh = tid >> 8;
        for (int qi = 0; qi < 16; ++qi) { const int q = 16 * qh + qi; float acc = 0.f;
#pragma unroll
            for (int sp = 0; sp < 16; ++sp) acc += PO[((size_t)sp * 32 + q) * 256 + d] * wts[q * 16 + sp];
            olat[q * 256 + d] = acc; } }
    __syncthreads();
    { const int dv = tid & 63, rq = tid >> 6;
#pragma unroll
        for (int j = 0; j < 4; ++j) { const int row = rq + 8 * j, t = row >> 3, hq = row & 7; const float* wv = a.in[I_WUV] + (size_t)l * 256 * 512 + hq * 64 + dv; float acc = 0.f;
#pragma unroll 8
            for (int r = 0; r < 256; ++r) acc += olat[row * 256 + r] * wv[(size_t)r * 512];
            const int tr = NP + 4 * b + t; const float gz = bf2f(WSP(bf16, WS_PROJ)[(size_t)tr * INWP + O_GATE + hq * 64 + dv]);
            WSP(bf16, WS_MIX)[(size_t)tr * MIXW + 1024 + hq * 64 + dv] = f2bf(acc * silu_f(gz)); } }
}


__device__ __forceinline__ void tiny_out_unit(int l, int tile, unsigned char* lds, int tid) { ENTER();
    __syncthreads();
    const bf16* WoT = WSP(bf16, WS_WOUT) + (size_t)l * DM * MIXW;
    const int r0 = NP + 16 * (tile >> 5), c0 = 32 * (tile & 31), q4 = lane >> 4, l15 = lane & 15;
    const bf16* ap = WSP(bf16, WS_MIX) + (size_t)(r0 + l15) * MIXW + 256 * wave + 8 * q4; const bf16* bp = WoT + (size_t)(c0 + l15) * MIXW + 256 * wave + 8 * q4;
    f32x4 acc0 = (f32x4){0.f, 0.f, 0.f, 0.f}, acc1 = acc0;
#pragma unroll
    for (int ks = 0; ks < 8; ++ks) { const bf16x8 af = *(const bf16x8*)(ap + 32 * ks); acc0 = mfma16(af, *(const bf16x8*)(bp + 32 * ks), acc0); acc1 = mfma16(af, *(const bf16x8*)(bp + (size_t)16 * MIXW + 32 * ks), acc1); }
    float* part = (float*)lds;
#pragma unroll
    for (int r = 0; r < 4; ++r) { part[(wave * 16 + 4 * q4 + r) * 32 + l15] = acc0[r]; part[(wave * 16 + 4 * q4 + r) * 32 + 16 + l15] = acc1[r]; }
    __syncthreads();
    const int row = tid >> 5, col = tid & 31; float s = 0.f;
#pragma unroll
    for (int w = 0; w < 8; ++w) s += part[(w * 16 + row) * 32 + col];
    const size_t o = (size_t)(r0 + row) * DM + c0 + col; WSP(float, WS_Y)[o] = s + ALPHA * WSP(float, WS_XF)[o];
}
__device__ __forceinline__ void ln_phase(int l, int tid, int bid, int G) { ENTER();
    const float* lg = a.in[I_LNG] + l * DM; const float* lb = a.in[I_LNB] + l * DM;
    for (int m = bid * NWAVES + wave; m < MT; m += G * NWAVES) {
        const float* yr = WSP(float, WS_Y) + (size_t)m * DM;
        if (l == 0) ln_row(yr, lg, lb, WSP(float, WS_XF) + (size_t)m * DM, WSP(bf16, WS_XN) + (size_t)m * DM, lane);
        else ln_row(yr, lg, lb, (m < NP) ? a.out + OUT_YP + (size_t)m * DM : a.out + OUT_YS + (size_t)(m - NP) * DM, nullptr, lane);
    }
}

constexpr int NPH = 15;
#ifndef PHM
#define PHM 0xFFFF
#endif
#ifndef UM
#define UM 0xFFFF
#endif
#ifndef DUP
#define DUP 0
#endif
#ifndef UDUP
#define UDUP 0
#endif
#define REPS(bit) (((DUP) & (bit)) ? 2 : 1)
__global__ void __launch_bounds__(NTHR, 2) hymba_fwd(KArgs a_unused) {
    extern __shared__ __attribute__((aligned(16))) unsigned char lds[];
    const int tid = threadIdx.x, lane = tid & 63, wave = __builtin_amdgcn_readfirstlane(tid >> 6), bid = blockIdx.x, G = gridDim.x;
    const CAS KArgs* kp_ = (const CAS KArgs*)__builtin_amdgcn_kernarg_segment_ptr(); const CAS KArgs& a = *kp_; unsigned char* ws = a.ws;
#define FRESH() asm volatile("" : "+s"(ws))
    volatile unsigned* MISC = (volatile unsigned*)(lds + MISC_OFF);
    if (tid < 64) MISC[tid] = 0u;
    __syncthreads();
    unsigned* ctl = (unsigned*)(a.ws + WS_CTL);
    const int lo = a.ph_lo, hi = a.ph_hi;
    XcdBarrier bar; bar.bar = ctl + CW_BAR; bar.x = 0; bar.st = nullptr;
    if (hi - lo > 1) bar = xcd_barrier_post(ctl + CW_BAR, (volatile LAS unsigned*)(lds + MISC_OFF + 32));
    volatile unsigned* slot = MISC + 16;
#define IN(k) (lo <= (k) && (k) < hi)
#define SEAM(k) do { if (IN(k) && IN((k) + 1)) xcd_barrier(bar); } while (0)
    if (IN(0) && (PHM & 1)) { for (int rep = 0; rep < REPS(1); ++rep) { if (rep) xcd_barrier(bar); ph_prologue(lds, tid, bid, G); } }
    SEAM(0);
    for (int l = 0; l < 2; ++l) {
        const int P = 1 + 7 * l;
        if (IN(P) && (PHM & 2)) for (int rep = 0; rep < REPS(2); ++rep) { if (rep) xcd_barrier(bar); FRESH();
            pg8::Gemm g{WSP(bf16, WS_XN), WSP(bf16, WS_WIN) + (size_t)l * INWP * DM, MP, INWP, DM, DM, DM}; pg8::StaticOrder S; S.init(MP, INWP, G, bid);
            pg8::EpiBf16 E{WSP(bf16, WS_PROJ), INWP, 0};
            pg8::gemm_phase<pg8::EpiBf16, pg8::StaticOrder, true, true>((PG8_LAS unsigned char*)lds, g, S, E);
        }
        SEAM(P);
        if (IN(P + 1) && (PHM & 4)) for (int rep = 0; rep < REPS(4); ++rep) { if (rep) xcd_barrier(bar);
            unsigned* ctr = ctl + CW_Q + 64 * (2 * l + 8 * rep);
            for (;;) { int u = q_next(ctr, slot, tid);
                if (u < 256) { if (UM & 1) { ssd_s1_unit(l, u, lds, tid); if (UDUP & 1) { __syncthreads(); ssd_s1_unit(l, u, lds, tid); } } continue; } u -= 256;
                if (u < 1024) { if (UM & 2) { gdn_prep_unit(l, u, lds, tid); if (UDUP & 2) { __syncthreads(); gdn_prep_unit(l, u, lds, tid); } } continue; } u -= 1024;
                if (u < 64) { if (UM & 4) ssd_sample_unit(l, u, lds, tid); continue; } u -= 64;
                if (u < 128) { if (UM & 8) gdn_sample_unit(l, u, lds, tid); continue; } u -= 128;
                if (u < 258) { if (UM & 16) e1_unit(l, u, tid); continue; }
                break; }
        }
        SEAM(P + 1);
        if (IN(P + 2) && (PHM & 8)) for (int rep = 0; rep < REPS(8); ++rep) { if (rep) xcd_barrier(bar); FRESH();
            { pg8::Gemm g{WSP(bf16, WS_CQN), WSP(bf16, WS_WUQ) + (size_t)l * 768 * 384, MP, 768, 384, 384, 384}; pg8::StaticOrder S; S.init(MP, 768, G, bid);
              pg8::EpiBf16 E{WSP(bf16, WS_Q), 768, 0}; pg8::gemm_phase<pg8::EpiBf16, pg8::StaticOrder, true, true>((PG8_LAS unsigned char*)lds, g, S, E); }
            { pg8::Gemm g{WSP(bf16, WS_CKVN), WSP(bf16, WS_WUK) + (size_t)l * 512 * 256, NP, 512, 256, 256, 256}; pg8::StaticOrder S; S.init(NP, 512, G, (bid + G - 195 % G) % G);
              pg8::EpiBf16 E{WSP(bf16, WS_KK), 768, 1}; pg8::gemm_phase<pg8::EpiBf16, pg8::StaticOrder, true, true>((PG8_LAS unsigned char*)lds, g, S, E); }
            { pg8::Gemm g{WSP(bf16, WS_WUV) + (size_t)l * 512 * 256, WSP(bf16, WS_CKVN), 512, NP, 256, 256, 256}; pg8::StaticOrder S; S.init(512, NP, G, (bid + G - 67 % G) % G);
              pg8::EpiBf16 E{WSP(bf16, WS_VT), NP, 0}; pg8::gemm_phase<pg8::EpiBf16, pg8::StaticOrder, true, true>((PG8_LAS unsigned char*)lds, g, S, E); }
            { pg8::Gemm g{WSP(bf16, WS_CQN) + (size_t)NP * 384, WSP(bf16, WS_WABS) + (size_t)l * 2048 * 384, 256, 2048, 384, 384, 384}; pg8::StaticOrder S; S.init(256, 2048, G, (bid + G - 195 % G) % G);
              pg8::EpiBf16 E{WSP(bf16, WS_QLAT), 2048, 0}; pg8::gemm_phase<pg8::EpiBf16, pg8::StaticOrder, true, true>((PG8_LAS unsigned char*)lds, g, S, E); }
        }
        SEAM(P + 2);
        if (IN(P + 3) && (PHM & 16)) for (int rep = 0; rep < REPS(16); ++rep) { if (rep) xcd_barrier(bar);
            unsigned* ctr = ctl + CW_Q + 64 * (2 * l + 1 + 8 * rep);
            for (;;) { int u = q_next(ctr, slot, tid);
                if (u < 32) { if (UM & 32) { gdn_chain_unit(l, u, lds, tid); if (UDUP & 32) { __syncthreads(); gdn_chain_unit(l, u, lds, tid); } } continue; } u -= 32;
                if (u < 128) { if (UM & 64) { ssd_chain_unit(l, u, lds, tid); if (UDUP & 64) { __syncthreads(); ssd_chain_unit(l, u, lds, tid); } } continue; } u -= 128;
                if (u < 1024) { if (u & 1) { if (UM & 128) { decode_unit(l, u >> 1, lds, tid); if (UDUP & 128) { __syncthreads(); decode_unit(l, u >> 1, lds, tid); } } } else if (UM & 256) { attn_unit(l, u >> 1, lds, tid); if (UDUP & 256) { __syncthreads(); attn_unit(l, u >> 1, lds, tid); } } continue; }
                break; }
        }
        SEAM(P + 3);
        if (IN(P + 4) && (PHM & 32)) for (int rep = 0; rep < REPS(32); ++rep) { if (rep) xcd_barrier(bar);
            for (int u = bid; u < 288; u += G) { if (u < 32) { __syncthreads(); combine_unit(l, u, lds, tid); } else ssd_final_unit(l, u - 32, tid); }
        }
        SEAM(P + 4);
        if (IN(P + 5) && (PHM & 64)) for (int rep = 0; rep < REPS(64); ++rep) { if (rep) xcd_barrier(bar); FRESH();
            const bf16* WoT = WSP(bf16, WS_WOUT) + (size_t)l * DM * MIXW;
            { pg8::Gemm g{WSP(bf16, WS_MIX), WoT, NP, DM, MIXW, MIXW, MIXW}; pg8::StaticOrder S; S.init(NP, DM, G, bid);
              pg8::EpiF32Res E{WSP(float, WS_Y), WSP(float, WS_XF), DM, ALPHA}; pg8::gemm_phase<pg8::EpiF32Res, pg8::StaticOrder, false, true>((PG8_LAS unsigned char*)lds, g, S, E); }
            for (int tile = bid; tile < 256; tile += G) tiny_out_unit(l, tile, lds, tid);
        }
        SEAM(P + 5);
        if (IN(P + 6) && (PHM & 128)) for (int rep = 0; rep < REPS(128); ++rep) { if (rep) xcd_barrier(bar); FRESH();
            ln_phase(l, tid, bid, G);
        }
        if (l == 0) SEAM(P + 6);
    }
#undef IN
#undef SEAM
}

#ifndef MK_ONE_LAUNCH
#define MK_ONE_LAUNCH 1
#endif
extern "C" void kernel_launch(void* const* d_in, const int* in_sizes, int n_in, void* d_out, int out_size, void* d_ws, size_t ws_size, hipStream_t stream) {
    static int grid = 0;
    if (grid == 0) {
        if (n_in != N_IN || (size_t)out_size != OUT_END || ws_size < WS_END) { fprintf(stderr, "kernel_launch: unexpected shapes: n_in %d out %d ws %zu\n", n_in, out_size, ws_size); grid = -1; return; }
        int dev = 0, cus = 0;
        if (hipGetDevice(&dev) != hipSuccess || hipDeviceGetAttribute(&cus, hipDeviceAttributeMultiprocessorCount, dev) != hipSuccess) { grid = -1; return; }
        if (hipFuncSetAttribute((const void*)hymba_fwd, hipFuncAttributeMaxDynamicSharedMemorySize, LDS_BYTES) != hipSuccess) { fprintf(stderr, "kernel_launch: hipFuncSetAttribute failed\n"); grid = -1; return; }
        int per_cu = 0; (void)hipOccupancyMaxActiveBlocksPerMultiprocessor(&per_cu, (const void*)hymba_fwd, NTHR, LDS_BYTES); (void)hipGetLastError();
        grid = cus > 256 ? 256 : cus;
    }
    if (grid < 0) return;
    (void)hipMemsetAsync((char*)d_ws + WS_CTL, 0, CTL_ZERO_BYTES, stream);
    KArgs a{};
    for (int i = 0; i < N_IN; ++i) a.in[i] = (const float*)d_in[i];
    a.out = (float*)d_out; a.ws = (unsigned char*)d_ws;
#if MK_ONE_LAUNCH
    a.ph_lo = 0; a.ph_hi = NPH;
    hipLaunchKernelGGL(hymba_fwd, dim3(grid), dim3(NTHR), LDS_BYTES, stream, a);
#else
    for (int p = 0; p < NPH; ++p) { a.ph_lo = p; a.ph_hi = p + 1; hipLaunchKernelGGL(hymba_fwd, dim3(grid), dim3(NTHR), LDS_BYTES, stream, a); }
#endif
}
```

```cpp
#include <hip/hip_runtime.h>
#include <cstdio>
#include <cstdint>

#define LAS __attribute__((address_space(3)))
#define GAS __attribute__((address_space(1)))
typedef unsigned short bf16;
typedef short bf16x8 __attribute__((ext_vector_type(8)));
typedef short bf16x4 __attribute__((ext_vector_type(4)));
typedef float f32x4 __attribute__((ext_vector_type(4)));
typedef float f32x2 __attribute__((ext_vector_type(2)));
typedef float f32x16 __attribute__((ext_vector_type(16)));
typedef unsigned u32x4 __attribute__((ext_vector_type(4)));
typedef unsigned u32x2 __attribute__((ext_vector_type(2)));

namespace pg8 {
#define PG8_LAS __attribute__((address_space(3)))
typedef unsigned short bf16_t;
constexpr int BM = 256, BK = 64, HALF = 128, HTB = HALF * BK * 2, STAGE_BYTES = 8 * HTB, NXCD = 8, WGM = 8;
__host__ __device__ __forceinline__ int lds_byte(int r, int c) { const int st = (r >> 4) * 2 + (c >> 5), rr = r & 15, cc = c & 31, ob = rr * 64 + cc * 2; return st * 1024 + (ob ^ (((ob >> 9) & 1) << 5)); }
__host__ __device__ __forceinline__ void stage_rc(int b, int& R, int& C) { const int st = b / 1024, sb = b % 1024, swz = sb ^ (((sb >> 9) & 1) << 5); R = (st >> 1) * 16 + swz / 64; C = (st & 1) * 32 + (swz % 64) / 2; }
__host__ __device__ __forceinline__ int perm32(int rho) { const int n = rho >> 4, i = rho & 15; return 8 * (i >> 2) + 4 * n + (i & 3); }
struct Unit { int pm, pn; };
struct Gemm { const bf16_t* A; const bf16_t* Bt; int M, N, K, lda, ldb; };
struct StaticOrder {
    int nM, nN, nwg, G, c;
    __host__ __device__ void init(int M, int N, int G_, int c_) { nM = M / BM; nN = N / BM; nwg = nM * nN; G = G_; c = c_; }
    __host__ __device__ bool next(int i, Unit& u) const {
        const long L = (long)i * G + c; if (L >= nwg) return false;
        int wgid = (int)L; { const int q = nwg / NXCD, r = nwg % NXCD, xcd = wgid % NXCD, off = wgid / NXCD; wgid = (xcd < r ? xcd * (q + 1) : r * (q + 1) + (xcd - r) * q) + off; }
        const int nig = WGM * nN, gid = wgid / nig, fm = gid * WGM, gsz = (nM - fm) < WGM ? (nM - fm) : WGM;
        u.pm = fm + ((wgid % nig) % gsz); u.pn = (wgid % nig) / gsz; return true;
    }
    __device__ __forceinline__ void a_ready(const Unit&) const {}
    __device__ __forceinline__ void done(const Unit&) const {}
};
__device__ __forceinline__ unsigned cvt_pk_bf16(float lo, float hi) { unsigned r; asm volatile("v_cvt_pk_bf16_f32 %0, %1, %2" : "=v"(r) : "v"(lo), "v"(hi)); return r; }
struct EpiBf16 {
    static constexpr bool PERM = true, AFTER_DRAIN = false;
    bf16_t* O; int ldc; int remap;
    __device__ __forceinline__ void operator()(const f32x4 (&acc)[2][2][4][2], const Unit& u, int wr, int wc, int fr, int fq) const {
        const int row0 = u.pm * BM + wr * 64 + fr, colb = u.pn * BM + wc * 32 + 8 * fq;
#pragma unroll
        for (int ai = 0; ai < 2; ++ai)
#pragma unroll
            for (int m = 0; m < 4; ++m) { bf16_t* rowp = O + (size_t)(row0 + ai * HALF + m * 16) * ldc;
#pragma unroll
                for (int bj = 0; bj < 2; ++bj) { int c = colb + bj * HALF; if (remap) c = (c >> 6) * 96 + (c & 63);
                    const f32x4 v0 = acc[ai][bj][m][0], v1 = acc[ai][bj][m][1];
                    u32x4 w; w.x = cvt_pk_bf16(v0[0], v0[1]); w.y = cvt_pk_bf16(v0[2], v0[3]); w.z = cvt_pk_bf16(v1[0], v1[1]); w.w = cvt_pk_bf16(v1[2], v1[3]);
                    *(u32x4*)(rowp + c) = w; } }
    }
};
struct EpiF32Res {
    static constexpr bool PERM = false, AFTER_DRAIN = false;
    float* Y; const float* X; int ldc; float alpha;
    __device__ __forceinline__ void operator()(const f32x4 (&acc)[2][2][4][2], const Unit& u, int wr, int wc, int fr, int fq) const {
        const int row0 = u.pm * BM + wr * 64 + fr, col0 = u.pn * BM + wc * 32 + 4 * fq;
#pragma unroll
        for (int ai = 0; ai < 2; ++ai)
#pragma unroll
            for (int m = 0; m < 4; ++m) { const size_t ro = (size_t)(row0 + ai * HALF + m * 16) * ldc + col0;
#pragma unroll
                for (int bj = 0; bj < 2; ++bj)
#pragma unroll
                    for (int n = 0; n < 2; ++n) { const f32x4 x = *(const f32x4*)(X + ro + bj * HALF + n * 16); *(f32x4*)(Y + ro + bj * HALF + n * 16) = acc[ai][bj][m][n] + x * alpha; } }
    }
};
template <class Epi, class Sched, bool ALIGN_EPI = false, bool SP2 = false>
__device__ __forceinline__ void gemm_phase(PG8_LAS unsigned char* lds, const Gemm g, const Sched& S, const Epi& E) {
    int tid_ = threadIdx.x; asm volatile("" : "+v"(tid_));
    const int tid = tid_, wid = __builtin_amdgcn_readfirstlane(tid >> 6), lane = tid & 63, wr = wid >> 2, wc = wid & 3, fr = lane & 15, fq = lane >> 4;
    const int K = g.K, nt = K / BK;
    unsigned voffA[2], voffB[2];
#pragma unroll
    for (int i = 0; i < 2; ++i) { int R, C; stage_rc(tid * 16 + i * 8192, R, C); const int Rb = Epi::PERM ? ((R & ~31) + perm32(R & 31)) : R;
        voffA[i] = (unsigned)(R * g.lda + C) * 2u; voffB[i] = (unsigned)(Rb * g.ldb + C) * 2u; }
    const size_t kstep = (size_t)(BK * 2);
    const size_t hstepA = (size_t)HALF * g.lda * 2, hstepB = (size_t)HALF * g.ldb * 2;
    const size_t tstepA = 2 * hstepA, tstepB = 2 * hstepB;
    const unsigned ldsw = (unsigned)wid * 1024u;
    const int aoff = lds_byte(wr * 64 + fr, fq * 8), boff = lds_byte(wc * 32 + fr, fq * 8);
#define PG8_SA(b, h) (((b) * 2 + (h)) * HTB)
#define PG8_SB(b, h) ((4 + (b) * 2 + (h)) * HTB)
#define PG8_STAGE(bufoff, gbase, voff) do { _Pragma("unroll") for (int _i = 0; _i < 2; ++_i) \
        __builtin_amdgcn_global_load_lds((const unsigned*)((const char*)(gbase) + (voff)[_i]), (PG8_LAS unsigned*)(lds + (bufoff) + ldsw + _i * 8192), 16, 0, 0); } while (0)
#define PG8_LDA(dst, b, h) do { _Pragma("unroll") for (int m = 0; m < 4; ++m) _Pragma("unroll") for (int k = 0; k < 2; ++k) dst[m][k] = *(const PG8_LAS bf16x8*)(lds + PG8_SA(b, h) + aoff + m * 2048 + k * 1024); } while (0)
#define PG8_LDB(dst, b, h) do { _Pragma("unroll") for (int n = 0; n < 2; ++n) _Pragma("unroll") for (int k = 0; k < 2; ++k) dst[n][k] = *(const PG8_LAS bf16x8*)(lds + PG8_SB(b, h) + boff + n * 2048 + k * 1024); } while (0)
#define PG8_MMA(ai, bj, At, Bt) do { __builtin_amdgcn_s_setprio(1); _Pragma("unroll") for (int m = 0; m < 4; ++m) _Pragma("unroll") for (int n = 0; n < 2; ++n) _Pragma("unroll") for (int k = 0; k < 2; ++k) \
        acc[ai][bj][m][n] = __builtin_amdgcn_mfma_f32_16x16x32_bf16(Bt[n][k], At[m][k], acc[ai][bj][m][n], 0, 0, 0); __builtin_amdgcn_s_setprio(0); } while (0)
#define PG8_WAIT_V(n) asm volatile("s_waitcnt vmcnt(" #n ")" ::: "memory")
#define PG8_WAIT_L(n) asm volatile("s_waitcnt lgkmcnt(" #n ")" ::: "memory")
#define PG8_BAR __builtin_amdgcn_s_barrier()
#define PG8_SCHED __builtin_amdgcn_sched_barrier(0)
    Unit cur, nxt; int ui = 0;
    if (!S.next(0, cur)) return;
    f32x4 acc[2][2][4][2];
#pragma unroll
    for (int a = 0; a < 2; ++a)
#pragma unroll
        for (int b = 0; b < 2; ++b)
#pragma unroll
            for (int m = 0; m < 4; ++m)
#pragma unroll
                for (int n = 0; n < 2; ++n) acc[a][b][m][n] = (f32x4){0.f, 0.f, 0.f, 0.f};
    bf16x8 At[4][2], B0[2][2], B1[2][2];
    const char* cA = (const char*)g.A + (size_t)cur.pm * tstepA; const char* cB = (const char*)g.Bt + (size_t)cur.pn * tstepB;
    S.a_ready(cur);
    if constexpr (SP2) {
        PG8_STAGE(PG8_SB(0, 0), cB, voffB); PG8_STAGE(PG8_SB(0, 1), cB + hstepB, voffB); PG8_STAGE(PG8_SA(0, 0), cA, voffA); PG8_STAGE(PG8_SA(0, 1), cA + hstepA, voffA);
        if (wr == 1) PG8_BAR;
        PG8_WAIT_V(2); PG8_BAR;
        PG8_STAGE(PG8_SB(1, 0), cB + kstep, voffB); PG8_STAGE(PG8_SA(1, 0), cA + kstep, voffA); PG8_STAGE(PG8_SB(1, 1), cB + hstepB + kstep, voffB);
        PG8_WAIT_V(6); PG8_BAR;
    } else {
        PG8_STAGE(PG8_SB(0, 0), cB, voffB); PG8_STAGE(PG8_SA(0, 0), cA, voffA); PG8_STAGE(PG8_SB(0, 1), cB + hstepB, voffB); PG8_STAGE(PG8_SA(0, 1), cA + hstepA, voffA);
        if (wr == 1) PG8_BAR;
        PG8_WAIT_V(4); PG8_BAR;
        PG8_STAGE(PG8_SB(1, 0), cB + kstep, voffB); PG8_STAGE(PG8_SA(1, 0), cA + kstep, voffA); PG8_STAGE(PG8_SB(1, 1), cB + hstepB + kstep, voffB);
        PG8_WAIT_V(6); PG8_BAR;
    }
    for (;;) {
        const bool has_next = S.next(ui + 1, nxt);
        const char* nA = has_next ? (const char*)g.A + (size_t)nxt.pm * tstepA : cA; const char* nB = has_next ? (const char*)g.Bt + (size_t)nxt.pn * tstepB : cB;
        for (int t = 0; t < nt; t += 2) {
            const bool last = (t == nt - 2);
            const char* a1 = cA + (size_t)(t + 1) * kstep;
            const char* a2 = last ? nA : cA + (size_t)(t + 2) * kstep; const char* b2 = last ? nB : cB + (size_t)(t + 2) * kstep;
            const char* a3 = a2 + kstep; const char* b3 = b2 + kstep;
            if (last && has_next) S.a_ready(nxt);
            if constexpr (SP2) {
            PG8_LDB(B0, 0, 0); PG8_LDB(B1, 0, 1); PG8_SCHED; PG8_LDA(At, 0, 0); PG8_STAGE(PG8_SA(1, 1), a1 + hstepA, voffA);
            PG8_WAIT_V(8); PG8_WAIT_L(0); PG8_BAR; PG8_MMA(0, 0, At, B0); PG8_MMA(0, 1, At, B1); PG8_BAR; PG8_SCHED;
            PG8_LDA(At, 0, 1); PG8_STAGE(PG8_SB(0, 0), b2, voffB); PG8_STAGE(PG8_SB(0, 1), b2 + hstepB, voffB); PG8_STAGE(PG8_SA(0, 0), a2, voffA);
            PG8_WAIT_V(8); PG8_WAIT_L(0); PG8_BAR; PG8_MMA(1, 0, At, B0); PG8_MMA(1, 1, At, B1); PG8_BAR; PG8_SCHED;
            PG8_LDB(B0, 1, 0); PG8_LDB(B1, 1, 1); PG8_SCHED; PG8_LDA(At, 1, 0); PG8_STAGE(PG8_SA(0, 1), a2 + hstepA, voffA);
            PG8_WAIT_V(8); PG8_WAIT_L(0); PG8_BAR; PG8_MMA(0, 0, At, B0); PG8_MMA(0, 1, At, B1); PG8_BAR; PG8_SCHED;
            PG8_LDA(At, 1, 1); PG8_STAGE(PG8_SB(1, 0), b3, voffB); PG8_STAGE(PG8_SB(1, 1), b3 + hstepB, voffB); PG8_STAGE(PG8_SA(1, 0), a3, voffA);
            PG8_WAIT_V(8); PG8_WAIT_L(0); PG8_BAR; PG8_MMA(1, 0, At, B0); PG8_MMA(1, 1, At, B1); PG8_BAR; PG8_SCHED;
            } else {
            PG8_LDB(B0, 0, 0); PG8_SCHED; PG8_LDA(At, 0, 0); PG8_STAGE(PG8_SA(1, 1), a1 + hstepA, voffA);
            PG8_WAIT_L(8); PG8_BAR; PG8_WAIT_L(0); PG8_MMA(0, 0, At, B0); PG8_BAR; PG8_SCHED;
            PG8_LDB(B1, 0, 1); PG8_STAGE(PG8_SB(0, 0), b2, voffB);
            PG8_BAR; PG8_WAIT_L(0); PG8_MMA(0, 1, At, B1); PG8_BAR;
            PG8_LDA(At, 0, 1); PG8_STAGE(PG8_SA(0, 0), a2, voffA);
            PG8_BAR; PG8_WAIT_L(0); PG8_MMA(1, 0, At, B0); PG8_BAR; PG8_SCHED;
            PG8_STAGE(PG8_SB(0, 1), b2 + hstepB, voffB);
            PG8_WAIT_V(6); PG8_BAR; PG8_MMA(1, 1, At, B1); PG8_BAR;
            PG8_LDB(B0, 1, 0); PG8_SCHED; PG8_LDA(At, 1, 0); PG8_STAGE(PG8_SA(0, 1), a2 + hstepA, voffA);
            PG8_WAIT_L(8); PG8_BAR; PG8_WAIT_L(0); PG8_MMA(0, 0, At, B0); PG8_BAR; PG8_SCHED;
            PG8_LDB(B1, 1, 1); PG8_STAGE(PG8_SB(1, 0), b3, voffB);
            PG8_BAR; PG8_WAIT_L(0); PG8_MMA(0, 1, At, B1); PG8_BAR;
            PG8_LDA(At, 1, 1); PG8_STAGE(PG8_SA(1, 0), a3, voffA);
            PG8_BAR; PG8_WAIT_L(0); PG8_MMA(1, 0, At, B0); PG8_BAR; PG8_SCHED;
            PG8_STAGE(PG8_SB(1, 1), b3 + hstepB, voffB);
            PG8_WAIT_V(6); PG8_BAR; PG8_MMA(1, 1, At, B1); PG8_BAR;
            }
        }
        if constexpr (ALIGN_EPI) { if (wr == 0) PG8_BAR; }
        if constexpr (!Epi::AFTER_DRAIN) { E(acc, cur, wr, wc, fr, fq); S.done(cur); }
        if (!has_next) break;
#pragma unroll
        for (int a = 0; a < 2; ++a)
#pragma unroll
            for (int b = 0; b < 2; ++b)
#pragma unroll
                for (int m = 0; m < 4; ++m)
#pragma unroll
                    for (int n = 0; n < 2; ++n) acc[a][b][m][n] = (f32x4){0.f, 0.f, 0.f, 0.f};
        cur = nxt; cA = nA; cB = nB; ++ui;
        if constexpr (ALIGN_EPI) { if (wr == 1) PG8_BAR; }
    }
    PG8_WAIT_V(0);
    if constexpr (!ALIGN_EPI) { if (wr == 0) PG8_BAR; }
    PG8_BAR;
    if constexpr (Epi::AFTER_DRAIN) { E.fused(acc, cur, wr, wc, fr, fq, lds, wid, lane); S.done(cur); }
#undef PG8_SA
#undef PG8_SB
#undef PG8_STAGE
#undef PG8_LDA
#undef PG8_LDB
#undef PG8_MMA
#undef PG8_WAIT_V
#undef PG8_WAIT_L
#undef PG8_BAR
#undef PG8_SCHED
}
}

constexpr int DM = 1024, NPB = 8, SEQ = 2048, NP = NPB * SEQ, NSB = 32, DSQ = 4, NS = NSB * DSQ, MT = NP + NS, MP = 16640;
constexpr int PASTL = 16384, PAGE = 128, NPAGES = 128, NPHYS = 5120;
constexpr int INW = 5816, INWP = 5888, MIXW = 2048;
constexpr int O_SSDZ = 0, O_XBC = 1024, O_DT = 2560, O_CQ = 2576, O_CKV = 2960, O_KR = 3216, O_GATE = 3248, O_GQKV = 3760, O_GZ = 5296, O_GB = 5808, O_GA = 5812;
constexpr float LN_EPS = 1e-5f, RMS_EPS = 1e-6f, L2_EPS = 1e-6f, ALPHA = 1.41421356237309515f;
constexpr float LOG2E = 1.4426950408889634f;
constexpr float ATT_SC = 0.10206207261596575f * LOG2E;
constexpr size_t OUT_YP = 0, OUT_YS = OUT_YP + 16777216, OUT_PLAT = OUT_YS + 131072, OUT_PROPE = OUT_PLAT + 8388608, OUT_PSC = OUT_PROPE + 1048576, OUT_PSSD = OUT_PSC + 73728,
                 OUT_PGC = OUT_PSSD + 2097152, OUT_PGDN = OUT_PGC + 73728, OUT_SLAT = OUT_PGDN + 1048576, OUT_SROPE = OUT_SLAT + 65536, OUT_SSC = OUT_SROPE + 8192,
                 OUT_SSSD = OUT_SSC + 294912, OUT_SGC = OUT_SSSD + 8388608, OUT_SGDN = OUT_SGC + 294912, OUT_END = OUT_SGDN + 4194304;
enum { I_XP = 0, I_XS, I_CLAT, I_CROPE, I_SSC, I_SSD, I_SGC, I_SGDN, I_PT, I_EG, I_EB, I_WIN, I_SCW, I_SCB, I_SDTB, I_SALOG, I_SD, I_SNW, I_QNW, I_WUQ, I_KVNW, I_WUK, I_WUV,
       I_GCW, I_GDTB, I_GALOG, I_GNW, I_WOUT, I_LNG, I_LNB, N_IN };
constexpr size_t MiB = 1u << 20;
constexpr size_t WS_CTL = 0, CTL_ZERO_BYTES = 1 * MiB;
constexpr size_t WS_WIN = 2 * MiB, WS_WOUT = 26 * MiB, WS_WUQ = 34 * MiB, WS_WUK = 36 * MiB, WS_WUV = 37 * MiB, WS_WABS = 38 * MiB, WS_ROPECS = 42 * MiB;
constexpr size_t WS_XF = 46 * MiB, WS_XN = 112 * MiB, WS_PROJ = 146 * MiB, WS_CQN = 334 * MiB, WS_CKVN = 347 * MiB, WS_KROPE = 356 * MiB, WS_Q = 358 * MiB, WS_KK = 383 * MiB;
constexpr size_t WS_VT = 407 * MiB, WS_QLAT = 423 * MiB, WS_CC = 424 * MiB, WS_ACUM = 432 * MiB, WS_YI = 433 * MiB, WS_HLOC = 497 * MiB, WS_YG = 561 * MiB, WS_SSQ = 593 * MiB;
constexpr size_t WS_GNW = 594 * MiB, WS_GQG = 610 * MiB, WS_GKDT = 626 * MiB, WS_GU = 642 * MiB, WS_GATT = 674 * MiB, WS_GEG = 682 * MiB, WS_PARTO = 683 * MiB, WS_PARTML = 699 * MiB;
constexpr size_t WS_MIX = 700 * MiB, WS_Y = 766 * MiB, WS_END = 832 * MiB;
static_assert(WS_WIN + (size_t)2 * INWP * DM * 2 <= WS_WOUT && WS_XF + (size_t)MT * DM * 4 <= WS_XN && WS_XN + (size_t)MP * DM * 2 <= WS_PROJ && WS_PROJ + (size_t)MP * INWP * 2 <= WS_CQN, "ws map");
static_assert(WS_CQN + (size_t)MP * 384 * 2 <= WS_CKVN && WS_CKVN + (size_t)MP * 256 * 2 <= WS_KROPE && WS_Q + (size_t)MP * 768 * 2 <= WS_KK && WS_MIX + (size_t)MP * MIXW * 2 <= WS_Y && WS_Y + (size_t)MT * DM * 4 <= WS_END, "ws map");
constexpr int CW_BAR = 4096;
constexpr int CW_Q = 16384;
constexpr int LDS_BYTES = 147456, MISC_OFF = 144 * 1024 - 256;
constexpr int NWAVES = 8, NTHR = 512;

#define LDS_WAIT() asm volatile("s_waitcnt lgkmcnt(0)" ::: "memory")
#define VM_WAIT() asm volatile("s_waitcnt vmcnt(0)" ::: "memory")
__device__ __forceinline__ float bflo(unsigned w) { return __uint_as_float(w << 16); }
__device__ __forceinline__ float bfhi(unsigned w) { return __uint_as_float(w & 0xffff0000u); }
__device__ __forceinline__ float bf2f(bf16 v) { return __uint_as_float((unsigned)v << 16); }
__device__ __forceinline__ unsigned pk2(float lo, float hi) { unsigned r; asm volatile("v_cvt_pk_bf16_f32 %0, %1, %2" : "=v"(r) : "v"(lo), "v"(hi)); return r; }
__device__ __forceinline__ bf16 f2bf(float f) { return (bf16)(pk2(f, 0.f) & 0xffffu); }
__device__ __forceinline__ float silu_f(float x) { return x * __builtin_amdgcn_rcpf(1.f + __expf(-x)); }
__device__ __forceinline__ float sigmoid_f(float x) { return __builtin_amdgcn_rcpf(1.f + __expf(-x)); }
__device__ __forceinline__ float softplus_f(float x) { return x > 20.f ? x : log1pf(__expf(x)); }
__device__ __forceinline__ float wave_sum(float v) {
    v += __builtin_bit_cast(float, __builtin_amdgcn_update_dpp(0, __builtin_bit_cast(int, v), 0xB1, 0xF, 0xF, true));
    v += __builtin_bit_cast(float, __builtin_amdgcn_update_dpp(0, __builtin_bit_cast(int, v), 0x4E, 0xF, 0xF, true));
    v += __builtin_bit_cast(float, __builtin_amdgcn_update_dpp(0, __builtin_bit_cast(int, v), 0x141, 0xF, 0xF, true));
    v += __builtin_bit_cast(float, __builtin_amdgcn_update_dpp(0, __builtin_bit_cast(int, v), 0x140, 0xF, 0xF, true));
    v += __builtin_bit_cast(float, __builtin_amdgcn_update_dpp(0, __builtin_bit_cast(int, v), 0x142, 0xA, 0xF, false));
    v += __builtin_bit_cast(float, __builtin_amdgcn_update_dpp(0, __builtin_bit_cast(int, v), 0x143, 0xC, 0xF, false));
    return __builtin_bit_cast(float, __builtin_amdgcn_readlane(__builtin_bit_cast(int, v), 63));
}
__device__ __forceinline__ float half_sum(float v) { float a = v, b = v; asm volatile("s_nop 1\n\tv_permlane32_swap_b32 %0, %1\n\ts_nop 1" : "+v"(a), "+v"(b)); return a + b; }
__device__ __forceinline__ float half_max(float v) { float a = v, b = v; asm volatile("s_nop 1\n\tv_permlane32_swap_b32 %0, %1\n\ts_nop 1" : "+v"(a), "+v"(b)); return fmaxf(a, b); }
__device__ __forceinline__ float row16_sum(float v) { float a = v, b = v; asm volatile("s_nop 1\n\tv_permlane16_swap_b32 %0, %1\n\ts_nop 1" : "+v"(a), "+v"(b)); return a + b; }
__device__ __forceinline__ float wave_scan_incl(float v, int lane) {
#pragma unroll
    for (int o = 1; o < 64; o <<= 1) { const float t = __shfl_up(v, o); if (lane >= o) v += t; }
    return v;
}
__device__ __forceinline__ f32x4 mfma16(bf16x8 a, bf16x8 b, f32x4 c) { return __builtin_amdgcn_mfma_f32_16x16x32_bf16(a, b, c, 0, 0, 0); }
__device__ __forceinline__ f32x16 mfma32(bf16x8 a, bf16x8 b, f32x16 c) { return __builtin_amdgcn_mfma_f32_32x32x16_bf16(a, b, c, 0, 0, 0); }
__device__ __forceinline__ bf16x8 frag16(const bf16* base, int pitch, int row0, int k0, int lane) { return *(const bf16x8*)(base + (row0 + (lane & 15)) * pitch + k0 + 8 * (lane >> 4)); }
__device__ __forceinline__ bf16x8 frag16p(const bf16* base, int pitch, int row0, int k0, int lane) {
    const bf16* p = base + (row0 + (lane & 15)) * pitch + k0 + 4 * (lane >> 4);
    const bf16x4 lo = *(const bf16x4*)p, hi = *(const bf16x4*)(p + 16);
    return (bf16x8){lo[0], lo[1], lo[2], lo[3], hi[0], hi[1], hi[2], hi[3]};
}
__device__ __forceinline__ bf16x8 accpair(f32x4 a, f32x4 b) { u32x4 w; w.x = pk2(a[0], a[1]); w.y = pk2(a[2], a[3]); w.z = pk2(b[0], b[1]); w.w = pk2(b[2], b[3]); return __builtin_bit_cast(bf16x8, w); }

#define XB_TMO      128
#define XB_XCNT(j)  (256  + 64 * (j))
#define XB_XSUB(j)  (1280 + 64 * (j))
#define XB_XGEN(j)  (2304 + 64 * (j))
#define XB_TOP      3328
#define XB_TOPGEN   3392
#define XCD_BAR_WORDS 3456
#define XB_SPIN_CAP (1u << 18)

__device__ __forceinline__ unsigned xb_ld(unsigned* p)              { return __hip_atomic_load(p, __ATOMIC_RELAXED, __HIP_MEMORY_SCOPE_AGENT); }
__device__ __forceinline__ unsigned xb_add(unsigned* p, unsigned v) { return __hip_atomic_fetch_add(p, v, __ATOMIC_RELAXED, __HIP_MEMORY_SCOPE_AGENT); }
__device__ __forceinline__ unsigned xb_xcc_id() { return (unsigned)__builtin_amdgcn_s_getreg((3 << 11) | 20) & 0xFu; }
#define XB_SPIN(cond, bar) do { unsigned _sp = 0; while (cond) { __builtin_amdgcn_s_sleep(1); \
    if ((++_sp & 255u) == 0u) { if (xb_ld(&(bar)[XB_TMO])) break; if (_sp > XB_SPIN_CAP) { atomicAdd(&(bar)[XB_TMO], 1u); break; } } } } while (0)

struct XcdBarrier {
    unsigned* bar; unsigned x;
    volatile LAS unsigned* st;
};

__device__ __forceinline__ XcdBarrier xcd_barrier_post(unsigned* bar, volatile LAS unsigned* st) {
    XcdBarrier b; b.bar = bar; b.x = xb_xcc_id(); b.st = st;
    if (threadIdx.x == 0) (void)xb_add(&bar[XB_XCNT(b.x)], 1u);
    return b;
}
__device__ __forceinline__ void xcd_barrier_complete(unsigned* bar, unsigned x, unsigned& nloc, unsigned& nx) {
    const unsigned G = gridDim.x * gridDim.y * gridDim.z;
    unsigned sum, cnt, mine, sp = 0u;
    for (;;) {
        sum = 0u; cnt = 0u; mine = 0u;
#pragma unroll
        for (unsigned j = 0; j < 16; ++j) { const unsigned c = xb_ld(&bar[XB_XCNT(j)]); sum += c; cnt += (c > 0u) ? 1u : 0u; mine = (j == x) ? c : mine; }
        if (sum == G) break;
        __builtin_amdgcn_s_sleep(1);
        if ((++sp & 255u) == 0u) { if (xb_ld(&bar[XB_TMO])) break; if (sp > XB_SPIN_CAP) { atomicAdd(&bar[XB_TMO], 1u); break; } }
    }
    nloc = mine > 0u ? mine : 1u; nx = cnt > 0u ? cnt : 1u;
}

__device__ __forceinline__ void xcd_barrier(const XcdBarrier& b) {
    asm volatile("s_waitcnt vmcnt(0)" ::: "memory");
    __syncthreads();
    if (threadIdx.x == 0) {
        unsigned* bar = b.bar;
        __builtin_amdgcn_s_waitcnt(0);
        unsigned nloc = b.st[0], nx = b.st[1];
        if (nloc == 0u) { xcd_barrier_complete(bar, b.x, nloc, nx); b.st[0] = nloc; b.st[1] = nx; }
        const unsigned old = xb_add(&bar[XB_XSUB(b.x)], 1u);
        const unsigned gen = old / nloc;
        if (old + 1u == (gen + 1u) * nloc) {
            __builtin_amdgcn_fence(__ATOMIC_RELEASE, "agent");
            asm volatile("s_waitcnt vmcnt(0)" ::: "memory");
            const unsigned og = xb_add(&bar[XB_TOP], 1u);
            const unsigned tg = og / nx;
            if (og + 1u == (tg + 1u) * nx) xb_add(&bar[XB_TOPGEN], 1u);
            else XB_SPIN(xb_ld(&bar[XB_TOPGEN]) == tg, bar);
            __builtin_amdgcn_fence(__ATOMIC_ACQUIRE, "agent");
            xb_add(&bar[XB_XGEN(b.x)], 1u);
            asm volatile("s_waitcnt vmcnt(0)" ::: "memory");
        } else {
            XB_SPIN(xb_ld(&bar[XB_XGEN(b.x)]) == gen, bar);
            __builtin_amdgcn_fence(__ATOMIC_ACQUIRE, "agent");
            asm volatile("s_waitcnt vmcnt(0)" ::: "memory");
        }
    }
    __syncthreads();
}

struct KArgs { const float* in[N_IN]; float* out; unsigned char* ws; int ph_lo, ph_hi; };
#define WSP(T, off) ((T*)(ws + (off)))
#define CAS __attribute__((address_space(4)))
#define ENTER() const CAS KArgs* kp_ = (const CAS KArgs*)__builtin_amdgcn_kernarg_segment_ptr(); asm volatile("" : "+s"(kp_)); const CAS KArgs& a = *kp_; unsigned char* ws = a.ws; asm volatile("" : "+v"(tid)); const int lane = tid & 63, wave = __builtin_amdgcn_readfirstlane(tid >> 6); (void)lane; (void)wave

__device__ __forceinline__ int q_next(unsigned* ctr, volatile unsigned* slot, int tid) {
    __syncthreads();
    if (tid == 0) *slot = __hip_atomic_fetch_add(ctr, 1u, __ATOMIC_RELAXED, __HIP_MEMORY_SCOPE_AGENT);
    __syncthreads();
    return __builtin_amdgcn_readfirstlane((int)*slot);
}

__device__ __forceinline__ void tr_item(const float* W, int K, int N, int Npad, bf16* WT, float* scr, int item, int lane) {
    const int nblk = Npad / 32, kb = item / nblk, nb = item % nblk, k0 = 64 * kb, n0 = 32 * nb;
    const int n = n0 + (lane & 31);
#pragma unroll
    for (int i = 0; i < 32; ++i) { const int kk = 2 * i + (lane >> 5); scr[kk * 33 + (lane & 31)] = (n < N) ? W[(size_t)(k0 + kk) * N + n] : 0.f; }
    LDS_WAIT(); asm volatile("" ::: "memory");
    const int c = lane & 7;
#pragma unroll
    for (int j = 0; j < 4; ++j) { const int nn = (lane >> 3) + 8 * j; const float* s = scr + (8 * c) * 33 + nn;
        u32x4 o; o.x = pk2(s[0 * 33], s[1 * 33]); o.y = pk2(s[2 * 33], s[3 * 33]); o.z = pk2(s[4 * 33], s[5 * 33]); o.w = pk2(s[6 * 33], s[7 * 33]);
        *(u32x4*)(WT + (size_t)(n0 + nn) * K + k0 + 8 * c) = o; }
    LDS_WAIT(); asm volatile("" ::: "memory");
}
__device__ __forceinline__ void ln_row(const float* xrow, const float* g, const float* b, float* of32, bf16* obf, int lane) {
    f32x4 v[4]; float s = 0.f;
#pragma unroll
    for (int j = 0; j < 4; ++j) { v[j] = *(const f32x4*)(xrow + 4 * lane + 256 * j); s += (v[j].x + v[j].y) + (v[j].z + v[j].w); }
    const float mean = wave_sum(s) * (1.f / DM); float s2 = 0.f;
#pragma unroll
    for (int j = 0; j < 4; ++j) { v[j] = v[j] - mean; s2 += (v[j].x * v[j].x + v[j].y * v[j].y) + (v[j].z * v[j].z + v[j].w * v[j].w); }
    const float rstd = 1.f / sqrtf(wave_sum(s2) * (1.f / DM) + LN_EPS);
#pragma unroll
    for (int j = 0; j < 4; ++j) { const f32x4 gg = *(const f32x4*)(g + 4 * lane + 256 * j), bb = *(const f32x4*)(b + 4 * lane + 256 * j); const f32x4 o = v[j] * rstd * gg + bb;
        if (of32) *(f32x4*)(of32 + 4 * lane + 256 * j) = o;
        if (obf) { u32x2 w; w.x = pk2(o.x, o.y); w.y = pk2(o.z, o.w); *(u32x2*)(obf + 4 * lane + 256 * j) = w; } }
}
__device__ __forceinline__ void ln_row2(const float* x1, const float* x2, const float* g, const float* b, float* of1, bf16* ob1, float* of2, bf16* ob2, int lane) {
    f32x4 v[2][4]; float s[2] = {0.f, 0.f};
#pragma unroll
    for (int j = 0; j < 4; ++j) { v[0][j] = *(const f32x4*)(x1 + 4 * lane + 256 * j); v[1][j] = *(const f32x4*)(x2 + 4 * lane + 256 * j); }
#pragma unroll
    for (int r = 0; r < 2; ++r)
#pragma unroll
        for (int j = 0; j < 4; ++j) s[r] += (v[r][j].x + v[r][j].y) + (v[r][j].z + v[r][j].w);
    float rstd[2];
#pragma unroll
    for (int r = 0; r < 2; ++r) { const float mean = wave_sum(s[r]) * (1.f / DM); float s2 = 0.f;
#pragma unroll
        for (int j = 0; j < 4; ++j) { v[r][j] = v[r][j] - mean; s2 += (v[r][j].x * v[r][j].x + v[r][j].y * v[r][j].y) + (v[r][j].z * v[r][j].z + v[r][j].w * v[r][j].w); }
        rstd[r] = 1.f / sqrtf(wave_sum(s2) * (1.f / DM) + LN_EPS); }
#pragma unroll
    for (int j = 0; j < 4; ++j) { const f32x4 gg = *(const f32x4*)(g + 4 * lane + 256 * j), bb = *(const f32x4*)(b + 4 * lane + 256 * j);
#pragma unroll
        for (int r = 0; r < 2; ++r) { const f32x4 o = v[r][j] * rstd[r] * gg + bb; float* of = r ? of2 : of1; bf16* ob = r ? ob2 : ob1;
            if (of) *(f32x4*)(of + 4 * lane + 256 * j) = o;
            if (ob) { u32x2 w; w.x = pk2(o.x, o.y); w.y = pk2(o.z, o.w); *(u32x2*)(ob + 4 * lane + 256 * j) = w; } } }
}
__device__ __forceinline__ void ph_prologue(unsigned char* lds, int tid, int bid, int G) { ENTER();
    float* scr = (float*)(lds + wave * 8448);
    const int gw = bid * NWAVES + wave, NGW = G * NWAVES, gt = bid * NTHR + tid, NGT = G * NTHR;
    constexpr int IT_IN = 16 * 184, IT_OUT = 32 * 32, IT_UQ = 6 * 24, IT_UK = 4 * 16, IT_L = IT_IN + IT_OUT + IT_UQ + 2 * IT_UK;
    for (int it = gw; it < 2 * IT_L; it += NGW) {
        const int l = it / IT_L; int r = it % IT_L;
        if (r < IT_IN) { tr_item(a.in[I_WIN] + (size_t)l * DM * INW, DM, INW, INWP, WSP(bf16, WS_WIN) + (size_t)l * INWP * DM, scr, r, lane); continue; } r -= IT_IN;
        if (r < IT_OUT) { tr_item(a.in[I_WOUT] + (size_t)l * MIXW * DM, MIXW, DM, DM, WSP(bf16, WS_WOUT) + (size_t)l * DM * MIXW, scr, r, lane); continue; } r -= IT_OUT;
        if (r < IT_UQ) { tr_item(a.in[I_WUQ] + (size_t)l * 384 * 768, 384, 768, 768, WSP(bf16, WS_WUQ) + (size_t)l * 768 * 384, scr, r, lane); continue; } r -= IT_UQ;
        if (r < IT_UK) { tr_item(a.in[I_WUK] + (size_t)l * 256 * 512, 256, 512, 512, WSP(bf16, WS_WUK) + (size_t)l * 512 * 256, scr, r, lane); continue; } r -= IT_UK;
        tr_item(a.in[I_WUV] + (size_t)l * 256 * 512, 256, 512, 512, WSP(bf16, WS_WUV) + (size_t)l * 512 * 256, scr, r, lane);
    }
    for (int e = gt; e < 2 * 2048 * 384; e += NGT) {
        const int k = e % 384, n = (e / 384) % 2048, l = e / (384 * 2048), h = n >> 8, r = n & 255;
        const float* pq = a.in[I_WUQ] + ((size_t)l * 384 + k) * 768 + h * 96; const float* pk = a.in[I_WUK] + ((size_t)l * 256 + r) * 512 + h * 64;
        float s = 0.f;
#pragma unroll 4
        for (int d = 0; d < 64; d += 4) { const f32x4 x = *(const f32x4*)(pq + d), y = *(const f32x4*)(pk + d); s += x.x * y.x + x.y * y.y + x.z * y.z + x.w * y.w; }
        WSP(bf16, WS_WABS)[e] = f2bf(s);
    }
    for (int e = gt; e < MT * 16; e += NGT) {
        const int i = e & 15, m = e >> 4; const int pos = (m < NP) ? (m & (SEQ - 1)) : (PASTL + ((m - NP) & 3));
        const float inv = powf(10000.f, -(float)i * (1.f / 16.f)); const float ang = (float)pos * inv;
        float sn, cs; sincosf(ang, &sn, &cs);
        WSP(float, WS_ROPECS)[m * 32 + i] = cs; WSP(float, WS_ROPECS)[m * 32 + 16 + i] = sn;
    }
    for (int m = gw; m < MT; m += 2 * NGW) {
        const int m2 = m + NGW; const bool has2 = m2 < MT; const int mm2 = has2 ? m2 : m;
        const float* xr = (m < NP) ? a.in[I_XP] + (size_t)m * DM : a.in[I_XS] + (size_t)(m - NP) * DM;
        const float* xr2 = (mm2 < NP) ? a.in[I_XP] + (size_t)mm2 * DM : a.in[I_XS] + (size_t)(mm2 - NP) * DM;
        ln_row2(xr, xr2, a.in[I_EG], a.in[I_EB], WSP(float, WS_XF) + (size_t)m * DM, WSP(bf16, WS_XN) + (size_t)m * DM, WSP(float, WS_XF) + (size_t)mm2 * DM, WSP(bf16, WS_XN) + (size_t)mm2 * DM, lane);
    }
}

__device__ __forceinline__ void e1_unit(int l, int unit, int tid) { ENTER();
    const bf16* PROJ = WSP(bf16, WS_PROJ); const float* RC = WSP(float, WS_ROPECS);
    const int m0 = unit * 32 + wave * 4;
    {
        unsigned w[4][3];
#pragma unroll
        for (int i = 0; i < 4; ++i) { const bf16* pr = PROJ + (size_t)(m0 + i) * INWP + O_CQ + 2 * lane; w[i][0] = *(const unsigned*)pr; w[i][1] = *(const unsigned*)(pr + 128); w[i][2] = *(const unsigned*)(pr + 256); }
        const float* nw = a.in[I_QNW] + l * 384 + 2 * lane; const float n0 = nw[0], n1 = nw[1], n2 = nw[128], n3 = nw[129], n4 = nw[256], n5 = nw[257];
#pragma unroll
        for (int i = 0; i < 4; ++i) { const float x0 = bflo(w[i][0]), x1 = bfhi(w[i][0]), x2 = bflo(w[i][1]), x3 = bfhi(w[i][1]), x4 = bflo(w[i][2]), x5 = bfhi(w[i][2]);
            const float r = 1.f / sqrtf(wave_sum(x0 * x0 + x1 * x1 + x2 * x2 + x3 * x3 + x4 * x4 + x5 * x5) * (1.f / 384.f) + RMS_EPS);
            bf16* o = WSP(bf16, WS_CQN) + (size_t)(m0 + i) * 384 + 2 * lane;
            *(unsigned*)(o) = pk2(x0 * r * n0, x1 * r * n1); *(unsigned*)(o + 128) = pk2(x2 * r * n2, x3 * r * n3); *(unsigned*)(o + 256) = pk2(x4 * r * n4, x5 * r * n5); }
    }
    {
        u32x2 w[4];
#pragma unroll
        for (int i = 0; i < 4; ++i) w[i] = *(const u32x2*)(PROJ + (size_t)(m0 + i) * INWP + O_CKV + 4 * lane);
        const f32x4 nw = *(const f32x4*)(a.in[I_KVNW] + l * 256 + 4 * lane);
#pragma unroll
        for (int i = 0; i < 4; ++i) { const int m = m0 + i; const float x0 = bflo(w[i].x), x1 = bfhi(w[i].x), x2 = bflo(w[i].y), x3 = bfhi(w[i].y);
            const float r = 1.f / sqrtf(wave_sum(x0 * x0 + x1 * x1 + x2 * x2 + x3 * x3) * (1.f / 256.f) + RMS_EPS);
            const f32x4 v = (f32x4){x0 * r * nw.x, x1 * r * nw.y, x2 * r * nw.z, x3 * r * nw.w};
            float* o = (m >= NP) ? a.out + OUT_SLAT + ((size_t)l * NS + (m - NP)) * 256 : a.out + OUT_PLAT + ((size_t)l * NP + m) * 256;
            *(f32x4*)(o + 4 * lane) = v;
            u32x2 ww; ww.x = pk2(v.x, v.y); ww.y = pk2(v.z, v.w); *(u32x2*)(WSP(bf16, WS_CKVN) + (size_t)m * 256 + 4 * lane) = ww; }
    }
    {
        const int i = lane >> 4, j = lane & 15, m = m0 + i; const bf16* pr = PROJ + (size_t)m * INWP + O_KR;
        const float x1 = bf2f(pr[j]), x2 = bf2f(pr[16 + j]), c = RC[m * 32 + j], s = RC[m * 32 + 16 + j];
        const float o1 = x1 * c - x2 * s, o2 = x2 * c + x1 * s; const bool samp = m >= NP;
        float* o = samp ? a.out + OUT_SROPE + ((size_t)l * NS + (m - NP)) * 32 : a.out + OUT_PROPE + ((size_t)l * NP + m) * 32;
        o[j] = o1; o[16 + j] = o2;
        const bf16 b1 = f2bf(o1), b2 = f2bf(o2);
        bf16* kr = WSP(bf16, WS_KROPE) + (size_t)m * 32; kr[j] = b1; kr[16 + j] = b2;
        if (!samp) { bf16* kk = WSP(bf16, WS_KK) + (size_t)m * 768 + 64;
#pragma unroll
            for (int h = 0; h < 8; ++h) { kk[h * 96 + j] = b1; kk[h * 96 + 16 + j] = b2; } }
    }
    for (int i = 0; i < 4; ++i) {
        const int m = m0 + i; const bool samp = m >= NP; const int sb = samp ? (m - NP) >> 2 : m >> 11, st = samp ? (m - NP) & 3 : m & (SEQ - 1), T = samp ? DSQ : SEQ;
        if (st >= T - 3) { const int j = st - (T - 3); const bf16* pr = PROJ + (size_t)m * INWP;
            float* o1 = samp ? a.out + OUT_SSC + ((size_t)(l * NSB + sb) * 3 + j) * 1536 : a.out + OUT_PSC + ((size_t)(l * NPB + sb) * 3 + j) * 1536;
            float* o2 = samp ? a.out + OUT_SGC + ((size_t)(l * NSB + sb) * 3 + j) * 1536 : a.out + OUT_PGC + ((size_t)(l * NPB + sb) * 3 + j) * 1536;
            for (int c = 2 * lane; c < 1536; c += 128) {
                const unsigned w1 = *(const unsigned*)(pr + O_XBC + c), w2 = *(const unsigned*)(pr + O_GQKV + c);
                o1[c] = bflo(w1); o1[c + 1] = bfhi(w1); o2[c] = bflo(w2); o2[c + 1] = bfhi(w2); } }
    }
}

template <int NR, bool SILU_BIAS>
__device__ __forceinline__ void conv_pair(const bf16* colp  , int r0, bool first, const float* wp  , const float* bp  , f32x2 (&y)[NR]) {
    f32x2 w[4];
#pragma unroll
    for (int j = 0; j < 4; ++j) w[j] = (f32x2){wp[j * 1536], wp[j * 1536 + 1]};
    const f32x2 bias = bp ? (f32x2){bp[0], bp[1]} : (f32x2){0.f, 0.f};
    f32x2 h[3];
#pragma unroll
    for (int j = 0; j < 3; ++j) { const int r = r0 - 3 + j; unsigned v = 0u; if (!(first && r < 0)) v = *(const unsigned*)(colp + (long)r * INWP); h[j] = (f32x2){bflo(v), bfhi(v)}; }
#pragma unroll
    for (int i = 0; i < NR; ++i) {
        const unsigned v = *(const unsigned*)(colp + (long)(r0 + i) * INWP); const f32x2 cur = (f32x2){bflo(v), bfhi(v)};
        f32x2 s = w[0] * h[0] + w[1] * h[1] + w[2] * h[2] + w[3] * cur + bias;
        y[i] = (f32x2){silu_f(s.x), silu_f(s.y)};
        h[0] = h[1]; h[1] = h[2]; h[2] = cur;
    }
}


template <int NR>
__device__ __forceinline__ void conv_load(const bf16* colp, int r0, bool first, unsigned (&raw)[NR + 3]) {
#pragma unroll
    for (int j = 0; j < 3; ++j) { const int r = r0 - 3 + j; unsigned v = 0u; if (!(first && r < 0)) v = *(const unsigned*)(colp + (long)r * INWP); raw[j] = v; }
#pragma unroll
    for (int i = 0; i < NR; ++i) raw[3 + i] = *(const unsigned*)(colp + (long)(r0 + i) * INWP);
}
template <int NR>
__device__ __forceinline__ void conv_apply(const unsigned (&raw)[NR + 3], const float* wp, const float* bp, f32x2 (&y)[NR]) {
    f32x2 w[4];
#pragma unroll
    for (int j = 0; j < 4; ++j) w[j] = (f32x2){wp[j * 1536], wp[j * 1536 + 1]};
    const f32x2 bias = bp ? (f32x2){bp[0], bp[1]} : (f32x2){0.f, 0.f};
#pragma unroll
    for (int i = 0; i < NR; ++i) {
        const f32x2 h0 = (f32x2){bflo(raw[i]), bfhi(raw[i])}, h1 = (f32x2){bflo(raw[i + 1]), bfhi(raw[i + 1])}, h2 = (f32x2){bflo(raw[i + 2]), bfhi(raw[i + 2])}, cur = (f32x2){bflo(raw[i + 3]), bfhi(raw[i + 3])};
        const f32x2 s = w[0] * h0 + w[1] * h1 + w[2] * h2 + w[3] * cur + bias;
        y[i] = (f32x2){silu_f(s.x), silu_f(s.y)};
    }
}

__device__ __forceinline__ void ssd_s1_unit(int l, int unit, unsigned char* lds, int tid) { ENTER();
    const int g = unit & 1, c = (unit >> 1) & 15, b = unit >> 5, tok0 = b * SEQ + c * 128, q4 = lane >> 4, l15 = lane & 15;
    constexpr int PB = 136;
    const bf16* PROJ = WSP(bf16, WS_PROJ);
    bf16* Bs = (bf16*)lds; bf16* Cs = (bf16*)(lds + 34816); bf16* BT = (bf16*)(lds + 69632);
    float* dts = (float*)(lds + 104448); float* acs = dts + 1024; float* wds = acs + 1024; float* rds = wds + 1024;
    const float* cw = a.in[I_SCW] + (size_t)l * 4 * 1536; const float* cb = a.in[I_SCB] + (size_t)l * 1536;
    {
        const int h = 8 * g + wave; const float dtb = a.in[I_SDTB][l * 16 + h], A = -__expf(a.in[I_SALOG][l * 16 + h]);
        const float r0 = bf2f(PROJ[(size_t)(tok0 + 2 * lane) * INWP + O_DT + h]), r1 = bf2f(PROJ[(size_t)(tok0 + 2 * lane + 1) * INWP + O_DT + h]);
        const float d0 = softplus_f(r0 + dtb), d1 = softplus_f(r1 + dtb), a0 = d0 * A, a1 = d1 * A;
        const float incl = wave_scan_incl(a0 + a1, lane), last = __shfl(incl, 63), ac0 = incl - a1, ac1 = incl;
        const int o = wave * 128 + 2 * lane;
        dts[o] = d0; dts[o + 1] = d1; acs[o] = ac0; acs[o + 1] = ac1; wds[o] = __expf(last - ac0); wds[o + 1] = __expf(last - ac1); rds[o] = 1.f / d0; rds[o + 1] = 1.f / d1;
        float* ACUM = WSP(float, WS_ACUM); ACUM[(size_t)(tok0 + 2 * lane) * 16 + h] = ac0; ACUM[(size_t)(tok0 + 2 * lane + 1) * 16 + h] = ac1;
    }
    {
        const int cp = 2 * lane, r0 = 16 * wave, chB = 1024 + g * 128 + cp, chC = 1280 + g * 128 + cp;
        unsigned rb[19], rc[19];
        conv_load<16>(PROJ + (size_t)tok0 * INWP + O_XBC + chB, r0, c == 0, rb); conv_load<16>(PROJ + (size_t)tok0 * INWP + O_XBC + chC, r0, c == 0, rc);
        f32x2 y[16];
        conv_apply<16>(rb, cw + chB, cb + chB, y);
#pragma unroll
        for (int i = 0; i < 16; ++i) { const int s = r0 + i; *(unsigned*)(Bs + s * PB + cp) = pk2(y[i].x, y[i].y); BT[cp * PB + s] = f2bf(y[i].x); BT[(cp + 1) * PB + s] = f2bf(y[i].y); }
        conv_apply<16>(rc, cw + chC, cb + chC, y);
        bf16* CC = WSP(bf16, WS_CC);
#pragma unroll
        for (int i = 0; i < 16; ++i) { const int t = r0 + i; const unsigned w = pk2(y[i].x, y[i].y); *(unsigned*)(Cs + t * PB + cp) = w; *(unsigned*)(CC + (size_t)(tok0 + t) * 256 + g * 128 + cp) = w; }
    }
    __syncthreads();
    f32x4 gacc[8];
#pragma unroll
    for (int sb = 0; sb < 8; ++sb) { gacc[sb] = (f32x4){0.f, 0.f, 0.f, 0.f};
        if (sb <= wave) {
#pragma unroll
            for (int ks = 0; ks < 4; ++ks) gacc[sb] = mfma16(frag16(Bs, PB, 16 * sb, 32 * ks, lane), frag16(Cs, PB, 16 * wave, 32 * ks, lane), gacc[sb]); } }
    __syncthreads();
    float* YI = WSP(float, WS_YI); float* HLOC = WSP(float, WS_HLOC);
    bf16* XTb = (bf16*)lds;
    unsigned xraw[11];
    const int xcp = 2 * (tid & 31), xr0 = 8 * (tid >> 5);
    conv_load<8>(PROJ + (size_t)tok0 * INWP + O_XBC + (8 * g) * 64 + xcp, xr0, c == 0, xraw);
    { f32x2 y[8]; const int ch = (8 * g) * 64 + xcp; conv_apply<8>(xraw, cw + ch, cb + ch, y);
      conv_load<8>(PROJ + (size_t)tok0 * INWP + O_XBC + ch + 64, xr0, c == 0, xraw);
#pragma unroll
      for (int i = 0; i < 8; ++i) { const int t = xr0 + i; const float dt = dts[t]; XTb[xcp * PB + t] = f2bf(y[i].x * dt); XTb[(xcp + 1) * PB + t] = f2bf(y[i].y * dt); } }
    __syncthreads();
    for (int hh = 0; hh < 8; ++hh) {
        const int h = 8 * g + hh; const float Dh = a.in[I_SD][l * 16 + h];
        const bf16* XT = XTb + (hh & 1) * (64 * PB);
        const int t = 16 * wave + l15; const float at = acs[hh * 128 + t], rd = rds[hh * 128 + t];
        bf16x8 scf[4];
#pragma unroll
        for (int ks = 0; ks < 4; ++ks) { f32x4 v0, v1;
#pragma unroll
            for (int r = 0; r < 4; ++r) { const int s0 = 32 * ks + 4 * q4 + r, s1 = s0 + 16;
                v0[r] = (2 * ks <= wave && s0 <= t) ? gacc[2 * ks][r] * __expf(fminf(at - acs[hh * 128 + s0], 0.f)) : 0.f;
                v1[r] = (2 * ks + 1 <= wave && s1 <= t) ? gacc[2 * ks + 1][r] * __expf(fminf(at - acs[hh * 128 + s1], 0.f)) : 0.f; }
            scf[ks] = accpair(v0, v1); }
#pragma unroll
        for (int pb = 0; pb < 4; ++pb) { f32x4 acc = (f32x4){0.f, 0.f, 0.f, 0.f};
#pragma unroll
            for (int ks = 0; ks < 4; ++ks) if (2 * ks <= wave) acc = mfma16(frag16p(XT, PB, 16 * pb, 32 * ks, lane), scf[ks], acc);
            const int p0 = 16 * pb + 4 * q4; f32x4 o;
#pragma unroll
            for (int r = 0; r < 4; ++r) o[r] = acc[r] + Dh * bf2f(XT[(p0 + r) * PB + t]) * rd;
            *(f32x4*)(YI + (size_t)(tok0 + t) * 1024 + h * 64 + p0) = o; }
        {
            float* hl = HLOC + (size_t)((b * 16 + c) * 16 + h) * 8192;
            bf16x8 bw[4];
#pragma unroll
            for (int ks = 0; ks < 4; ++ks) { const u32x4 w = __builtin_bit_cast(u32x4, frag16(BT, PB, 16 * wave, 32 * ks, lane));
                const f32x4 d0 = *(const f32x4*)(wds + hh * 128 + 32 * ks + 8 * q4), d1 = *(const f32x4*)(wds + hh * 128 + 32 * ks + 8 * q4 + 4);
                u32x4 o; o.x = pk2(bflo(w.x) * d0.x, bfhi(w.x) * d0.y); o.y = pk2(bflo(w.y) * d0.z, bfhi(w.y) * d0.w); o.z = pk2(bflo(w.z) * d1.x, bfhi(w.z) * d1.y); o.w = pk2(bflo(w.w) * d1.z, bfhi(w.w) * d1.w);
                bw[ks] = __builtin_bit_cast(bf16x8, o); }
#pragma unroll
            for (int pb = 0; pb < 4; ++pb) { f32x4 acc = (f32x4){0.f, 0.f, 0.f, 0.f};
#pragma unroll
                for (int ks = 0; ks < 4; ++ks) acc = mfma16(bw[ks], frag16(XT, PB, 16 * pb, 32 * ks, lane), acc);
                *(f32x4*)(hl + (16 * pb + l15) * 128 + 16 * wave + 4 * q4) = acc; }
        }
        if (hh < 7) {
            f32x2 y[8]; const int ch = (h + 1) * 64 + xcp; conv_apply<8>(xraw, cw + ch, cb + ch, y);
            if (hh < 6) conv_load<8>(PROJ + (size_t)tok0 * INWP + O_XBC + ch + 64, xr0, c == 0, xraw);
            bf16* XN = XTb + ((hh + 1) & 1) * (64 * PB);
#pragma unroll
            for (int i = 0; i < 8; ++i) { const int tt = xr0 + i; const float dt = dts[(hh + 1) * 128 + tt]; XN[xcp * PB + tt] = f2bf(y[i].x * dt); XN[(xcp + 1) * PB + tt] = f2bf(y[i].y * dt); }
        }
        __syncthreads();
    }
}

__device__ __forceinline__ void ssd_sample_unit(int l, int unit, unsigned char* lds, int tid) { ENTER();
    const int g = unit & 1, b = unit >> 1, m0 = NP + 4 * b;
    const bf16* PROJ = WSP(bf16, WS_PROJ);
    float* xs = (float*)lds; float* Bv = xs + 2048; float* Cv = Bv + 512; float* ygs = Cv + 512; float* cbm = ygs + 2048; float* dtv = cbm + 16; float* acv = dtv + 32; float* yst = acv + 32;
    for (int idx = tid; idx < 768; idx += NTHR) {
        int ch; float* dst; int ds;
        if (idx < 512) { ch = g * 512 + idx; dst = xs + idx; ds = 512; } else if (idx < 640) { ch = 1024 + g * 128 + (idx - 512); dst = Bv + (idx - 512); ds = 128; } else { ch = 1280 + g * 128 + (idx - 640); dst = Cv + (idx - 640); ds = 128; }
        float xp[7];
#pragma unroll
        for (int j = 0; j < 3; ++j) xp[j] = a.in[I_SSC][((size_t)(l * NSB + b) * 3 + j) * 1536 + ch];
#pragma unroll
        for (int t = 0; t < 4; ++t) xp[3 + t] = bf2f(PROJ[(size_t)(m0 + t) * INWP + O_XBC + ch]);
        const float bias = a.in[I_SCB][l * 1536 + ch]; float w[4];
#pragma unroll
        for (int j = 0; j < 4; ++j) w[j] = a.in[I_SCW][(size_t)(l * 4 + j) * 1536 + ch];
#pragma unroll
        for (int t = 0; t < 4; ++t) dst[t * ds] = silu_f(w[0] * xp[t] + w[1] * xp[t + 1] + w[2] * xp[t + 2] + w[3] * xp[t + 3] + bias);
    }
    if (tid < 32) { const int hh = tid >> 2, t = tid & 3, h = 8 * g + hh; const float dtb = a.in[I_SDTB][l * 16 + h], A = -__expf(a.in[I_SALOG][l * 16 + h]); float ac = 0.f, dt = 0.f;
        for (int j = 0; j < 4; ++j) { const float d = softplus_f(bf2f(PROJ[(size_t)(m0 + j) * INWP + O_DT + h]) + dtb); if (j <= t) { ac += d * A; dt = d; } }
        dtv[hh * 4 + t] = dt; acv[hh * 4 + t] = ac; }
    __syncthreads();
    {
#pragma unroll
        for (int k = 0; k < 2; ++k) { const int pr = 2 * wave + k, t = pr >> 2, s = pr & 3;
            const float v = wave_sum(Cv[t * 128 + lane] * Bv[s * 128 + lane] + Cv[t * 128 + 64 + lane] * Bv[s * 128 + 64 + lane]); if (lane == 0) cbm[pr] = v; }
    }
    __syncthreads();
    for (int hh = 0; hh < 8; ++hh) {
        const int h = 8 * g + hh, p = tid >> 3, n0 = (tid & 7) * 16;
        const float* hin = a.in[I_SSD] + ((size_t)((l * NSB + b) * 16 + h) * 64 + p) * 128 + n0;
        float* hout = a.out + OUT_SSSD + ((size_t)((l * NSB + b) * 16 + h) * 64 + p) * 128 + n0;
        float h0[16];
#pragma unroll
        for (int i = 0; i < 4; ++i) { const f32x4 v = *(const f32x4*)(hin + 4 * i); h0[4 * i] = v.x; h0[4 * i + 1] = v.y; h0[4 * i + 2] = v.z; h0[4 * i + 3] = v.w; }
        const float ac3 = acv[hh * 4 + 3];
#pragma unroll
        for (int t = 0; t < 4; ++t) { float s = 0.f;
#pragma unroll
            for (int i = 0; i < 16; ++i) s += Cv[t * 128 + n0 + i] * h0[i];
            s += __shfl_xor(s, 1); s += __shfl_xor(s, 2); s += __shfl_xor(s, 4);
            if ((tid & 7) == 0) yst[t * 64 + p] = s; }
        float hn[16]; const float e3 = __expf(ac3);
#pragma unroll
        for (int i = 0; i < 16; ++i) hn[i] = e3 * h0[i];
#pragma unroll
        for (int s = 0; s < 4; ++s) { const float cf = __expf(ac3 - acv[hh * 4 + s]) * dtv[hh * 4 + s] * xs[s * 512 + hh * 64 + p];
#pragma unroll
            for (int i = 0; i < 16; ++i) hn[i] += cf * Bv[s * 128 + n0 + i]; }
#pragma unroll
        for (int i = 0; i < 4; ++i) *(f32x4*)(hout + 4 * i) = (f32x4){hn[4 * i], hn[4 * i + 1], hn[4 * i + 2], hn[4 * i + 3]};
        __syncthreads();
        if (tid < 256) { const int t = tid >> 6, pp = tid & 63; const float at = acv[hh * 4 + t]; float y = __expf(at) * yst[t * 64 + pp] + a.in[I_SD][l * 16 + h] * xs[t * 512 + hh * 64 + pp];
            for (int s = 0; s <= t; ++s) y += cbm[t * 4 + s] * __expf(at - acv[hh * 4 + s]) * dtv[hh * 4 + s] * xs[s * 512 + hh * 64 + pp];
            const float z = bf2f(PROJ[(size_t)(m0 + t) * INWP + O_SSDZ + h * 64 + pp]);
            ygs[t * 512 + hh * 64 + pp] = y * silu_f(z); }
        __syncthreads();
    }
    if (wave < 4) { const int t = wave; float ss = 0.f;
#pragma unroll
        for (int j = 0; j < 8; ++j) { const float v = ygs[t * 512 + lane + 64 * j]; ss += v * v; }
        const float rs = 1.f / sqrtf(wave_sum(ss) * (1.f / 512.f) + RMS_EPS);
        bf16* mx = WSP(bf16, WS_MIX) + (size_t)(m0 + t) * MIXW + g * 512;
#pragma unroll
        for (int j = 0; j < 8; ++j) { const int cidx = lane + 64 * j; mx[cidx] = f2bf(ygs[t * 512 + cidx] * rs * a.in[I_SNW][l * 1024 + g * 512 + cidx]); } }
}

__device__ __forceinline__ void gdn_sample_unit(int l, int unit, unsigned char* lds, int tid) { ENTER();
    const int h = unit & 3, b = unit >> 2, m0 = NP + 4 * b;
    const bf16* PROJ = WSP(bf16, WS_PROJ);
    float* qv = (float*)lds; float* kv = qv + 512; float* vv = kv + 512; float* pa = vv + 512; float* pb = pa + 512; float* ot = pb + 512; float* bet = ot + 512; float* gex = bet + 4;
    if (tid < 384) { const int which = tid >> 7, d = tid & 127, ch = which * 512 + h * 128 + d; float xp[7];
#pragma unroll
        for (int j = 0; j < 3; ++j) xp[j] = a.in[I_SGC][((size_t)(l * NSB + b) * 3 + j) * 1536 + ch];
#pragma unroll
        for (int t = 0; t < 4; ++t) xp[3 + t] = bf2f(PROJ[(size_t)(m0 + t) * INWP + O_GQKV + ch]);
        float w[4];
#pragma unroll
        for (int j = 0; j < 4; ++j) w[j] = a.in[I_GCW][(size_t)(l * 4 + j) * 1536 + ch];
        float* dst = qv + which * 512 + d;
#pragma unroll
        for (int t = 0; t < 4; ++t) dst[t * 128] = silu_f(w[0] * xp[t] + w[1] * xp[t + 1] + w[2] * xp[t + 2] + w[3] * xp[t + 3]);
    } else if (tid < 392) { const int t = (tid - 384) & 3;
        if (tid < 388) bet[t] = sigmoid_f(bf2f(PROJ[(size_t)(m0 + t) * INWP + O_GB + h]));
        else gex[t] = __expf(-__expf(a.in[I_GALOG][l * 4 + h]) * softplus_f(bf2f(PROJ[(size_t)(m0 + t) * INWP + O_GA + h]) + a.in[I_GDTB][l * 4 + h])); }
    __syncthreads();
    { const int t = wave >> 1, which = wave & 1; float* arr = (which ? kv : qv) + t * 128; const float v0 = arr[lane], v1 = arr[64 + lane];
      const float sc = (1.f / sqrtf(wave_sum(v0 * v0 + v1 * v1) + L2_EPS)) * (which ? 1.f : 0.08838834764831845f); arr[lane] = v0 * sc; arr[64 + lane] = v1 * sc; }
    __syncthreads();
    const int e = tid & 127, dq = tid >> 7;
    const float* sin_ = a.in[I_SGDN] + ((size_t)((l * NSB + b) * 4 + h) * 128 + 32 * dq) * 128 + e;
    float S[32];
#pragma unroll
    for (int i = 0; i < 32; ++i) S[i] = sin_[(size_t)i * 128];
    for (int t = 0; t < 4; ++t) {
        float ks = 0.f;
#pragma unroll
        for (int i = 0; i < 32; ++i) ks += kv[t * 128 + 32 * dq + i] * S[i];
        pa[dq * 128 + e] = ks; __syncthreads();
        const float kS = (pa[e] + pa[128 + e]) + (pa[256 + e] + pa[384 + e]);
        const float bt = bet[t], ge = gex[t], ve = vv[t * 128 + e]; float os = 0.f;
#pragma unroll
        for (int i = 0; i < 32; ++i) { const float ki = kv[t * 128 + 32 * dq + i]; S[i] = ge * (S[i] - bt * ki * kS) + bt * ki * ve; os += qv[t * 128 + 32 * dq + i] * S[i]; }
        pb[dq * 128 + e] = os; __syncthreads();
        if (dq == 0) ot[t * 128 + e] = (pb[e] + pb[128 + e]) + (pb[256 + e] + pb[384 + e]);
    }
    __syncthreads();
    if (wave < 4) { const int t = wave; const float o0 = ot[t * 128 + lane], o1 = ot[t * 128 + 64 + lane];
        const float rs = 1.f / sqrtf(wave_sum(o0 * o0 + o1 * o1) * (1.f / 128.f) + RMS_EPS);
        const bf16* zr = PROJ + (size_t)(m0 + t) * INWP + O_GZ + h * 128; const float* nw = a.in[I_GNW] + l * 128;
        bf16* mx = WSP(bf16, WS_MIX) + (size_t)(m0 + t) * MIXW + 1536 + h * 128;
        mx[lane] = f2bf(o0 * rs * nw[lane] * silu_f(bf2f(zr[lane]))); mx[64 + lane] = f2bf(o1 * rs * nw[64 + lane] * silu_f(bf2f(zr[64 + lane]))); }
    float* so = a.out + OUT_SGDN + ((size_t)((l * NSB + b) * 4 + h) * 128 + 32 * dq) * 128 + e;
#pragma unroll
    for (int i = 0; i < 32; ++i) so[(size_t)i * 128] = S[i];
}

__device__ __forceinline__ void gdn_prep_unit(int l, int u, unsigned char* lds, int tid) { ENTER();
    const int h = u & 3, c = (u >> 2) & 31, b = u >> 7, tok0 = b * SEQ + c * 64, q4 = lane >> 4, l15 = lane & 15;
    const bf16* PROJ = WSP(bf16, WS_PROJ);
    bf16* Ks = (bf16*)lds; bf16* KBs = (bf16*)(lds + 17408); bf16* Qs = (bf16*)(lds + 34816); bf16* VBT = (bf16*)(lds + 52224); bf16* KBGT = (bf16*)(lds + 70656); bf16* KDTs = (bf16*)(lds + 89088);
    float* Am = (float*)(lds + 107520); bf16* Ts = (bf16*)(lds + 124928); float* gcs = (float*)(lds + 134144); float* bts = gcs + 64;
    if (wave == 0) {
        const float rb = bf2f(PROJ[(size_t)(tok0 + lane) * INWP + O_GB + h]), ra = bf2f(PROJ[(size_t)(tok0 + lane) * INWP + O_GA + h]);
        const float gt = -__expf(a.in[I_GALOG][l * 4 + h]) * softplus_f(ra + a.in[I_GDTB][l * 4 + h]);
        gcs[lane] = wave_scan_incl(gt, lane); bts[lane] = sigmoid_f(rb);
    }
    __syncthreads();
    {
        const int cp = 2 * lane, r0 = 8 * wave; const float* cw = a.in[I_GCW] + (size_t)l * 4 * 1536; const float glast = gcs[63];
        f32x2 q[8], k[8], v[8];
        { unsigned rq[11], rk[11], rv[11];
          conv_load<8>(PROJ + (size_t)tok0 * INWP + O_GQKV + h * 128 + cp, r0, c == 0, rq); conv_load<8>(PROJ + (size_t)tok0 * INWP + O_GQKV + 512 + h * 128 + cp, r0, c == 0, rk);
          conv_load<8>(PROJ + (size_t)tok0 * INWP + O_GQKV + 1024 + h * 128 + cp, r0, c == 0, rv);
          conv_apply<8>(rq, cw + h * 128 + cp, nullptr, q); conv_apply<8>(rk, cw + 512 + h * 128 + cp, nullptr, k); conv_apply<8>(rv, cw + 1024 + h * 128 + cp, nullptr, v); }
        bf16* QG = WSP(bf16, WS_GQG) + (size_t)u * 8192;
#pragma unroll
        for (int i = 0; i < 8; ++i) { const int t = r0 + i;
            const float sq = 0.08838834764831845f / sqrtf(wave_sum(q[i].x * q[i].x + q[i].y * q[i].y) + L2_EPS), sk = 1.f / sqrtf(wave_sum(k[i].x * k[i].x + k[i].y * k[i].y) + L2_EPS);
            const float q0 = q[i].x * sq, q1 = q[i].y * sq, k0 = k[i].x * sk, k1 = k[i].y * sk, bt = bts[t], gc = gcs[t], eg = __expf(gc), ed = __expf(glast - gc);
            *(unsigned*)(Ks + t * 136 + cp) = pk2(k0, k1); *(unsigned*)(KBs + t * 136 + cp) = pk2(k0 * bt, k1 * bt); *(unsigned*)(Qs + t * 136 + cp) = pk2(q0, q1);
            VBT[cp * 72 + t] = f2bf(v[i].x * bt); VBT[(cp + 1) * 72 + t] = f2bf(v[i].y * bt);
            KBGT[cp * 72 + t] = f2bf(k0 * bt * eg); KBGT[(cp + 1) * 72 + t] = f2bf(k1 * bt * eg);
            KDTs[cp * 72 + t] = f2bf(k0 * ed); KDTs[(cp + 1) * 72 + t] = f2bf(k1 * ed);
            *(unsigned*)(QG + t * 128 + cp) = pk2(q0 * eg, q1 * eg); }
    }
    __syncthreads();
    bf16* ATT = WSP(bf16, WS_GATT) + (size_t)u * 4096;
    for (int item = wave; item < 26; item += 8) {
        if (item < 10) {
            const int tb = item >= 6 ? 3 : item >= 3 ? 2 : item >= 1 ? 1 : 0, sb = item - tb * (tb + 1) / 2;
            f32x4 acc = (f32x4){0.f, 0.f, 0.f, 0.f};
#pragma unroll
            for (int ks = 0; ks < 4; ++ks) acc = mfma16(frag16(KBs, 136, 16 * tb, 32 * ks, lane), frag16(Ks, 136, 16 * sb, 32 * ks, lane), acc);
            const int s = 16 * sb + l15; const float gs = gcs[s];
#pragma unroll
            for (int r = 0; r < 4; ++r) { const int t = 16 * tb + 4 * q4 + r; Am[t * 68 + s] = (s < t) ? acc[r] * __expf(fminf(gcs[t] - gs, 0.f)) : 0.f; }
        } else {
            const int j = item - 10, tb = j >> 2, sb = j & 3; f32x4 acc = (f32x4){0.f, 0.f, 0.f, 0.f};
            if (sb <= tb) {
#pragma unroll
                for (int ks = 0; ks < 4; ++ks) acc = mfma16(frag16(Ks, 136, 16 * sb, 32 * ks, lane), frag16(Qs, 136, 16 * tb, 32 * ks, lane), acc); }
            const int t = 16 * tb + l15, s0 = 16 * sb + 4 * q4; const float gt = gcs[t]; float vv[4];
#pragma unroll
            for (int r = 0; r < 4; ++r) vv[r] = (sb <= tb && s0 + r <= t) ? acc[r] * __expf(fminf(gt - gcs[s0 + r], 0.f)) : 0.f;
            u32x2 w; w.x = pk2(vv[0], vv[1]); w.y = pk2(vv[2], vv[3]); *(u32x2*)(ATT + t * 64 + s0) = w;
        }
    }
    __syncthreads();
#ifndef NOINV
    if (wave == 0) {
        float x[64]; int zo = 0; asm volatile("" : "+v"(zo)); const float* Amz = Am + zo;
#pragma unroll
        for (int i = 0; i < 64; ++i) { float acc = fmaxf(0.f, 1.f - fabsf((float)(i - lane)));
#pragma unroll
            for (int jj = 0; jj < (i + 3) / 4; ++jj) { const f32x4 av = *(const f32x4*)(Amz + i * 68 + 4 * jj);
#pragma unroll
                for (int e = 0; e < 4; ++e) if (4 * jj + e < i) acc -= av[e] * x[4 * jj + e]; }
            x[i] = acc; Ts[i * 72 + lane] = f2bf(acc); }
    }
#endif
    __syncthreads();
    {
        float* U = WSP(float, WS_GU) + (size_t)u * 8192; bf16* NW = WSP(bf16, WS_GNW) + (size_t)u * 8192;
#pragma unroll
        for (int tb = 0; tb < 4; ++tb) { f32x4 au = (f32x4){0.f, 0.f, 0.f, 0.f}, aw = au;
#pragma unroll
            for (int ks = 0; ks < 2; ++ks) { const bf16x8 bf = frag16(Ts, 72, 16 * tb, 32 * ks, lane); au = mfma16(frag16(VBT, 72, 16 * wave, 32 * ks, lane), bf, au); aw = mfma16(frag16(KBGT, 72, 16 * wave, 32 * ks, lane), bf, aw); }
            const int t = 16 * tb + l15, e0 = 16 * wave + 4 * q4;
            *(f32x4*)(U + t * 128 + e0) = au; u32x2 w; w.x = pk2(-aw[0], -aw[1]); w.y = pk2(-aw[2], -aw[3]); *(u32x2*)(NW + t * 128 + e0) = w; }
        bf16* KDT = WSP(bf16, WS_GKDT) + (size_t)u * 8192;
#pragma unroll
        for (int i = 0; i < 2; ++i) { const int id = tid + 512 * i, d = id >> 3, cc = id & 7; *(u32x4*)(KDT + d * 64 + 8 * cc) = *(const u32x4*)(KDTs + d * 72 + 8 * cc); }
        if (tid == 0) WSP(float, WS_GEG)[u] = __expf(gcs[63]);
    }
}

struct GdnPre { u32x4 nw[2], qg[2], kd[2], at; float u[16]; unsigned z[8]; float eg; };
__device__ __forceinline__ void gdn_load(unsigned char* ws, int b, int h, int c, int tid, int lane, int wave, GdnPre& p) {
    const int u = (b * 32 + c) * 4 + h, tok0 = b * SEQ + c * 64, q4 = lane >> 4, l15 = lane & 15, e0 = 16 * wave;
    const bf16* NW = WSP(bf16, WS_GNW) + (size_t)u * 8192; const bf16* QG = WSP(bf16, WS_GQG) + (size_t)u * 8192; const bf16* KDT = WSP(bf16, WS_GKDT) + (size_t)u * 8192;
    const bf16* ATT = WSP(bf16, WS_GATT) + (size_t)u * 4096; const float* U = WSP(float, WS_GU) + (size_t)u * 8192; const bf16* PROJ = WSP(bf16, WS_PROJ);
#pragma unroll
    for (int i = 0; i < 2; ++i) { const int id = tid + 512 * i, row = id >> 4, cc = id & 15, d = id >> 3, c8 = id & 7;
        p.nw[i] = *(const u32x4*)(NW + row * 128 + 8 * cc); p.qg[i] = *(const u32x4*)(QG + row * 128 + 8 * cc); p.kd[i] = *(const u32x4*)(KDT + d * 64 + 8 * c8); }
    p.at = *(const u32x4*)(ATT + (tid >> 3) * 64 + 8 * (tid & 7));
#pragma unroll
    for (int tb = 0; tb < 4; ++tb)
#pragma unroll
        for (int r = 0; r < 4; ++r) p.u[4 * tb + r] = U[(16 * tb + 4 * q4 + r) * 128 + e0 + l15];
#pragma unroll
    for (int i = 0; i < 8; ++i) p.z[i] = *(const unsigned*)(PROJ + (size_t)(tok0 + 8 * wave + i) * INWP + O_GZ + h * 128 + 2 * lane);
    p.eg = WSP(float, WS_GEG)[u];
}
__device__ __forceinline__ void gdn_chain_unit(int l, int unit, unsigned char* lds, int tid) { ENTER();
    const int h = unit & 3, b = unit >> 2, q4 = lane >> 4, l15 = lane & 15, e0 = 16 * wave;
    bf16* NWs = (bf16*)lds; bf16* QGs = (bf16*)(lds + 17408); bf16* KDs = (bf16*)(lds + 34816); bf16* ATs = (bf16*)(lds + 53248); float* Os = (float*)(lds + 62464);
    f32x4 sacc[8];
#pragma unroll
    for (int i = 0; i < 8; ++i) sacc[i] = (f32x4){0.f, 0.f, 0.f, 0.f};
    const float nw0 = a.in[I_GNW][l * 128 + 2 * lane], nw1 = a.in[I_GNW][l * 128 + 2 * lane + 1];
    GdnPre p; gdn_load(ws, b, h, 0, tid, lane, wave, p);
    for (int c = 0; c < 32; ++c) {
        const int tok0 = b * SEQ + c * 64;
#pragma unroll
        for (int i = 0; i < 2; ++i) { const int id = tid + 512 * i, row = id >> 4, cc = id & 15, d = id >> 3, c8 = id & 7;
            *(u32x4*)(NWs + row * 136 + 8 * cc) = p.nw[i]; *(u32x4*)(QGs + row * 136 + 8 * cc) = p.qg[i]; *(u32x4*)(KDs + d * 72 + 8 * c8) = p.kd[i]; }
        *(u32x4*)(ATs + (tid >> 3) * 72 + 8 * (tid & 7)) = p.at;
        float ucur[16]; unsigned zcur[8]; const float eg = p.eg;
#pragma unroll
        for (int i = 0; i < 16; ++i) ucur[i] = p.u[i];
#pragma unroll
        for (int i = 0; i < 8; ++i) zcur[i] = p.z[i];
        if (c + 1 < 32) gdn_load(ws, b, h, c + 1, tid, lane, wave, p);
        __syncthreads();
        bf16x8 sf[4];
#pragma unroll
        for (int ks = 0; ks < 4; ++ks) sf[ks] = accpair(sacc[2 * ks], sacc[2 * ks + 1]);
        f32x4 vn[4];
#pragma unroll
        for (int tb = 0; tb < 4; ++tb) { f32x4 acc = (f32x4){ucur[4 * tb], ucur[4 * tb + 1], ucur[4 * tb + 2], ucur[4 * tb + 3]};
#pragma unroll
            for (int ks = 0; ks < 4; ++ks) acc = mfma16(frag16p(NWs, 136, 16 * tb, 32 * ks, lane), sf[ks], acc);
            vn[tb] = acc; }
        const bf16x8 vf0 = accpair(vn[0], vn[1]), vf1 = accpair(vn[2], vn[3]);
#pragma unroll
        for (int tb = 0; tb < 4; ++tb) { f32x4 acc = (f32x4){0.f, 0.f, 0.f, 0.f};
#pragma unroll
            for (int ks = 0; ks < 4; ++ks) acc = mfma16(frag16p(QGs, 136, 16 * tb, 32 * ks, lane), sf[ks], acc);
            acc = mfma16(frag16p(ATs, 72, 16 * tb, 0, lane), vf0, acc); acc = mfma16(frag16p(ATs, 72, 16 * tb, 32, lane), vf1, acc);
#pragma unroll
            for (int r = 0; r < 4; ++r) Os[(16 * tb + 4 * q4 + r) * 132 + e0 + l15] = acc[r]; }
#pragma unroll
        for (int db = 0; db < 8; ++db) { f32x4 acc = sacc[db] * eg;
            acc = mfma16(frag16p(KDs, 72, 16 * db, 0, lane), vf0, acc); acc = mfma16(frag16p(KDs, 72, 16 * db, 32, lane), vf1, acc); sacc[db] = acc; }
        __syncthreads();
#pragma unroll
        for (int i = 0; i < 8; ++i) { const int t = 8 * wave + i; const f32x2 o = *(const f32x2*)(Os + t * 132 + 2 * lane);
            const float rs = 1.f / sqrtf(wave_sum(o.x * o.x + o.y * o.y) * (1.f / 128.f) + RMS_EPS); const unsigned z = zcur[i];
            *(unsigned*)(WSP(bf16, WS_MIX) + (size_t)(tok0 + t) * MIXW + 1536 + h * 128 + 2 * lane) = pk2(o.x * rs * nw0 * silu_f(bflo(z)), o.y * rs * nw1 * silu_f(bfhi(z))); }
        __syncthreads();
    }
    float* so = a.out + OUT_PGDN + (size_t)((l * NPB + b) * 4 + h) * 16384;
#pragma unroll
    for (int db = 0; db < 8; ++db)
#pragma unroll
        for (int r = 0; r < 4; ++r) so[(16 * db + 4 * q4 + r) * 128 + e0 + l15] = sacc[db][r];
}

struct SsdPre { u32x4 cs[4]; f32x4 hl[4]; f32x4 yi[4]; u32x2 z[4]; float ac, dl; };
__device__ __forceinline__ void ssd_load(unsigned char* ws, int b, int h, int c, int tid, int lane, int wave, SsdPre& p) {
    const int g = h >> 3, tok0 = b * SEQ + c * 128, q4 = lane >> 4, l15 = lane & 15, hp = tid >> 3, hn0 = (tid & 7) * 16, tok = tok0 + 16 * wave + l15;
    const bf16* CC = WSP(bf16, WS_CC); const float* ACUM = WSP(float, WS_ACUM); const float* YI = WSP(float, WS_YI); const bf16* PROJ = WSP(bf16, WS_PROJ);
    const float* hl = WSP(float, WS_HLOC) + (size_t)((b * 16 + c) * 16 + h) * 8192 + hp * 128 + hn0;
#pragma unroll
    for (int i = 0; i < 4; ++i) { const int id = tid + 512 * i, row = id >> 4, cc = id & 15; p.cs[i] = *(const u32x4*)(CC + (size_t)(tok0 + row) * 256 + g * 128 + 8 * cc); p.hl[i] = *(const f32x4*)(hl + 4 * i); }
    p.ac = ACUM[(size_t)tok * 16 + h]; p.dl = ACUM[(size_t)(tok0 + 127) * 16 + h];
#pragma unroll
    for (int pb = 0; pb < 4; ++pb) { const int p0 = 16 * pb + 4 * q4; p.yi[pb] = *(const f32x4*)(YI + (size_t)tok * 1024 + h * 64 + p0); p.z[pb] = *(const u32x2*)(PROJ + (size_t)tok * INWP + O_SSDZ + h * 64 + p0); }
}
__device__ __forceinline__ void ssd_chain_unit(int l, int unit, unsigned char* lds, int tid) { ENTER();
    const int h = unit & 15, b = unit >> 4, q4 = lane >> 4, l15 = lane & 15;
    bf16* YG = WSP(bf16, WS_YG); float* SSQ = WSP(float, WS_SSQ);
    bf16* Hs = (bf16*)lds; bf16* Cs = (bf16*)(lds + 17408);
    const int hp = tid >> 3, hn0 = (tid & 7) * 16;
    float H[16];
#pragma unroll
    for (int i = 0; i < 16; ++i) H[i] = 0.f;
    SsdPre p; ssd_load(ws, b, h, 0, tid, lane, wave, p);
    for (int c = 0; c < 16; ++c) {
        const int tok0 = b * SEQ + c * 128;
        { u32x4 w0, w1; w0.x = pk2(H[0], H[1]); w0.y = pk2(H[2], H[3]); w0.z = pk2(H[4], H[5]); w0.w = pk2(H[6], H[7]); w1.x = pk2(H[8], H[9]); w1.y = pk2(H[10], H[11]); w1.z = pk2(H[12], H[13]); w1.w = pk2(H[14], H[15]);
          *(u32x4*)(Hs + hp * 136 + hn0) = w0; *(u32x4*)(Hs + hp * 136 + hn0 + 8) = w1; }
#pragma unroll
        for (int i = 0; i < 4; ++i) { const int id = tid + 512 * i, row = id >> 4, cc = id & 15; *(u32x4*)(Cs + row * 136 + 8 * cc) = p.cs[i]; }
        f32x4 chl[4], cyi[4]; u32x2 cz[4]; const float ea = __expf(p.ac), dl = __expf(p.dl);
#pragma unroll
        for (int i = 0; i < 4; ++i) { chl[i] = p.hl[i]; cyi[i] = p.yi[i]; cz[i] = p.z[i]; }
        if (c + 1 < 16) ssd_load(ws, b, h, c + 1, tid, lane, wave, p);
        __syncthreads();
        {
            const int tok = tok0 + 16 * wave + l15; float ssq = 0.f;
#pragma unroll
            for (int pb = 0; pb < 4; ++pb) { f32x4 acc = (f32x4){0.f, 0.f, 0.f, 0.f};
#pragma unroll
                for (int ks = 0; ks < 4; ++ks) acc = mfma16(frag16(Hs, 136, 16 * pb, 32 * ks, lane), frag16(Cs, 136, 16 * wave, 32 * ks, lane), acc);
                const int p0 = 16 * pb + 4 * q4; const f32x4 yi = cyi[pb]; const u32x2 z = cz[pb];
                const float y0 = (yi.x + ea * acc[0]) * silu_f(bflo(z.x)), y1 = (yi.y + ea * acc[1]) * silu_f(bfhi(z.x)), y2 = (yi.z + ea * acc[2]) * silu_f(bflo(z.y)), y3 = (yi.w + ea * acc[3]) * silu_f(bfhi(z.y));
                ssq += (y0 * y0 + y1 * y1) + (y2 * y2 + y3 * y3);
                u32x2 w; w.x = pk2(y0, y1); w.y = pk2(y2, y3); *(u32x2*)(YG + (size_t)tok * 1024 + h * 64 + p0) = w; }
            ssq = row16_sum(ssq); ssq = half_sum(ssq);
            if (q4 == 0) SSQ[(size_t)tok * 16 + h] = ssq;
        }
#pragma unroll
        for (int i = 0; i < 4; ++i) { const f32x4 v = chl[i]; H[4 * i] = dl * H[4 * i] + v.x; H[4 * i + 1] = dl * H[4 * i + 1] + v.y; H[4 * i + 2] = dl * H[4 * i + 2] + v.z; H[4 * i + 3] = dl * H[4 * i + 3] + v.w; }
        __syncthreads();
    }
    float* ho = a.out + OUT_PSSD + (size_t)((l * NPB + b) * 16 + h) * 8192 + hp * 128 + hn0;
#pragma unroll
    for (int i = 0; i < 4; ++i) *(f32x4*)(ho + 4 * i) = (f32x4){H[4 * i], H[4 * i + 1], H[4 * i + 2], H[4 * i + 3]};
}

__device__ __forceinline__ void ssd_final_unit(int l, int unit, int tid) { ENTER();
    const bf16* YG = WSP(bf16, WS_YG); const float* SSQ = WSP(float, WS_SSQ); bf16* MIX = WSP(bf16, WS_MIX);
    const int m0 = unit * 32 + wave * 4;
    u32x4 w[4][2]; f32x4 sq[4][4];
#pragma unroll
    for (int i = 0; i < 4; ++i) {
#pragma unroll
        for (int g = 0; g < 2; ++g) w[i][g] = *(const u32x4*)(YG + (size_t)(m0 + i) * 1024 + g * 512 + 8 * lane);
#pragma unroll
        for (int j = 0; j < 4; ++j) sq[i][j] = *(const f32x4*)(SSQ + (size_t)(m0 + i) * 16 + 4 * j); }
    f32x4 n0[2], n1[2];
#pragma unroll
    for (int g = 0; g < 2; ++g) { n0[g] = *(const f32x4*)(a.in[I_SNW] + l * 1024 + g * 512 + 8 * lane); n1[g] = *(const f32x4*)(a.in[I_SNW] + l * 1024 + g * 512 + 8 * lane + 4); }
#pragma unroll
    for (int i = 0; i < 4; ++i)
#pragma unroll
        for (int g = 0; g < 2; ++g) { const f32x4 s0 = sq[i][2 * g], s1 = sq[i][2 * g + 1]; const float ss = ((s0.x + s0.y) + (s0.z + s0.w)) + ((s1.x + s1.y) + (s1.z + s1.w));
            const float rs = __builtin_amdgcn_rsqf(ss * (1.f / 512.f) + RMS_EPS); const u32x4 v = w[i][g];
            u32x4 o; o.x = pk2(bflo(v.x) * rs * n0[g].x, bfhi(v.x) * rs * n0[g].y); o.y = pk2(bflo(v.y) * rs * n0[g].z, bfhi(v.y) * rs * n0[g].w);
            o.z = pk2(bflo(v.z) * rs * n1[g].x, bfhi(v.z) * rs * n1[g].y); o.w = pk2(bflo(v.w) * rs * n1[g].z, bfhi(v.w) * rs * n1[g].w);
            *(u32x4*)(MIX + (size_t)(m0 + i) * MIXW + g * 512 + 8 * lane) = o; }
}

__device__ __forceinline__ void attn_unit(int l, int unit, unsigned char* lds, int tid) { ENTER();
    const int qb = 7 - (unit >> 6), bh = unit & 63, b = bh >> 3, h = bh & 7, r32 = lane & 31, hh = lane >> 5;
    const bf16* Q = WSP(bf16, WS_Q); const bf16* KK = WSP(bf16, WS_KK); const bf16* VT = WSP(bf16, WS_VT); const float* RC = WSP(float, WS_ROPECS);
    bf16* Ks = (bf16*)lds; bf16* VTs = (bf16*)(lds + 13312);
    const int qrow = 256 * qb + 32 * wave + r32, tok = b * SEQ + qrow;
    bf16x8 qf[6];
    {
        const bf16* qp = Q + (size_t)tok * 768 + h * 96 + 8 * hh;
#pragma unroll
        for (int ks = 0; ks < 4; ++ks) { const u32x4 w = *(const u32x4*)(qp + 16 * ks); u32x4 o;
            o.x = pk2(bflo(w.x) * ATT_SC, bfhi(w.x) * ATT_SC); o.y = pk2(bflo(w.y) * ATT_SC, bfhi(w.y) * ATT_SC); o.z = pk2(bflo(w.z) * ATT_SC, bfhi(w.z) * ATT_SC); o.w = pk2(bflo(w.w) * ATT_SC, bfhi(w.w) * ATT_SC);
            qf[ks] = __builtin_bit_cast(bf16x8, o); }
        const u32x4 w1 = *(const u32x4*)(qp + 64), w2 = *(const u32x4*)(qp + 80);
        const f32x4 c0 = *(const f32x4*)(RC + (size_t)tok * 32 + 8 * hh), c1 = *(const f32x4*)(RC + (size_t)tok * 32 + 8 * hh + 4), s0 = *(const f32x4*)(RC + (size_t)tok * 32 + 16 + 8 * hh), s1 = *(const f32x4*)(RC + (size_t)tok * 32 + 16 + 8 * hh + 4);
        float x1[8] = {bflo(w1.x), bfhi(w1.x), bflo(w1.y), bfhi(w1.y), bflo(w1.z), bfhi(w1.z), bflo(w1.w), bfhi(w1.w)};
        float x2[8] = {bflo(w2.x), bfhi(w2.x), bflo(w2.y), bfhi(w2.y), bflo(w2.z), bfhi(w2.z), bflo(w2.w), bfhi(w2.w)};
        float cc[8] = {c0.x, c0.y, c0.z, c0.w, c1.x, c1.y, c1.z, c1.w}, sn[8] = {s0.x, s0.y, s0.z, s0.w, s1.x, s1.y, s1.z, s1.w};
        float o1[8], o2[8];
#pragma unroll
        for (int i = 0; i < 8; ++i) { o1[i] = (x1[i] * cc[i] - x2[i] * sn[i]) * ATT_SC; o2[i] = (x2[i] * cc[i] + x1[i] * sn[i]) * ATT_SC; }
        u32x4 p1, p2; p1.x = pk2(o1[0], o1[1]); p1.y = pk2(o1[2], o1[3]); p1.z = pk2(o1[4], o1[5]); p1.w = pk2(o1[6], o1[7]); p2.x = pk2(o2[0], o2[1]); p2.y = pk2(o2[2], o2[3]); p2.z = pk2(o2[4], o2[5]); p2.w = pk2(o2[6], o2[7]);
        qf[4] = __builtin_bit_cast(bf16x8, p1); qf[5] = __builtin_bit_cast(bf16x8, p2);
    }
    f32x16 o0, o1;
#pragma unroll
    for (int r = 0; r < 16; ++r) { o0[r] = 0.f; o1[r] = 0.f; }
    float m = -1e30f, lsum = 0.f;
    const int KT = 4 * qb + 4;
    const int kr0 = tid / 12, kc0 = tid % 12, kr1 = (tid + 512) / 12, kc1 = (tid + 512) % 12, vr = tid >> 3, vc = tid & 7;
    const bf16* kbase = KK + (size_t)(b * SEQ) * 768 + h * 96; const bf16* vbase = VT + (size_t)(h * 64 + vr) * NP + b * SEQ + 8 * vc;
    u32x4 kreg0 = *(const u32x4*)(kbase + (size_t)kr0 * 768 + 8 * kc0), kreg1 = (u32x4){0u, 0u, 0u, 0u}, vreg = *(const u32x4*)(vbase);
    if (tid < 256) kreg1 = *(const u32x4*)(kbase + (size_t)kr1 * 768 + 8 * kc1);
    for (int kt = 0; kt < KT; ++kt) {
        const int key0 = 64 * kt;
        __syncthreads();
        *(u32x4*)(Ks + kr0 * 104 + 8 * kc0) = kreg0; if (tid < 256) *(u32x4*)(Ks + kr1 * 104 + 8 * kc1) = kreg1; *(u32x4*)(VTs + vr * 72 + 8 * vc) = vreg;
        if (kt + 1 < KT) { kreg0 = *(const u32x4*)(kbase + (size_t)(key0 + 64 + kr0) * 768 + 8 * kc0); if (tid < 256) kreg1 = *(const u32x4*)(kbase + (size_t)(key0 + 64 + kr1) * 768 + 8 * kc1); vreg = *(const u32x4*)(vbase + key0 + 64); }
        __syncthreads();
        if (key0 <= 256 * qb + 32 * wave + 31) {
            f32x16 s0, s1;
#pragma unroll
            for (int r = 0; r < 16; ++r) { s0[r] = 0.f; s1[r] = 0.f; }
#pragma unroll
            for (int ks = 0; ks < 6; ++ks) { const bf16x8 a0 = *(const bf16x8*)(Ks + r32 * 104 + 16 * ks + 8 * hh), a1 = *(const bf16x8*)(Ks + (32 + r32) * 104 + 16 * ks + 8 * hh);
                s0 = mfma32(a0, qf[ks], s0); s1 = mfma32(a1, qf[ks], s1); }
            if (key0 + 63 > 256 * qb + 32 * wave) {
#pragma unroll
                for (int r = 0; r < 16; ++r) { const int key = key0 + (r & 3) + 8 * (r >> 2) + 4 * hh; if (key > qrow) s0[r] = -1e30f; if (key + 32 > qrow) s1[r] = -1e30f; } }
            float mx = s0[0];
#pragma unroll
            for (int r = 1; r < 16; ++r) mx = fmaxf(mx, s0[r]);
#pragma unroll
            for (int r = 0; r < 16; ++r) mx = fmaxf(mx, s1[r]);
            mx = half_max(mx);
            const float mn = fmaxf(m, mx), alpha = __builtin_amdgcn_exp2f(m - mn); m = mn;
            float ps = 0.f;
#pragma unroll
            for (int r = 0; r < 16; ++r) { s0[r] = __builtin_amdgcn_exp2f(s0[r] - mn); s1[r] = __builtin_amdgcn_exp2f(s1[r] - mn); ps += s0[r] + s1[r]; }
            ps = half_sum(ps); lsum = lsum * alpha + ps;
#pragma unroll
            for (int r = 0; r < 16; ++r) { o0[r] *= alpha; o1[r] *= alpha; }
            bf16x8 pf[4];
#pragma unroll
            for (int s2 = 0; s2 < 2; ++s2) { u32x4 w;
                w.x = pk2(s0[8 * s2], s0[8 * s2 + 1]); w.y = pk2(s0[8 * s2 + 2], s0[8 * s2 + 3]); w.z = pk2(s0[8 * s2 + 4], s0[8 * s2 + 5]); w.w = pk2(s0[8 * s2 + 6], s0[8 * s2 + 7]); pf[s2] = __builtin_bit_cast(bf16x8, w);
                w.x = pk2(s1[8 * s2], s1[8 * s2 + 1]); w.y = pk2(s1[8 * s2 + 2], s1[8 * s2 + 3]); w.z = pk2(s1[8 * s2 + 4], s1[8 * s2 + 5]); w.w = pk2(s1[8 * s2 + 6], s1[8 * s2 + 7]); pf[2 + s2] = __builtin_bit_cast(bf16x8, w); }
#pragma unroll
            for (int kk = 0; kk < 4; ++kk) {
                const bf16* vp0 = VTs + r32 * 72 + 16 * kk + 4 * hh; const bf16* vp1 = vp0 + 32 * 72;
                const bf16x4 l0 = *(const bf16x4*)vp0, h0 = *(const bf16x4*)(vp0 + 8), l1 = *(const bf16x4*)vp1, h1 = *(const bf16x4*)(vp1 + 8);
                o0 = mfma32((bf16x8){l0[0], l0[1], l0[2], l0[3], h0[0], h0[1], h0[2], h0[3]}, pf[kk], o0);
                o1 = mfma32((bf16x8){l1[0], l1[1], l1[2], l1[3], h1[0], h1[1], h1[2], h1[3]}, pf[kk], o1); }
        }
    }
    {
        const float inv = 1.f / lsum; const bf16* gp = WSP(bf16, WS_PROJ) + (size_t)tok * INWP + O_GATE + h * 64; bf16* mp = WSP(bf16, WS_MIX) + (size_t)tok * MIXW + 1024 + h * 64;
#pragma unroll
        for (int rr = 0; rr < 4; ++rr) { const int d0 = 8 * rr + 4 * hh;
            { const u32x2 gz = *(const u32x2*)(gp + d0); u32x2 w; w.x = pk2(o0[4 * rr] * inv * silu_f(bflo(gz.x)), o0[4 * rr + 1] * inv * silu_f(bfhi(gz.x))); w.y = pk2(o0[4 * rr + 2] * inv * silu_f(bflo(gz.y)), o0[4 * rr + 3] * inv * silu_f(bfhi(gz.y))); *(u32x2*)(mp + d0) = w; }
            { const u32x2 gz = *(const u32x2*)(gp + 32 + d0); u32x2 w; w.x = pk2(o1[4 * rr] * inv * silu_f(bflo(gz.x)), o1[4 * rr + 1] * inv * silu_f(bfhi(gz.x))); w.y = pk2(o1[4 * rr + 2] * inv * silu_f(bflo(gz.y)), o1[4 * rr + 3] * inv * silu_f(bfhi(gz.y))); *(u32x2*)(mp + 32 + d0) = w; } }
    }
}

struct DecRegs { f32x4 L[2][4]; f32x4 R; };
__device__ __forceinline__ void dec_load(const CAS KArgs& a, unsigned char* ws, int l, int b, int sp, int j, int tid, DecRegs& d) {
    if (j < 16) {
        const int page = ((const int*)a.in[I_PT])[b * NPAGES + 8 * sp + (j >> 1)]; const int key0 = (j & 1) * 64;
        const float* lat = a.in[I_CLAT] + ((size_t)(l * NPHYS + page) * PAGE + key0) * 256; const float* rp = a.in[I_CROPE] + ((size_t)(l * NPHYS + page) * PAGE + key0) * 32;
#pragma unroll
        for (int g2 = 0; g2 < 2; ++g2) { const int gi = tid + 512 * g2, kq = gi >> 6, dq = gi & 63;
#pragma unroll
            for (int i = 0; i < 4; ++i) d.L[g2][i] = __builtin_nontemporal_load((const f32x4*)(lat + (size_t)(4 * kq + i) * 256 + 4 * dq)); }
        d.R = __builtin_nontemporal_load((const f32x4*)(rp + (size_t)(tid >> 3) * 32 + 4 * (tid & 7)));
    } else {
        const bf16* ck = WSP(bf16, WS_CKVN) + (size_t)(NP + 4 * b) * 256; const bf16* kr = WSP(bf16, WS_KROPE) + (size_t)(NP + 4 * b) * 32;
#pragma unroll
        for (int g2 = 0; g2 < 2; ++g2) { const int gi = tid + 512 * g2, kq = gi >> 6, dq = gi & 63;
#pragma unroll
            for (int i = 0; i < 4; ++i) { f32x4 v = (f32x4){0.f, 0.f, 0.f, 0.f}; if (kq == 0) { const u32x2 w = *(const u32x2*)(ck + i * 256 + 4 * dq); v = (f32x4){bflo(w.x), bfhi(w.x), bflo(w.y), bfhi(w.y)}; } d.L[g2][i] = v; } }
        f32x4 v = (f32x4){0.f, 0.f, 0.f, 0.f}; if ((tid >> 3) < 4) { const u32x2 w = *(const u32x2*)(kr + (tid >> 3) * 32 + 4 * (tid & 7)); v = (f32x4){bflo(w.x), bfhi(w.x), bflo(w.y), bfhi(w.y)}; } d.R = v;
    }
}
__device__ __forceinline__ void dec_store(const DecRegs& d, bf16* Kb, int tid) {
#pragma unroll
    for (int g2 = 0; g2 < 2; ++g2) { const int gi = tid + 512 * g2, kq = gi >> 6, dq = gi & 63;
#pragma unroll
        for (int i = 0; i < 4; ++i) { u32x2 w; w.x = pk2(d.L[g2][i].x, d.L[g2][i].y); w.y = pk2(d.L[g2][i].z, d.L[g2][i].w); *(u32x2*)(Kb + (4 * kq + i) * 296 + 4 * dq) = w; } }
    { u32x2 w; w.x = pk2(d.R.x, d.R.y); w.y = pk2(d.R.z, d.R.w); *(u32x2*)(Kb + (tid >> 3) * 296 + 256 + 4 * (tid & 7)) = w; }
}
__device__ __forceinline__ void decode_unit(int l, int unit, unsigned char* lds, int tid) { ENTER();
    const int sp = unit & 15, b = unit >> 4, r32 = lane & 31, hh = lane >> 5;
    bf16* Qs = (bf16*)lds; bf16* Kbuf = (bf16*)(lds + 18944);
    {
        const int row = tid >> 4, t = row >> 3, hq = row & 7, c0 = (tid & 15) * 16;
        const bf16* src = WSP(bf16, WS_QLAT) + (size_t)(4 * b + t) * 2048 + hq * 256 + c0;
#pragma unroll
        for (int i = 0; i < 2; ++i) { const u32x4 w = *(const u32x4*)(src + 8 * i); u32x4 o;
            o.x = pk2(bflo(w.x) * ATT_SC, bfhi(w.x) * ATT_SC); o.y = pk2(bflo(w.y) * ATT_SC, bfhi(w.y) * ATT_SC); o.z = pk2(bflo(w.z) * ATT_SC, bfhi(w.z) * ATT_SC); o.w = pk2(bflo(w.w) * ATT_SC, bfhi(w.w) * ATT_SC);
            *(u32x4*)(Qs + row * 296 + c0 + 8 * i) = o; }
        const int i = tid & 15, tr = NP + 4 * b + t; const bf16* qr = WSP(bf16, WS_Q) + (size_t)tr * 768 + hq * 96 + 64; const float* RC = WSP(float, WS_ROPECS) + (size_t)tr * 32;
        const float x1 = bf2f(qr[i]), x2 = bf2f(qr[16 + i]), c = RC[i], s = RC[16 + i];
        Qs[row * 296 + 256 + i] = f2bf((x1 * c - x2 * s) * ATT_SC); Qs[row * 296 + 272 + i] = f2bf((x2 * c + x1 * s) * ATT_SC);
    }
    const int nt = 16 + (sp == 15 ? 1 : 0);
    DecRegs d; dec_load(a, ws, l, b, sp, 0, tid, d);
    dec_store(d, Kbuf, tid);
    dec_load(a, ws, l, b, sp, 1, tid, d);
    __syncthreads();
    bf16x8 qf[18];
#pragma unroll
    for (int ks = 0; ks < 18; ++ks) qf[ks] = *(const bf16x8*)(Qs + r32 * 296 + 16 * ks + 8 * hh);
    f32x16 oacc;
#pragma unroll
    for (int r = 0; r < 16; ++r) oacc[r] = 0.f;
    float m = -1e30f, lsum = 0.f;
    for (int j = 0; j < nt; ++j) {
        const bf16* Ks = Kbuf + (j & 1) * (64 * 296);
        f32x16 s0, s1;
#pragma unroll
        for (int r = 0; r < 16; ++r) { s0[r] = 0.f; s1[r] = 0.f; }
#pragma unroll
        for (int ks = 0; ks < 18; ++ks) { const bf16x8 a0 = *(const bf16x8*)(Ks + r32 * 296 + 16 * ks + 8 * hh), a1 = *(const bf16x8*)(Ks + (32 + r32) * 296 + 16 * ks + 8 * hh);
            s0 = mfma32(a0, qf[ks], s0); s1 = mfma32(a1, qf[ks], s1); }
        if (j == 16) { const int tq = r32 >> 3;
#pragma unroll
            for (int r = 0; r < 16; ++r) { const int kl = (r & 3) + 8 * (r >> 2) + 4 * hh; if (!(kl < 4 && kl <= tq)) s0[r] = -1e30f; s1[r] = -1e30f; } }
        float mx = s0[0];
#pragma unroll
        for (int r = 1; r < 16; ++r) mx = fmaxf(mx, s0[r]);
#pragma unroll
        for (int r = 0; r < 16; ++r) mx = fmaxf(mx, s1[r]);
        mx = half_max(mx);
        const float mn = fmaxf(m, mx), alpha = __builtin_amdgcn_exp2f(m - mn); m = mn;
        float ps = 0.f;
#pragma unroll
        for (int r = 0; r < 16; ++r) { s0[r] = __builtin_amdgcn_exp2f(s0[r] - mn); s1[r] = __builtin_amdgcn_exp2f(s1[r] - mn); ps += s0[r] + s1[r]; }
        ps = half_sum(ps); lsum = lsum * alpha + ps;
#pragma unroll
        for (int r = 0; r < 16; ++r) oacc[r] *= alpha;
        bf16x8 pf[4];
#pragma unroll
        for (int s2 = 0; s2 < 2; ++s2) { u32x4 w;
            w.x = pk2(s0[8 * s2], s0[8 * s2 + 1]); w.y = pk2(s0[8 * s2 + 2], s0[8 * s2 + 3]); w.z = pk2(s0[8 * s2 + 4], s0[8 * s2 + 5]); w.w = pk2(s0[8 * s2 + 6], s0[8 * s2 + 7]); pf[s2] = __builtin_bit_cast(bf16x8, w);
            w.x = pk2(s1[8 * s2], s1[8 * s2 + 1]); w.y = pk2(s1[8 * s2 + 2], s1[8 * s2 + 3]); w.z = pk2(s1[8 * s2 + 4], s1[8 * s2 + 5]); w.w = pk2(s1[8 * s2 + 6], s1[8 * s2 + 7]); pf[2 + s2] = __builtin_bit_cast(bf16x8, w); }
#pragma unroll
        for (int kk = 0; kk < 4; ++kk) {
            const bf16* vp = Ks + (16 * kk + 4 * hh) * 296 + 32 * wave + r32;
            const bf16x8 va = (bf16x8){(short)vp[0], (short)vp[296], (short)vp[2 * 296], (short)vp[3 * 296], (short)vp[8 * 296], (short)vp[9 * 296], (short)vp[10 * 296], (short)vp[11 * 296]};
            oacc = mfma32(va, pf[kk], oacc); }
        if (j + 1 < nt) { dec_store(d, Kbuf + ((j + 1) & 1) * (64 * 296), tid); if (j + 2 < nt) dec_load(a, ws, l, b, sp, j + 2, tid, d); }
        __syncthreads();
    }
    float* po = WSP(float, WS_PARTO) + ((size_t)(b * 16 + sp) * 32 + r32) * 256 + 32 * wave + 4 * hh;
#pragma unroll
    for (int rr = 0; rr < 4; ++rr) *(f32x4*)(po + 8 * rr) = (f32x4){oacc[4 * rr], oacc[4 * rr + 1], oacc[4 * rr + 2], oacc[4 * rr + 3]};
    if (wave == 0 && hh == 0) { float* pm = WSP(float, WS_PARTML) + ((size_t)(b * 16 + sp) * 32 + r32) * 2; pm[0] = m; pm[1] = lsum; }
}
__device__ __forceinline__ void combine_unit(int l, int u, unsigned char* lds, int tid) { ENTER();
    const int b = u >> 2, t = u & 3;
    float* olat = (float*)lds; float* wts = olat + 2048;
    const float* PO = WSP(float, WS_PARTO) + (size_t)b * 16 * 32 * 256; const float* PM = WSP(float, WS_PARTML) + (size_t)b * 16 * 32 * 2;
    if (tid < 8) { const int q = t * 8 + tid; float M = -1e30f;
        for (int sp = 0; sp < 16; ++sp) M = fmaxf(M, PM[(sp * 32 + q) * 2]);
        float L = 0.f;
        for (int sp = 0; sp < 16; ++sp) { const float w = __builtin_amdgcn_exp2f(PM[(sp * 32 + q) * 2] - M); L += PM[(sp * 32 + q) * 2 + 1] * w; wts[tid * 16 + sp] = w; }
        const float il = 1.f / L;
        for (int sp = 0; sp < 16; ++sp) wts[tid * 16 + sp] *= il; }
    __syncthreads();
    { const int d = tid & 255, h2 = tid >> 8;
#pragma unroll
        for (int hi = 0; hi < 4; ++hi) { const int hq = 4 * h2 + hi, q = t * 8 + hq; float acc = 0.f;
#pragma unroll
            for (int sp = 0; sp < 16; ++sp) acc += PO[((size_t)sp * 32 + q) * 256 + d] * wts[hq * 16 + sp];
            olat[hq * 256 + d] = acc; } }
    __syncthreads();
    {
        const int hq = tid >> 6; const bf16* wr = WSP(bf16, WS_WUV) + (size_t)l * 512 * 256 + (size_t)tid * 256; const float* ol = olat + hq * 256; float acc = 0.f;
#pragma unroll 8
        for (int c = 0; c < 32; ++c) { const u32x4 w = *(const u32x4*)(wr + 8 * c); const f32x4 o0 = *(const f32x4*)(ol + 8 * c), o1 = *(const f32x4*)(ol + 8 * c + 4);
            acc += (bflo(w.x) * o0.x + bfhi(w.x) * o0.y) + (bflo(w.y) * o0.z + bfhi(w.y) * o0.w) + (bflo(w.z) * o1.x + bfhi(w.z) * o1.y) + (bflo(w.w) * o1.z + bfhi(w.w) * o1.w); }
        const int tr = NP + 4 * b + t; const float gz = bf2f(WSP(bf16, WS_PROJ)[(size_t)tr * INWP + O_GATE + tid]);
        WSP(bf16, WS_MIX)[(size_t)tr * MIXW + 1024 + tid] = f2bf(acc * silu_f(gz));
    }
}


__device__ __forceinline__ void tiny_out_unit(int l, int tile, unsigned char* lds, int tid) { ENTER();
    __syncthreads();
    const bf16* WoT = WSP(bf16, WS_WOUT) + (size_t)l * DM * MIXW;
    const int r0 = NP + 16 * (tile >> 5), c0 = 32 * (tile & 31), q4 = lane >> 4, l15 = lane & 15;
    const bf16* ap = WSP(bf16, WS_MIX) + (size_t)(r0 + l15) * MIXW + 256 * wave + 8 * q4; const bf16* bp = WoT + (size_t)(c0 + l15) * MIXW + 256 * wave + 8 * q4;
    f32x4 acc0 = (f32x4){0.f, 0.f, 0.f, 0.f}, acc1 = acc0;
#pragma unroll
    for (int ks = 0; ks < 8; ++ks) { const bf16x8 af = *(const bf16x8*)(ap + 32 * ks); acc0 = mfma16(af, *(const bf16x8*)(bp + 32 * ks), acc0); acc1 = mfma16(af, *(const bf16x8*)(bp + (size_t)16 * MIXW + 32 * ks), acc1); }
    float* part = (float*)lds;
#pragma unroll
    for (int r = 0; r < 4; ++r) { part[(wave * 16 + 4 * q4 + r) * 32 + l15] = acc0[r]; part[(wave * 16 + 4 * q4 + r) * 32 + 16 + l15] = acc1[r]; }
    __syncthreads();
    const int row = tid >> 5, col = tid & 31; float s = 0.f;
#pragma unroll
    for (int w = 0; w < 8; ++w) s += part[(w * 16 + row) * 32 + col];
    const size_t o = (size_t)(r0 + row) * DM + c0 + col; WSP(float, WS_Y)[o] = s + ALPHA * WSP(float, WS_XF)[o];
}
__device__ __forceinline__ void ln_phase(int l, int tid, int bid, int G) { ENTER();
    const float* lg = a.in[I_LNG] + l * DM; const float* lb = a.in[I_LNB] + l * DM;
    const int NGW = G * NWAVES;
    for (int m = bid * NWAVES + wave; m < MT; m += 2 * NGW) {
        const int m2 = (m + NGW < MT) ? m + NGW : m;
        const float* yr = WSP(float, WS_Y) + (size_t)m * DM; const float* yr2 = WSP(float, WS_Y) + (size_t)m2 * DM;
        if (l == 0) ln_row2(yr, yr2, lg, lb, WSP(float, WS_XF) + (size_t)m * DM, WSP(bf16, WS_XN) + (size_t)m * DM, WSP(float, WS_XF) + (size_t)m2 * DM, WSP(bf16, WS_XN) + (size_t)m2 * DM, lane);
        else ln_row2(yr, yr2, lg, lb, (m < NP) ? a.out + OUT_YP + (size_t)m * DM : a.out + OUT_YS + (size_t)(m - NP) * DM, nullptr, (m2 < NP) ? a.out + OUT_YP + (size_t)m2 * DM : a.out + OUT_YS + (size_t)(m2 - NP) * DM, nullptr, lane);
    }
}

constexpr int NPH = 15;
#ifndef PHM
#define PHM 0xFFFF
#endif
#ifndef UM
#define UM 0xFFFF
#endif
#ifndef DUP
#define DUP 0
#endif
#ifndef UDUP
#define UDUP 0
#endif
#ifndef UM2
#define UM2 0xFFFF
#endif
#define REPS(bit) (((DUP) & (bit)) ? 2 : 1)
__global__ void __launch_bounds__(NTHR, 2) hymba_fwd(KArgs a_unused) {
    extern __shared__ __attribute__((aligned(16))) unsigned char lds[];
    const int tid = threadIdx.x, lane = tid & 63, wave = __builtin_amdgcn_readfirstlane(tid >> 6), bid = blockIdx.x, G = gridDim.x;
    const CAS KArgs* kp_ = (const CAS KArgs*)__builtin_amdgcn_kernarg_segment_ptr(); const CAS KArgs& a = *kp_; unsigned char* ws = a.ws;
#define FRESH() asm volatile("" : "+s"(ws))
    volatile unsigned* MISC = (volatile unsigned*)(lds + MISC_OFF);
    if (tid < 64) MISC[tid] = 0u;
    __syncthreads();
    unsigned* ctl = (unsigned*)(a.ws + WS_CTL);
    const int lo = a.ph_lo, hi = a.ph_hi;
    XcdBarrier bar; bar.bar = ctl + CW_BAR; bar.x = 0; bar.st = nullptr;
    if (hi - lo > 1) bar = xcd_barrier_post(ctl + CW_BAR, (volatile LAS unsigned*)(lds + MISC_OFF + 32));
    volatile unsigned* slot = MISC + 16;
#define IN(k) (lo <= (k) && (k) < hi)
#define SEAM(k) do { if (IN(k) && IN((k) + 1)) xcd_barrier(bar); } while (0)
    if (IN(0) && (PHM & 1)) { for (int rep = 0; rep < REPS(1); ++rep) { if (rep) xcd_barrier(bar); ph_prologue(lds, tid, bid, G); } }
    SEAM(0);
    for (int l = 0; l < 2; ++l) {
        const int P = 1 + 7 * l;
        if (IN(P) && (PHM & 2)) for (int rep = 0; rep < REPS(2); ++rep) { if (rep) xcd_barrier(bar); FRESH();
            pg8::Gemm g{WSP(bf16, WS_XN), WSP(bf16, WS_WIN) + (size_t)l * INWP * DM, MP, INWP, DM, DM, DM}; pg8::StaticOrder S; S.init(MP, INWP, G, bid);
            pg8::EpiBf16 E{WSP(bf16, WS_PROJ), INWP, 0};
            pg8::gemm_phase<pg8::EpiBf16, pg8::StaticOrder, true, true>((PG8_LAS unsigned char*)lds, g, S, E);
        }
        SEAM(P);
        if (IN(P + 1) && (PHM & 4)) for (int rep = 0; rep < REPS(4); ++rep) { if (rep) xcd_barrier(bar);
            unsigned* ctr = ctl + CW_Q + 64 * (2 * l + 8 * rep); const int um = rep ? (UM2) : (UM);
            for (;;) { int u = q_next(ctr, slot, tid);
                if (u < 256) { if (um & 1) { ssd_s1_unit(l, u, lds, tid); if (UDUP & 1) { __syncthreads(); ssd_s1_unit(l, u, lds, tid); } } continue; } u -= 256;
                if (u < 1024) { if (um & 2) { gdn_prep_unit(l, u, lds, tid); if (UDUP & 2) { __syncthreads(); gdn_prep_unit(l, u, lds, tid); } } continue; } u -= 1024;
                if (u < 64) { if (um & 4) ssd_sample_unit(l, u, lds, tid); continue; } u -= 64;
                if (u < 128) { if (um & 8) gdn_sample_unit(l, u, lds, tid); continue; } u -= 128;
                if (u < 516) { if (um & 16) e1_unit(l, u, tid); continue; }
                break; }
        }
        SEAM(P + 1);
        if (IN(P + 2) && (PHM & 8)) for (int rep = 0; rep < REPS(8); ++rep) { if (rep) xcd_barrier(bar); FRESH();
            { pg8::Gemm g{WSP(bf16, WS_CQN), WSP(bf16, WS_WUQ) + (size_t)l * 768 * 384, MP, 768, 384, 384, 384}; pg8::StaticOrder S; S.init(MP, 768, G, bid);
              pg8::EpiBf16 E{WSP(bf16, WS_Q), 768, 0}; pg8::gemm_phase<pg8::EpiBf16, pg8::StaticOrder, true, true>((PG8_LAS unsigned char*)lds, g, S, E); }
            { pg8::Gemm g{WSP(bf16, WS_CKVN), WSP(bf16, WS_WUK) + (size_t)l * 512 * 256, NP, 512, 256, 256, 256}; pg8::StaticOrder S; S.init(NP, 512, G, (bid + G - 195 % G) % G);
              pg8::EpiBf16 E{WSP(bf16, WS_KK), 768, 1}; pg8::gemm_phase<pg8::EpiBf16, pg8::StaticOrder, true, true>((PG8_LAS unsigned char*)lds, g, S, E); }
            { pg8::Gemm g{WSP(bf16, WS_WUV) + (size_t)l * 512 * 256, WSP(bf16, WS_CKVN), 512, NP, 256, 256, 256}; pg8::StaticOrder S; S.init(512, NP, G, (bid + G - 67 % G) % G);
              pg8::EpiBf16 E{WSP(bf16, WS_VT), NP, 0}; pg8::gemm_phase<pg8::EpiBf16, pg8::StaticOrder, true, true>((PG8_LAS unsigned char*)lds, g, S, E); }
            { pg8::Gemm g{WSP(bf16, WS_CQN) + (size_t)NP * 384, WSP(bf16, WS_WABS) + (size_t)l * 2048 * 384, 256, 2048, 384, 384, 384}; pg8::StaticOrder S; S.init(256, 2048, G, (bid + G - 195 % G) % G);
              pg8::EpiBf16 E{WSP(bf16, WS_QLAT), 2048, 0}; pg8::gemm_phase<pg8::EpiBf16, pg8::StaticOrder, true, true>((PG8_LAS unsigned char*)lds, g, S, E); }
        }
        SEAM(P + 2);
        if (IN(P + 3) && (PHM & 16)) for (int rep = 0; rep < REPS(16); ++rep) { if (rep) xcd_barrier(bar);
            unsigned* ctr = ctl + CW_Q + 64 * (2 * l + 1 + 8 * rep); const int um = rep ? (UM2) : (UM);
            for (;;) { int u = q_next(ctr, slot, tid);
                if (u < 32) { if (um & 32) { gdn_chain_unit(l, u, lds, tid); if (UDUP & 32) { __syncthreads(); gdn_chain_unit(l, u, lds, tid); } } continue; } u -= 32;
                if (u < 128) { if (um & 64) { ssd_chain_unit(l, u, lds, tid); if (UDUP & 64) { __syncthreads(); ssd_chain_unit(l, u, lds, tid); } } continue; } u -= 128;
                if (u < 1024) { if (u & 1) { if (um & 128) { decode_unit(l, u >> 1, lds, tid); if (UDUP & 128) { __syncthreads(); decode_unit(l, u >> 1, lds, tid); } } } else if (um & 256) { attn_unit(l, u >> 1, lds, tid); if (UDUP & 256) { __syncthreads(); attn_unit(l, u >> 1, lds, tid); } } continue; }
                break; }
        }
        SEAM(P + 3);
        if (IN(P + 4) && (PHM & 32)) for (int rep = 0; rep < REPS(32); ++rep) { if (rep) xcd_barrier(bar);
            for (int u = bid; u < 640; u += G) { if (u < 128) { __syncthreads(); combine_unit(l, u, lds, tid); } else ssd_final_unit(l, u - 128, tid); }
        }
        SEAM(P + 4);
        if (IN(P + 5) && (PHM & 64)) for (int rep = 0; rep < REPS(64); ++rep) { if (rep) xcd_barrier(bar); FRESH();
            const bf16* WoT = WSP(bf16, WS_WOUT) + (size_t)l * DM * MIXW;
            { pg8::Gemm g{WSP(bf16, WS_MIX), WoT, NP, DM, MIXW, MIXW, MIXW}; pg8::StaticOrder S; S.init(NP, DM, G, bid);
              pg8::EpiF32Res E{WSP(float, WS_Y), WSP(float, WS_XF), DM, ALPHA}; pg8::gemm_phase<pg8::EpiF32Res, pg8::StaticOrder, false, true>((PG8_LAS unsigned char*)lds, g, S, E); }
            for (int tile = bid; tile < 256; tile += G) tiny_out_unit(l, tile, lds, tid);
        }
        SEAM(P + 5);
        if (IN(P + 6) && (PHM & 128)) for (int rep = 0; rep < REPS(128); ++rep) { if (rep) xcd_barrier(bar); FRESH();
            ln_phase(l, tid, bid, G);
        }
        if (l == 0) SEAM(P + 6);
    }
#undef IN
#undef SEAM
}

#ifndef MK_ONE_LAUNCH
#define MK_ONE_LAUNCH 1
#endif
extern "C" void kernel_launch(void* const* d_in, const int* in_sizes, int n_in, void* d_out, int out_size, void* d_ws, size_t ws_size, hipStream_t stream) {
    static int grid = 0;
    if (grid == 0) {
        if (n_in != N_IN || (size_t)out_size != OUT_END || ws_size < WS_END) { fprintf(stderr, "kernel_launch: unexpected shapes: n_in %d out %d ws %zu\n", n_in, out_size, ws_size); grid = -1; return; }
        int dev = 0, cus = 0;
        if (hipGetDevice(&dev) != hipSuccess || hipDeviceGetAttribute(&cus, hipDeviceAttributeMultiprocessorCount, dev) != hipSuccess) { grid = -1; return; }
        if (hipFuncSetAttribute((const void*)hymba_fwd, hipFuncAttributeMaxDynamicSharedMemorySize, LDS_BYTES) != hipSuccess) { fprintf(stderr, "kernel_launch: hipFuncSetAttribute failed\n"); grid = -1; return; }
        int per_cu = 0; (void)hipOccupancyMaxActiveBlocksPerMultiprocessor(&per_cu, (const void*)hymba_fwd, NTHR, LDS_BYTES); (void)hipGetLastError();
        grid = cus > 256 ? 256 : cus;
    }
    if (grid < 0) return;
    (void)hipMemsetAsync((char*)d_ws + WS_CTL, 0, CTL_ZERO_BYTES, stream);
    KArgs a{};
    for (int i = 0; i < N_IN; ++i) a.in[i] = (const float*)d_in[i];
    a.out = (float*)d_out; a.ws = (unsigned char*)d_ws;
#if MK_ONE_LAUNCH
    a.ph_lo = 0; a.ph_hi = NPH;
    hipLaunchKernelGGL(hymba_fwd, dim3(grid), dim3(NTHR), LDS_BYTES, stream, a);
#else
    for (int p = 0; p < NPH; ++p) { a.ph_lo = p; a.ph_hi = p + 1; hipLaunchKernelGGL(hymba_fwd, dim3(grid), dim3(NTHR), LDS_BYTES, stream, a); }
#endif
}
```

```cpp
#include <hip/hip_runtime.h>
#include <cstdio>
#include <cstdint>

#define LAS __attribute__((address_space(3)))
#define GAS __attribute__((address_space(1)))
typedef unsigned short bf16;
typedef short bf16x8 __attribute__((ext_vector_type(8)));
typedef short bf16x4 __attribute__((ext_vector_type(4)));
typedef float f32x4 __attribute__((ext_vector_type(4)));
typedef float f32x2 __attribute__((ext_vector_type(2)));
typedef float f32x16 __attribute__((ext_vector_type(16)));
typedef unsigned u32x4 __attribute__((ext_vector_type(4)));
typedef unsigned u32x2 __attribute__((ext_vector_type(2)));

namespace pg8 {
#define PG8_LAS __attribute__((address_space(3)))
typedef unsigned short bf16_t;
constexpr int BM = 256, BK = 64, HALF = 128, HTB = HALF * BK * 2, STAGE_BYTES = 8 * HTB, NXCD = 8, WGM = 8;
__host__ __device__ __forceinline__ int lds_byte(int r, int c) { const int st = (r >> 4) * 2 + (c >> 5), rr = r & 15, cc = c & 31, ob = rr * 64 + cc * 2; return st * 1024 + (ob ^ (((ob >> 9) & 1) << 5)); }
__host__ __device__ __forceinline__ void stage_rc(int b, int& R, int& C) { const int st = b / 1024, sb = b % 1024, swz = sb ^ (((sb >> 9) & 1) << 5); R = (st >> 1) * 16 + swz / 64; C = (st & 1) * 32 + (swz % 64) / 2; }
__host__ __device__ __forceinline__ int perm32(int rho) { const int n = rho >> 4, i = rho & 15; return 8 * (i >> 2) + 4 * n + (i & 3); }
struct Unit { int pm, pn; };
struct Gemm { const bf16_t* A; const bf16_t* Bt; int M, N, K, lda, ldb; };
struct StaticOrder {
    int nM, nN, nwg, G, c;
    __host__ __device__ void init(int M, int N, int G_, int c_) { nM = M / BM; nN = N / BM; nwg = nM * nN; G = G_; c = c_; }
    __host__ __device__ bool next(int i, Unit& u) const {
        const long L = (long)i * G + c; if (L >= nwg) return false;
        int wgid = (int)L; { const int q = nwg / NXCD, r = nwg % NXCD, xcd = wgid % NXCD, off = wgid / NXCD; wgid = (xcd < r ? xcd * (q + 1) : r * (q + 1) + (xcd - r) * q) + off; }
        const int nig = WGM * nN, gid = wgid / nig, fm = gid * WGM, gsz = (nM - fm) < WGM ? (nM - fm) : WGM;
        u.pm = fm + ((wgid % nig) % gsz); u.pn = (wgid % nig) / gsz; return true;
    }
    __device__ __forceinline__ void a_ready(const Unit&) const {}
    __device__ __forceinline__ void done(const Unit&) const {}
};
__device__ __forceinline__ unsigned cvt_pk_bf16(float lo, float hi) { unsigned r; asm volatile("v_cvt_pk_bf16_f32 %0, %1, %2" : "=v"(r) : "v"(lo), "v"(hi)); return r; }
struct EpiBf16 {
    static constexpr bool PERM = true, AFTER_DRAIN = false;
    bf16_t* O; int ldc; int remap;
    __device__ __forceinline__ void operator()(const f32x4 (&acc)[2][2][4][2], const Unit& u, int wr, int wc, int fr, int fq) const {
        const int row0 = u.pm * BM + wr * 64 + fr, colb = u.pn * BM + wc * 32 + 8 * fq;
#pragma unroll
        for (int ai = 0; ai < 2; ++ai)
#pragma unroll
            for (int m = 0; m < 4; ++m) { bf16_t* rowp = O + (size_t)(row0 + ai * HALF + m * 16) * ldc;
#pragma unroll
                for (int bj = 0; bj < 2; ++bj) { int c = colb + bj * HALF; if (remap) c = (c >> 6) * 96 + (c & 63);
                    const f32x4 v0 = acc[ai][bj][m][0], v1 = acc[ai][bj][m][1];
                    u32x4 w; w.x = cvt_pk_bf16(v0[0], v0[1]); w.y = cvt_pk_bf16(v0[2], v0[3]); w.z = cvt_pk_bf16(v1[0], v1[1]); w.w = cvt_pk_bf16(v1[2], v1[3]);
                    *(u32x4*)(rowp + c) = w; } }
    }
};
struct EpiF32Res {
    static constexpr bool PERM = false, AFTER_DRAIN = false;
    float* Y; const float* X; int ldc; float alpha;
    __device__ __forceinline__ void operator()(const f32x4 (&acc)[2][2][4][2], const Unit& u, int wr, int wc, int fr, int fq) const {
        const int row0 = u.pm * BM + wr * 64 + fr, col0 = u.pn * BM + wc * 32 + 4 * fq;
#pragma unroll
        for (int ai = 0; ai < 2; ++ai)
#pragma unroll
            for (int m = 0; m < 4; ++m) { const size_t ro = (size_t)(row0 + ai * HALF + m * 16) * ldc + col0;
#pragma unroll
                for (int bj = 0; bj < 2; ++bj)
#pragma unroll
                    for (int n = 0; n < 2; ++n) { const f32x4 x = *(const f32x4*)(X + ro + bj * HALF + n * 16); *(f32x4*)(Y + ro + bj * HALF + n * 16) = acc[ai][bj][m][n] + x * alpha; } }
    }
};
template <class Epi, class Sched, bool ALIGN_EPI = false, bool SP2 = false>
__device__ __forceinline__ void gemm_phase(PG8_LAS unsigned char* lds, const Gemm g, const Sched& S, const Epi& E) {
    int tid_ = threadIdx.x; asm volatile("" : "+v"(tid_));
    const int tid = tid_, wid = __builtin_amdgcn_readfirstlane(tid >> 6), lane = tid & 63, wr = wid >> 2, wc = wid & 3, fr = lane & 15, fq = lane >> 4;
    const int K = g.K, nt = K / BK;
    unsigned voffA[2], voffB[2];
#pragma unroll
    for (int i = 0; i < 2; ++i) { int R, C; stage_rc(tid * 16 + i * 8192, R, C); const int Rb = Epi::PERM ? ((R & ~31) + perm32(R & 31)) : R;
        voffA[i] = (unsigned)(R * g.lda + C) * 2u; voffB[i] = (unsigned)(Rb * g.ldb + C) * 2u; }
    const size_t kstep = (size_t)(BK * 2);
    const size_t hstepA = (size_t)HALF * g.lda * 2, hstepB = (size_t)HALF * g.ldb * 2;
    const size_t tstepA = 2 * hstepA, tstepB = 2 * hstepB;
    const unsigned ldsw = (unsigned)wid * 1024u;
    const int aoff = lds_byte(wr * 64 + fr, fq * 8), boff = lds_byte(wc * 32 + fr, fq * 8);
#define PG8_SA(b, h) (((b) * 2 + (h)) * HTB)
#define PG8_SB(b, h) ((4 + (b) * 2 + (h)) * HTB)
#define PG8_STAGE(bufoff, gbase, voff) do { _Pragma("unroll") for (int _i = 0; _i < 2; ++_i) \
        __builtin_amdgcn_global_load_lds((const unsigned*)((const char*)(gbase) + (voff)[_i]), (PG8_LAS unsigned*)(lds + (bufoff) + ldsw + _i * 8192), 16, 0, 0); } while (0)
#define PG8_LDA(dst, b, h) do { _Pragma("unroll") for (int m = 0; m < 4; ++m) _Pragma("unroll") for (int k = 0; k < 2; ++k) dst[m][k] = *(const PG8_LAS bf16x8*)(lds + PG8_SA(b, h) + aoff + m * 2048 + k * 1024); } while (0)
#define PG8_LDB(dst, b, h) do { _Pragma("unroll") for (int n = 0; n < 2; ++n) _Pragma("unroll") for (int k = 0; k < 2; ++k) dst[n][k] = *(const PG8_LAS bf16x8*)(lds + PG8_SB(b, h) + boff + n * 2048 + k * 1024); } while (0)
#define PG8_MMA(ai, bj, At, Bt) do { __builtin_amdgcn_s_setprio(1); _Pragma("unroll") for (int m = 0; m < 4; ++m) _Pragma("unroll") for (int n = 0; n < 2; ++n) _Pragma("unroll") for (int k = 0; k < 2; ++k) \
        acc[ai][bj][m][n] = __builtin_amdgcn_mfma_f32_16x16x32_bf16(Bt[n][k], At[m][k], acc[ai][bj][m][n], 0, 0, 0); __builtin_amdgcn_s_setprio(0); } while (0)
#define PG8_WAIT_V(n) asm volatile("s_waitcnt vmcnt(" #n ")" ::: "memory")
#define PG8_WAIT_L(n) asm volatile("s_waitcnt lgkmcnt(" #n ")" ::: "memory")
#define PG8_BAR __builtin_amdgcn_s_barrier()
#define PG8_SCHED __builtin_amdgcn_sched_barrier(0)
    Unit cur, nxt; int ui = 0;
    if (!S.next(0, cur)) return;
    f32x4 acc[2][2][4][2];
#pragma unroll
    for (int a = 0; a < 2; ++a)
#pragma unroll
        for (int b = 0; b < 2; ++b)
#pragma unroll
            for (int m = 0; m < 4; ++m)
#pragma unroll
                for (int n = 0; n < 2; ++n) acc[a][b][m][n] = (f32x4){0.f, 0.f, 0.f, 0.f};
    bf16x8 At[4][2], B0[2][2], B1[2][2];
    const char* cA = (const char*)g.A + (size_t)cur.pm * tstepA; const char* cB = (const char*)g.Bt + (size_t)cur.pn * tstepB;
    S.a_ready(cur);
    if constexpr (SP2) {
        PG8_STAGE(PG8_SB(0, 0), cB, voffB); PG8_STAGE(PG8_SB(0, 1), cB + hstepB, voffB); PG8_STAGE(PG8_SA(0, 0), cA, voffA); PG8_STAGE(PG8_SA(0, 1), cA + hstepA, voffA);
        if (wr == 1) PG8_BAR;
        PG8_WAIT_V(2); PG8_BAR;
        PG8_STAGE(PG8_SB(1, 0), cB + kstep, voffB); PG8_STAGE(PG8_SA(1, 0), cA + kstep, voffA); PG8_STAGE(PG8_SB(1, 1), cB + hstepB + kstep, voffB);
        PG8_WAIT_V(6); PG8_BAR;
    } else {
        PG8_STAGE(PG8_SB(0, 0), cB, voffB); PG8_STAGE(PG8_SA(0, 0), cA, voffA); PG8_STAGE(PG8_SB(0, 1), cB + hstepB, voffB); PG8_STAGE(PG8_SA(0, 1), cA + hstepA, voffA);
        if (wr == 1) PG8_BAR;
        PG8_WAIT_V(4); PG8_BAR;
        PG8_STAGE(PG8_SB(1, 0), cB + kstep, voffB); PG8_STAGE(PG8_SA(1, 0), cA + kstep, voffA); PG8_STAGE(PG8_SB(1, 1), cB + hstepB + kstep, voffB);
        PG8_WAIT_V(6); PG8_BAR;
    }
    for (;;) {
        const bool has_next = S.next(ui + 1, nxt);
        const char* nA = has_next ? (const char*)g.A + (size_t)nxt.pm * tstepA : cA; const char* nB = has_next ? (const char*)g.Bt + (size_t)nxt.pn * tstepB : cB;
        for (int t = 0; t < nt; t += 2) {
            const bool last = (t == nt - 2);
            const char* a1 = cA + (size_t)(t + 1) * kstep;
            const char* a2 = last ? nA : cA + (size_t)(t + 2) * kstep; const char* b2 = last ? nB : cB + (size_t)(t + 2) * kstep;
            const char* a3 = a2 + kstep; const char* b3 = b2 + kstep;
            if (last && has_next) S.a_ready(nxt);
            if constexpr (SP2) {
            PG8_LDB(B0, 0, 0); PG8_LDB(B1, 0, 1); PG8_SCHED; PG8_LDA(At, 0, 0); PG8_STAGE(PG8_SA(1, 1), a1 + hstepA, voffA);
            PG8_WAIT_V(8); PG8_WAIT_L(0); PG8_BAR; PG8_MMA(0, 0, At, B0); PG8_MMA(0, 1, At, B1); PG8_BAR; PG8_SCHED;
            PG8_LDA(At, 0, 1); PG8_STAGE(PG8_SB(0, 0), b2, voffB); PG8_STAGE(PG8_SB(0, 1), b2 + hstepB, voffB); PG8_STAGE(PG8_SA(0, 0), a2, voffA);
            PG8_WAIT_V(8); PG8_WAIT_L(0); PG8_BAR; PG8_MMA(1, 0, At, B0); PG8_MMA(1, 1, At, B1); PG8_BAR; PG8_SCHED;
            PG8_LDB(B0, 1, 0); PG8_LDB(B1, 1, 1); PG8_SCHED; PG8_LDA(At, 1, 0); PG8_STAGE(PG8_SA(0, 1), a2 + hstepA, voffA);
            PG8_WAIT_V(8); PG8_WAIT_L(0); PG8_BAR; PG8_MMA(0, 0, At, B0); PG8_MMA(0, 1, At, B1); PG8_BAR; PG8_SCHED;
            PG8_LDA(At, 1, 1); PG8_STAGE(PG8_SB(1, 0), b3, voffB); PG8_STAGE(PG8_SB(1, 1), b3 + hstepB, voffB); PG8_STAGE(PG8_SA(1, 0), a3, voffA);
            PG8_WAIT_V(8); PG8_WAIT_L(0); PG8_BAR; PG8_MMA(1, 0, At, B0); PG8_MMA(1, 1, At, B1); PG8_BAR; PG8_SCHED;
            } else {
            PG8_LDB(B0, 0, 0); PG8_SCHED; PG8_LDA(At, 0, 0); PG8_STAGE(PG8_SA(1, 1), a1 + hstepA, voffA);
            PG8_WAIT_L(8); PG8_BAR; PG8_WAIT_L(0); PG8_MMA(0, 0, At, B0); PG8_BAR; PG8_SCHED;
            PG8_LDB(B1, 0, 1); PG8_STAGE(PG8_SB(0, 0), b2, voffB);
            PG8_BAR; PG8_WAIT_L(0); PG8_MMA(0, 1, At, B1); PG8_BAR;
            PG8_LDA(At, 0, 1); PG8_STAGE(PG8_SA(0, 0), a2, voffA);
            PG8_BAR; PG8_WAIT_L(0); PG8_MMA(1, 0, At, B0); PG8_BAR; PG8_SCHED;
            PG8_STAGE(PG8_SB(0, 1), b2 + hstepB, voffB);
            PG8_WAIT_V(6); PG8_BAR; PG8_MMA(1, 1, At, B1); PG8_BAR;
            PG8_LDB(B0, 1, 0); PG8_SCHED; PG8_LDA(At, 1, 0); PG8_STAGE(PG8_SA(0, 1), a2 + hstepA, voffA);
            PG8_WAIT_L(8); PG8_BAR; PG8_WAIT_L(0); PG8_MMA(0, 0, At, B0); PG8_BAR; PG8_SCHED;
            PG8_LDB(B1, 1, 1); PG8_STAGE(PG8_SB(1, 0), b3, voffB);
            PG8_BAR; PG8_WAIT_L(0); PG8_MMA(0, 1, At, B1); PG8_BAR;
            PG8_LDA(At, 1, 1); PG8_STAGE(PG8_SA(1, 0), a3, voffA);
            PG8_BAR; PG8_WAIT_L(0); PG8_MMA(1, 0, At, B0); PG8_BAR; PG8_SCHED;
            PG8_STAGE(PG8_SB(1, 1), b3 + hstepB, voffB);
            PG8_WAIT_V(6); PG8_BAR; PG8_MMA(1, 1, At, B1); PG8_BAR;
            }
        }
        if constexpr (ALIGN_EPI) { if (wr == 0) PG8_BAR; }
        if constexpr (!Epi::AFTER_DRAIN) { E(acc, cur, wr, wc, fr, fq); S.done(cur); }
        if (!has_next) break;
#pragma unroll
        for (int a = 0; a < 2; ++a)
#pragma unroll
            for (int b = 0; b < 2; ++b)
#pragma unroll
                for (int m = 0; m < 4; ++m)
#pragma unroll
                    for (int n = 0; n < 2; ++n) acc[a][b][m][n] = (f32x4){0.f, 0.f, 0.f, 0.f};
        cur = nxt; cA = nA; cB = nB; ++ui;
        if constexpr (ALIGN_EPI) { if (wr == 1) PG8_BAR; }
    }
    PG8_WAIT_V(0);
    if constexpr (!ALIGN_EPI) { if (wr == 0) PG8_BAR; }
    PG8_BAR;
    if constexpr (Epi::AFTER_DRAIN) { E.fused(acc, cur, wr, wc, fr, fq, lds, wid, lane); S.done(cur); }
#undef PG8_SA
#undef PG8_SB
#undef PG8_STAGE
#undef PG8_LDA
#undef PG8_LDB
#undef PG8_MMA
#undef PG8_WAIT_V
#undef PG8_WAIT_L
#undef PG8_BAR
#undef PG8_SCHED
}
}

constexpr int DM = 1024, NPB = 8, SEQ = 2048, NP = NPB * SEQ, NSB = 32, DSQ = 4, NS = NSB * DSQ, MT = NP + NS, MP = 16640;
constexpr int PASTL = 16384, PAGE = 128, NPAGES = 128, NPHYS = 5120;
constexpr int INW = 5816, INWP = 5888, MIXW = 2048;
constexpr int O_SSDZ = 0, O_XBC = 1024, O_DT = 2560, O_CQ = 2576, O_CKV = 2960, O_KR = 3216, O_GATE = 3248, O_GQKV = 3760, O_GZ = 5296, O_GB = 5808, O_GA = 5812;
constexpr float LN_EPS = 1e-5f, RMS_EPS = 1e-6f, L2_EPS = 1e-6f, ALPHA = 1.41421356237309515f;
constexpr float LOG2E = 1.4426950408889634f;
constexpr float ATT_SC = 0.10206207261596575f * LOG2E;
constexpr size_t OUT_YP = 0, OUT_YS = OUT_YP + 16777216, OUT_PLAT = OUT_YS + 131072, OUT_PROPE = OUT_PLAT + 8388608, OUT_PSC = OUT_PROPE + 1048576, OUT_PSSD = OUT_PSC + 73728,
                 OUT_PGC = OUT_PSSD + 2097152, OUT_PGDN = OUT_PGC + 73728, OUT_SLAT = OUT_PGDN + 1048576, OUT_SROPE = OUT_SLAT + 65536, OUT_SSC = OUT_SROPE + 8192,
                 OUT_SSSD = OUT_SSC + 294912, OUT_SGC = OUT_SSSD + 8388608, OUT_SGDN = OUT_SGC + 294912, OUT_END = OUT_SGDN + 4194304;
enum { I_XP = 0, I_XS, I_CLAT, I_CROPE, I_SSC, I_SSD, I_SGC, I_SGDN, I_PT, I_EG, I_EB, I_WIN, I_SCW, I_SCB, I_SDTB, I_SALOG, I_SD, I_SNW, I_QNW, I_WUQ, I_KVNW, I_WUK, I_WUV,
       I_GCW, I_GDTB, I_GALOG, I_GNW, I_WOUT, I_LNG, I_LNB, N_IN };
constexpr size_t MiB = 1u << 20;
constexpr size_t WS_CTL = 0, CTL_ZERO_BYTES = 1 * MiB;
constexpr size_t WS_WIN = 2 * MiB, WS_WOUT = 26 * MiB, WS_WUQ = 34 * MiB, WS_WUK = 36 * MiB, WS_WUV = 37 * MiB, WS_WABS = 38 * MiB, WS_ROPECS = 42 * MiB;
constexpr size_t WS_XF = 46 * MiB, WS_XN = 112 * MiB, WS_PROJ = 146 * MiB, WS_CQN = 334 * MiB, WS_CKVN = 347 * MiB, WS_KROPE = 356 * MiB, WS_Q = 358 * MiB, WS_KK = 383 * MiB;
constexpr size_t WS_VT = 407 * MiB, WS_QLAT = 423 * MiB, WS_CC = 424 * MiB, WS_ACUM = 432 * MiB, WS_YI = 433 * MiB, WS_HLOC = 497 * MiB, WS_YG = 561 * MiB, WS_SSQ = 593 * MiB;
constexpr size_t WS_GNW = 594 * MiB, WS_GQG = 610 * MiB, WS_GKDT = 626 * MiB, WS_GU = 642 * MiB, WS_GATT = 674 * MiB, WS_GEG = 682 * MiB, WS_PARTO = 683 * MiB, WS_PARTML = 699 * MiB;
constexpr size_t WS_MIX = 700 * MiB, WS_Y = 766 * MiB, WS_END = 832 * MiB;
static_assert(WS_WIN + (size_t)2 * INWP * DM * 2 <= WS_WOUT && WS_XF + (size_t)MT * DM * 4 <= WS_XN && WS_XN + (size_t)MP * DM * 2 <= WS_PROJ && WS_PROJ + (size_t)MP * INWP * 2 <= WS_CQN, "ws map");
static_assert(WS_CQN + (size_t)MP * 384 * 2 <= WS_CKVN && WS_CKVN + (size_t)MP * 256 * 2 <= WS_KROPE && WS_Q + (size_t)MP * 768 * 2 <= WS_KK && WS_MIX + (size_t)MP * MIXW * 2 <= WS_Y && WS_Y + (size_t)MT * DM * 4 <= WS_END, "ws map");
constexpr int CW_BAR = 4096;
constexpr int CW_Q = 16384;
constexpr int LDS_BYTES = 147456, MISC_OFF = 144 * 1024 - 256;
constexpr int NWAVES = 8, NTHR = 512;

#define LDS_WAIT() asm volatile("s_waitcnt lgkmcnt(0)" ::: "memory")
#define VM_WAIT() asm volatile("s_waitcnt vmcnt(0)" ::: "memory")
__device__ __forceinline__ float bflo(unsigned w) { return __uint_as_float(w << 16); }
__device__ __forceinline__ float bfhi(unsigned w) { return __uint_as_float(w & 0xffff0000u); }
__device__ __forceinline__ float bf2f(bf16 v) { return __uint_as_float((unsigned)v << 16); }
__device__ __forceinline__ unsigned pk2(float lo, float hi) { unsigned r; asm volatile("v_cvt_pk_bf16_f32 %0, %1, %2" : "=v"(r) : "v"(lo), "v"(hi)); return r; }
__device__ __forceinline__ bf16 f2bf(float f) { return (bf16)(pk2(f, 0.f) & 0xffffu); }
__device__ __forceinline__ float silu_f(float x) { return x * __builtin_amdgcn_rcpf(1.f + __expf(-x)); }
__device__ __forceinline__ float sigmoid_f(float x) { return __builtin_amdgcn_rcpf(1.f + __expf(-x)); }
__device__ __forceinline__ float softplus_f(float x) { return x > 20.f ? x : log1pf(__expf(x)); }
__device__ __forceinline__ float wave_sum(float v) {
    v += __builtin_bit_cast(float, __builtin_amdgcn_update_dpp(0, __builtin_bit_cast(int, v), 0xB1, 0xF, 0xF, true));
    v += __builtin_bit_cast(float, __builtin_amdgcn_update_dpp(0, __builtin_bit_cast(int, v), 0x4E, 0xF, 0xF, true));
    v += __builtin_bit_cast(float, __builtin_amdgcn_update_dpp(0, __builtin_bit_cast(int, v), 0x141, 0xF, 0xF, true));
    v += __builtin_bit_cast(float, __builtin_amdgcn_update_dpp(0, __builtin_bit_cast(int, v), 0x140, 0xF, 0xF, true));
    v += __builtin_bit_cast(float, __builtin_amdgcn_update_dpp(0, __builtin_bit_cast(int, v), 0x142, 0xA, 0xF, false));
    v += __builtin_bit_cast(float, __builtin_amdgcn_update_dpp(0, __builtin_bit_cast(int, v), 0x143, 0xC, 0xF, false));
    return __builtin_bit_cast(float, __builtin_amdgcn_readlane(__builtin_bit_cast(int, v), 63));
}
__device__ __forceinline__ float half_sum(float v) { float a = v, b = v; asm volatile("s_nop 1\n\tv_permlane32_swap_b32 %0, %1\n\ts_nop 1" : "+v"(a), "+v"(b)); return a + b; }
__device__ __forceinline__ float half_max(float v) { float a = v, b = v; asm volatile("s_nop 1\n\tv_permlane32_swap_b32 %0, %1\n\ts_nop 1" : "+v"(a), "+v"(b)); return fmaxf(a, b); }
__device__ __forceinline__ float row16_sum(float v) { float a = v, b = v; asm volatile("s_nop 1\n\tv_permlane16_swap_b32 %0, %1\n\ts_nop 1" : "+v"(a), "+v"(b)); return a + b; }
__device__ __forceinline__ float wave_scan_incl(float v, int lane) {
#pragma unroll
    for (int o = 1; o < 64; o <<= 1) { const float t = __shfl_up(v, o); if (lane >= o) v += t; }
    return v;
}
__device__ __forceinline__ f32x4 mfma16(bf16x8 a, bf16x8 b, f32x4 c) { return __builtin_amdgcn_mfma_f32_16x16x32_bf16(a, b, c, 0, 0, 0); }
__device__ __forceinline__ f32x16 mfma32(bf16x8 a, bf16x8 b, f32x16 c) { return __builtin_amdgcn_mfma_f32_32x32x16_bf16(a, b, c, 0, 0, 0); }
__device__ __forceinline__ bf16x8 frag16(const bf16* base, int pitch, int row0, int k0, int lane) { return *(const bf16x8*)(base + (row0 + (lane & 15)) * pitch + k0 + 8 * (lane >> 4)); }
__device__ __forceinline__ bf16x8 frag16p(const bf16* base, int pitch, int row0, int k0, int lane) {
    const bf16* p = base + (row0 + (lane & 15)) * pitch + k0 + 4 * (lane >> 4);
    const bf16x4 lo = *(const bf16x4*)p, hi = *(const bf16x4*)(p + 16);
    return (bf16x8){lo[0], lo[1], lo[2], lo[3], hi[0], hi[1], hi[2], hi[3]};
}
__device__ __forceinline__ bf16x8 accpair(f32x4 a, f32x4 b) { u32x4 w; w.x = pk2(a[0], a[1]); w.y = pk2(a[2], a[3]); w.z = pk2(b[0], b[1]); w.w = pk2(b[2], b[3]); return __builtin_bit_cast(bf16x8, w); }

#define XB_TMO      128
#define XB_XCNT(j)  (256  + 64 * (j))
#define XB_XSUB(j)  (1280 + 64 * (j))
#define XB_XGEN(j)  (2304 + 64 * (j))
#define XB_TOP      3328
#define XB_TOPGEN   3392
#define XCD_BAR_WORDS 3456
#define XB_SPIN_CAP (1u << 18)

__device__ __forceinline__ unsigned xb_ld(unsigned* p)              { return __hip_atomic_load(p, __ATOMIC_RELAXED, __HIP_MEMORY_SCOPE_AGENT); }
__device__ __forceinline__ unsigned xb_add(unsigned* p, unsigned v) { return __hip_atomic_fetch_add(p, v, __ATOMIC_RELAXED, __HIP_MEMORY_SCOPE_AGENT); }
__device__ __forceinline__ unsigned xb_xcc_id() { return (unsigned)__builtin_amdgcn_s_getreg((3 << 11) | 20) & 0xFu; }
#define XB_SPIN(cond, bar) do { unsigned _sp = 0; while (cond) { __builtin_amdgcn_s_sleep(1); \
    if ((++_sp & 255u) == 0u) { if (xb_ld(&(bar)[XB_TMO])) break; if (_sp > XB_SPIN_CAP) { atomicAdd(&(bar)[XB_TMO], 1u); break; } } } } while (0)

struct XcdBarrier {
    unsigned* bar; unsigned x;
    volatile LAS unsigned* st;
};

__device__ __forceinline__ XcdBarrier xcd_barrier_post(unsigned* bar, volatile LAS unsigned* st) {
    XcdBarrier b; b.bar = bar; b.x = xb_xcc_id(); b.st = st;
    if (threadIdx.x == 0) (void)xb_add(&bar[XB_XCNT(b.x)], 1u);
    return b;
}
__device__ __forceinline__ void xcd_barrier_complete(unsigned* bar, unsigned x, unsigned& nloc, unsigned& nx) {
    const unsigned G = gridDim.x * gridDim.y * gridDim.z;
    unsigned sum, cnt, mine, sp = 0u;
    for (;;) {
        sum = 0u; cnt = 0u; mine = 0u;
#pragma unroll
        for (unsigned j = 0; j < 16; ++j) { const unsigned c = xb_ld(&bar[XB_XCNT(j)]); sum += c; cnt += (c > 0u) ? 1u : 0u; mine = (j == x) ? c : mine; }
        if (sum == G) break;
        __builtin_amdgcn_s_sleep(1);
        if ((++sp & 255u) == 0u) { if (xb_ld(&bar[XB_TMO])) break; if (sp > XB_SPIN_CAP) { atomicAdd(&bar[XB_TMO], 1u); break; } }
    }
    nloc = mine > 0u ? mine : 1u; nx = cnt > 0u ? cnt : 1u;
}

__device__ __forceinline__ void xcd_barrier(const XcdBarrier& b) {
    asm volatile("s_waitcnt vmcnt(0)" ::: "memory");
    __syncthreads();
    if (threadIdx.x == 0) {
        unsigned* bar = b.bar;
        __builtin_amdgcn_s_waitcnt(0);
        unsigned nloc = b.st[0], nx = b.st[1];
        if (nloc == 0u) { xcd_barrier_complete(bar, b.x, nloc, nx); b.st[0] = nloc; b.st[1] = nx; }
        const unsigned old = xb_add(&bar[XB_XSUB(b.x)], 1u);
        const unsigned gen = old / nloc;
        if (old + 1u == (gen + 1u) * nloc) {
            __builtin_amdgcn_fence(__ATOMIC_RELEASE, "agent");
            asm volatile("s_waitcnt vmcnt(0)" ::: "memory");
            const unsigned og = xb_add(&bar[XB_TOP], 1u);
            const unsigned tg = og / nx;
            if (og + 1u == (tg + 1u) * nx) xb_add(&bar[XB_TOPGEN], 1u);
            else XB_SPIN(xb_ld(&bar[XB_TOPGEN]) == tg, bar);
            __builtin_amdgcn_fence(__ATOMIC_ACQUIRE, "agent");
            xb_add(&bar[XB_XGEN(b.x)], 1u);
            asm volatile("s_waitcnt vmcnt(0)" ::: "memory");
        } else {
            XB_SPIN(xb_ld(&bar[XB_XGEN(b.x)]) == gen, bar);
            __builtin_amdgcn_fence(__ATOMIC_ACQUIRE, "agent");
            asm volatile("s_waitcnt vmcnt(0)" ::: "memory");
        }
    }
    __syncthreads();
}

struct KArgs { const float* in[N_IN]; float* out; unsigned char* ws; int ph_lo, ph_hi; };
#define WSP(T, off) ((T*)(ws + (off)))
#define CAS __attribute__((address_space(4)))
#define ENTER() const CAS KArgs* kp_ = (const CAS KArgs*)__builtin_amdgcn_kernarg_segment_ptr(); asm volatile("" : "+s"(kp_)); const CAS KArgs& a = *kp_; unsigned char* ws = a.ws; asm volatile("" : "+v"(tid)); const int lane = tid & 63, wave = __builtin_amdgcn_readfirstlane(tid >> 6); (void)lane; (void)wave

__device__ __forceinline__ int q_next(unsigned* ctr, volatile unsigned* slot, int tid) {
    __syncthreads();
    if (tid == 0) *slot = __hip_atomic_fetch_add(ctr, 1u, __ATOMIC_RELAXED, __HIP_MEMORY_SCOPE_AGENT);
    __syncthreads();
    return __builtin_amdgcn_readfirstlane((int)*slot);
}

__device__ __forceinline__ void tr_item(const float* W, int K, int N, int Npad, bf16* WT, float* scr, int item, int lane) {
    const int nblk = Npad / 32, kb = item / nblk, nb = item % nblk, k0 = 64 * kb, n0 = 32 * nb;
    const int n = n0 + (lane & 31);
#pragma unroll
    for (int i = 0; i < 32; ++i) { const int kk = 2 * i + (lane >> 5); scr[kk * 33 + (lane & 31)] = (n < N) ? W[(size_t)(k0 + kk) * N + n] : 0.f; }
    LDS_WAIT(); asm volatile("" ::: "memory");
    const int c = lane & 7;
#pragma unroll
    for (int j = 0; j < 4; ++j) { const int nn = (lane >> 3) + 8 * j; const float* s = scr + (8 * c) * 33 + nn;
        u32x4 o; o.x = pk2(s[0 * 33], s[1 * 33]); o.y = pk2(s[2 * 33], s[3 * 33]); o.z = pk2(s[4 * 33], s[5 * 33]); o.w = pk2(s[6 * 33], s[7 * 33]);
        *(u32x4*)(WT + (size_t)(n0 + nn) * K + k0 + 8 * c) = o; }
    LDS_WAIT(); asm volatile("" ::: "memory");
}
__device__ __forceinline__ void ln_row(const float* xrow, const float* g, const float* b, float* of32, bf16* obf, int lane) {
    f32x4 v[4]; float s = 0.f;
#pragma unroll
    for (int j = 0; j < 4; ++j) { v[j] = *(const f32x4*)(xrow + 4 * lane + 256 * j); s += (v[j].x + v[j].y) + (v[j].z + v[j].w); }
    const float mean = wave_sum(s) * (1.f / DM); float s2 = 0.f;
#pragma unroll
    for (int j = 0; j < 4; ++j) { v[j] = v[j] - mean; s2 += (v[j].x * v[j].x + v[j].y * v[j].y) + (v[j].z * v[j].z + v[j].w * v[j].w); }
    const float rstd = 1.f / sqrtf(wave_sum(s2) * (1.f / DM) + LN_EPS);
#pragma unroll
    for (int j = 0; j < 4; ++j) { const f32x4 gg = *(const f32x4*)(g + 4 * lane + 256 * j), bb = *(const f32x4*)(b + 4 * lane + 256 * j); const f32x4 o = v[j] * rstd * gg + bb;
        if (of32) *(f32x4*)(of32 + 4 * lane + 256 * j) = o;
        if (obf) { u32x2 w; w.x = pk2(o.x, o.y); w.y = pk2(o.z, o.w); *(u32x2*)(obf + 4 * lane + 256 * j) = w; } }
}
__device__ __forceinline__ void ln_row2(const float* x1, const float* x2, const float* g, const float* b, float* of1, bf16* ob1, float* of2, bf16* ob2, int lane) {
    f32x4 v[2][4]; float s[2] = {0.f, 0.f};
#pragma unroll
    for (int j = 0; j < 4; ++j) { v[0][j] = *(const f32x4*)(x1 + 4 * lane + 256 * j); v[1][j] = *(const f32x4*)(x2 + 4 * lane + 256 * j); }
#pragma unroll
    for (int r = 0; r < 2; ++r)
#pragma unroll
        for (int j = 0; j < 4; ++j) s[r] += (v[r][j].x + v[r][j].y) + (v[r][j].z + v[r][j].w);
    float rstd[2];
#pragma unroll
    for (int r = 0; r < 2; ++r) { const float mean = wave_sum(s[r]) * (1.f / DM); float s2 = 0.f;
#pragma unroll
        for (int j = 0; j < 4; ++j) { v[r][j] = v[r][j] - mean; s2 += (v[r][j].x * v[r][j].x + v[r][j].y * v[r][j].y) + (v[r][j].z * v[r][j].z + v[r][j].w * v[r][j].w); }
        rstd[r] = 1.f / sqrtf(wave_sum(s2) * (1.f / DM) + LN_EPS); }
#pragma unroll
    for (int j = 0; j < 4; ++j) { const f32x4 gg = *(const f32x4*)(g + 4 * lane + 256 * j), bb = *(const f32x4*)(b + 4 * lane + 256 * j);
#pragma unroll
        for (int r = 0; r < 2; ++r) { const f32x4 o = v[r][j] * rstd[r] * gg + bb; float* of = r ? of2 : of1; bf16* ob = r ? ob2 : ob1;
            if (of) *(f32x4*)(of + 4 * lane + 256 * j) = o;
            if (ob) { u32x2 w; w.x = pk2(o.x, o.y); w.y = pk2(o.z, o.w); *(u32x2*)(ob + 4 * lane + 256 * j) = w; } } }
}
__device__ __forceinline__ void ph_prologue(unsigned char* lds, int tid, int bid, int G) { ENTER();
    float* scr = (float*)(lds + wave * 8448);
    const int gw = bid * NWAVES + wave, NGW = G * NWAVES, gt = bid * NTHR + tid, NGT = G * NTHR;
    constexpr int IT_IN = 16 * 184, IT_OUT = 32 * 32, IT_UQ = 6 * 24, IT_UK = 4 * 16, IT_L = IT_IN + IT_OUT + IT_UQ + 2 * IT_UK;
    for (int it = gw; it < 2 * IT_L; it += NGW) {
        const int l = it / IT_L; int r = it % IT_L;
        if (r < IT_IN) { tr_item(a.in[I_WIN] + (size_t)l * DM * INW, DM, INW, INWP, WSP(bf16, WS_WIN) + (size_t)l * INWP * DM, scr, r, lane); continue; } r -= IT_IN;
        if (r < IT_OUT) { tr_item(a.in[I_WOUT] + (size_t)l * MIXW * DM, MIXW, DM, DM, WSP(bf16, WS_WOUT) + (size_t)l * DM * MIXW, scr, r, lane); continue; } r -= IT_OUT;
        if (r < IT_UQ) { tr_item(a.in[I_WUQ] + (size_t)l * 384 * 768, 384, 768, 768, WSP(bf16, WS_WUQ) + (size_t)l * 768 * 384, scr, r, lane); continue; } r -= IT_UQ;
        if (r < IT_UK) { tr_item(a.in[I_WUK] + (size_t)l * 256 * 512, 256, 512, 512, WSP(bf16, WS_WUK) + (size_t)l * 512 * 256, scr, r, lane); continue; } r -= IT_UK;
        tr_item(a.in[I_WUV] + (size_t)l * 256 * 512, 256, 512, 512, WSP(bf16, WS_WUV) + (size_t)l * 512 * 256, scr, r, lane);
    }
    __syncthreads();
    { float* qs = (float*)(lds + 69632); float* ks = qs + 64 * 65;
      for (int tile = bid; tile < 2 * 8 * 4 * 6; tile += G) {
        const int kb = tile % 6, rb = (tile / 6) % 4, h = (tile / 24) % 8, l = tile / 192;
        for (int e = tid; e < 64 * 16; e += NTHR) { const int row = e >> 4, c4 = (e & 15) * 4;
            const f32x4 x = *(const f32x4*)(a.in[I_WUQ] + ((size_t)l * 384 + 64 * kb + row) * 768 + h * 96 + c4), y = *(const f32x4*)(a.in[I_WUK] + ((size_t)l * 256 + 64 * rb + row) * 512 + h * 64 + c4);
            float* pq = qs + row * 65 + c4; pq[0] = x.x; pq[1] = x.y; pq[2] = x.z; pq[3] = x.w; float* pk = ks + row * 65 + c4; pk[0] = y.x; pk[1] = y.y; pk[2] = y.z; pk[3] = y.w; }
        __syncthreads();
        { const int kk = tid & 63, r0 = tid >> 6; float acc[8];
#pragma unroll
          for (int j = 0; j < 8; ++j) acc[j] = 0.f;
          for (int d = 0; d < 64; ++d) { const float qv = qs[kk * 65 + d];
#pragma unroll
              for (int j = 0; j < 8; ++j) acc[j] += qv * ks[(r0 + 8 * j) * 65 + d]; }
          bf16* o = WSP(bf16, WS_WABS) + ((size_t)l * 2048 + h * 256 + 64 * rb) * 384 + 64 * kb + kk;
#pragma unroll
          for (int j = 0; j < 8; ++j) o[(size_t)(r0 + 8 * j) * 384] = f2bf(acc[j]); }
        __syncthreads();
      } }
    for (int e = gt; e < MT * 16; e += NGT) {
        const int i = e & 15, m = e >> 4; const int pos = (m < NP) ? (m & (SEQ - 1)) : (PASTL + ((m - NP) & 3));
        const float inv = powf(10000.f, -(float)i * (1.f / 16.f)); const float ang = (float)pos * inv;
        float sn, cs; sincosf(ang, &sn, &cs);
        WSP(float, WS_ROPECS)[m * 32 + i] = cs; WSP(float, WS_ROPECS)[m * 32 + 16 + i] = sn;
    }
    for (int m = gw; m < MT; m += 2 * NGW) {
        const int m2 = m + NGW; const bool has2 = m2 < MT; const int mm2 = has2 ? m2 : m;
        const float* xr = (m < NP) ? a.in[I_XP] + (size_t)m * DM : a.in[I_XS] + (size_t)(m - NP) * DM;
        const float* xr2 = (mm2 < NP) ? a.in[I_XP] + (size_t)mm2 * DM : a.in[I_XS] + (size_t)(mm2 - NP) * DM;
        ln_row2(xr, xr2, a.in[I_EG], a.in[I_EB], WSP(float, WS_XF) + (size_t)m * DM, WSP(bf16, WS_XN) + (size_t)m * DM, WSP(float, WS_XF) + (size_t)mm2 * DM, WSP(bf16, WS_XN) + (size_t)mm2 * DM, lane);
    }
}

__device__ __forceinline__ void e1_unit(int l, int unit, int tid) { ENTER();
    const bf16* PROJ = WSP(bf16, WS_PROJ); const float* RC = WSP(float, WS_ROPECS);
    const int m0 = unit * 32 + wave * 4;
    {
        unsigned w[4][3];
#pragma unroll
        for (int i = 0; i < 4; ++i) { const bf16* pr = PROJ + (size_t)(m0 + i) * INWP + O_CQ + 2 * lane; w[i][0] = *(const unsigned*)pr; w[i][1] = *(const unsigned*)(pr + 128); w[i][2] = *(const unsigned*)(pr + 256); }
        const float* nw = a.in[I_QNW] + l * 384 + 2 * lane; const float n0 = nw[0], n1 = nw[1], n2 = nw[128], n3 = nw[129], n4 = nw[256], n5 = nw[257];
#pragma unroll
        for (int i = 0; i < 4; ++i) { const float x0 = bflo(w[i][0]), x1 = bfhi(w[i][0]), x2 = bflo(w[i][1]), x3 = bfhi(w[i][1]), x4 = bflo(w[i][2]), x5 = bfhi(w[i][2]);
            const float r = 1.f / sqrtf(wave_sum(x0 * x0 + x1 * x1 + x2 * x2 + x3 * x3 + x4 * x4 + x5 * x5) * (1.f / 384.f) + RMS_EPS);
            bf16* o = WSP(bf16, WS_CQN) + (size_t)(m0 + i) * 384 + 2 * lane;
            *(unsigned*)(o) = pk2(x0 * r * n0, x1 * r * n1); *(unsigned*)(o + 128) = pk2(x2 * r * n2, x3 * r * n3); *(unsigned*)(o + 256) = pk2(x4 * r * n4, x5 * r * n5); }
    }
    {
        u32x2 w[4];
#pragma unroll
        for (int i = 0; i < 4; ++i) w[i] = *(const u32x2*)(PROJ + (size_t)(m0 + i) * INWP + O_CKV + 4 * lane);
        const f32x4 nw = *(const f32x4*)(a.in[I_KVNW] + l * 256 + 4 * lane);
#pragma unroll
        for (int i = 0; i < 4; ++i) { const int m = m0 + i; const float x0 = bflo(w[i].x), x1 = bfhi(w[i].x), x2 = bflo(w[i].y), x3 = bfhi(w[i].y);
            const float r = 1.f / sqrtf(wave_sum(x0 * x0 + x1 * x1 + x2 * x2 + x3 * x3) * (1.f / 256.f) + RMS_EPS);
            const f32x4 v = (f32x4){x0 * r * nw.x, x1 * r * nw.y, x2 * r * nw.z, x3 * r * nw.w};
            float* o = (m >= NP) ? a.out + OUT_SLAT + ((size_t)l * NS + (m - NP)) * 256 : a.out + OUT_PLAT + ((size_t)l * NP + m) * 256;
            *(f32x4*)(o + 4 * lane) = v;
            u32x2 ww; ww.x = pk2(v.x, v.y); ww.y = pk2(v.z, v.w); *(u32x2*)(WSP(bf16, WS_CKVN) + (size_t)m * 256 + 4 * lane) = ww; }
    }
    {
        const int i = lane >> 4, j = lane & 15, m = m0 + i; const bf16* pr = PROJ + (size_t)m * INWP + O_KR;
        const float x1 = bf2f(pr[j]), x2 = bf2f(pr[16 + j]), c = RC[m * 32 + j], s = RC[m * 32 + 16 + j];
        const float o1 = x1 * c - x2 * s, o2 = x2 * c + x1 * s; const bool samp = m >= NP;
        float* o = samp ? a.out + OUT_SROPE + ((size_t)l * NS + (m - NP)) * 32 : a.out + OUT_PROPE + ((size_t)l * NP + m) * 32;
        o[j] = o1; o[16 + j] = o2;
        const bf16 b1 = f2bf(o1), b2 = f2bf(o2);
        bf16* kr = WSP(bf16, WS_KROPE) + (size_t)m * 32; kr[j] = b1; kr[16 + j] = b2;
        if (!samp) { bf16* kk = WSP(bf16, WS_KK) + (size_t)m * 768 + 64;
#pragma unroll
            for (int h = 0; h < 8; ++h) { kk[h * 96 + j] = b1; kk[h * 96 + 16 + j] = b2; } }
    }
    for (int i = 0; i < 4; ++i) {
        const int m = m0 + i; const bool samp = m >= NP; const int sb = samp ? (m - NP) >> 2 : m >> 11, st = samp ? (m - NP) & 3 : m & (SEQ - 1), T = samp ? DSQ : SEQ;
        if (st >= T - 3) { const int j = st - (T - 3); const bf16* pr = PROJ + (size_t)m * INWP;
            float* o1 = samp ? a.out + OUT_SSC + ((size_t)(l * NSB + sb) * 3 + j) * 1536 : a.out + OUT_PSC + ((size_t)(l * NPB + sb) * 3 + j) * 1536;
            float* o2 = samp ? a.out + OUT_SGC + ((size_t)(l * NSB + sb) * 3 + j) * 1536 : a.out + OUT_PGC + ((size_t)(l * NPB + sb) * 3 + j) * 1536;
            for (int c = 2 * lane; c < 1536; c += 128) {
                const unsigned w1 = *(const unsigned*)(pr + O_XBC + c), w2 = *(const unsigned*)(pr + O_GQKV + c);
                o1[c] = bflo(w1); o1[c + 1] = bfhi(w1); o2[c] = bflo(w2); o2[c + 1] = bfhi(w2); } }
    }
}

template <int NR, bool SILU_BIAS>
__device__ __forceinline__ void conv_pair(const bf16* colp  , int r0, bool first, const float* wp  , const float* bp  , f32x2 (&y)[NR]) {
    f32x2 w[4];
#pragma unroll
    for (int j = 0; j < 4; ++j) w[j] = (f32x2){wp[j * 1536], wp[j * 1536 + 1]};
    const f32x2 bias = bp ? (f32x2){bp[0], bp[1]} : (f32x2){0.f, 0.f};
    f32x2 h[3];
#pragma unroll
    for (int j = 0; j < 3; ++j) { const int r = r0 - 3 + j; unsigned v = 0u; if (!(first && r < 0)) v = *(const unsigned*)(colp + (long)r * INWP); h[j] = (f32x2){bflo(v), bfhi(v)}; }
#pragma unroll
    for (int i = 0; i < NR; ++i) {
        const unsigned v = *(const unsigned*)(colp + (long)(r0 + i) * INWP); const f32x2 cur = (f32x2){bflo(v), bfhi(v)};
        f32x2 s = w[0] * h[0] + w[1] * h[1] + w[2] * h[2] + w[3] * cur + bias;
        y[i] = (f32x2){silu_f(s.x), silu_f(s.y)};
        h[0] = h[1]; h[1] = h[2]; h[2] = cur;
    }
}


template <int NR>
__device__ __forceinline__ void conv_load(const bf16* colp, int r0, bool first, unsigned (&raw)[NR + 3]) {
#pragma unroll
    for (int j = 0; j < 3; ++j) { const int r = r0 - 3 + j; unsigned v = 0u; if (!(first && r < 0)) v = *(const unsigned*)(colp + (long)r * INWP); raw[j] = v; }
#pragma unroll
    for (int i = 0; i < NR; ++i) raw[3 + i] = *(const unsigned*)(colp + (long)(r0 + i) * INWP);
}
template <int NR>
__device__ __forceinline__ void conv_apply(const unsigned (&raw)[NR + 3], const float* wp, const float* bp, f32x2 (&y)[NR]) {
    f32x2 w[4];
#pragma unroll
    for (int j = 0; j < 4; ++j) w[j] = (f32x2){wp[j * 1536], wp[j * 1536 + 1]};
    const f32x2 bias = bp ? (f32x2){bp[0], bp[1]} : (f32x2){0.f, 0.f};
#pragma unroll
    for (int i = 0; i < NR; ++i) {
        const f32x2 h0 = (f32x2){bflo(raw[i]), bfhi(raw[i])}, h1 = (f32x2){bflo(raw[i + 1]), bfhi(raw[i + 1])}, h2 = (f32x2){bflo(raw[i + 2]), bfhi(raw[i + 2])}, cur = (f32x2){bflo(raw[i + 3]), bfhi(raw[i + 3])};
        const f32x2 s = w[0] * h0 + w[1] * h1 + w[2] * h2 + w[3] * cur + bias;
        y[i] = (f32x2){silu_f(s.x), silu_f(s.y)};
    }
}

__device__ __forceinline__ void ssd_s1_unit(int l, int unit, unsigned char* lds, int tid) { ENTER();
    const int g = unit & 1, c = (unit >> 1) & 15, b = unit >> 5, tok0 = b * SEQ + c * 128, q4 = lane >> 4, l15 = lane & 15;
    constexpr int PB = 136;
    const bf16* PROJ = WSP(bf16, WS_PROJ);
    bf16* Bs = (bf16*)lds; bf16* Cs = (bf16*)(lds + 34816); bf16* BT = (bf16*)(lds + 69632);
    float* dts = (float*)(lds + 104448); float* acs = dts + 1024; float* wds = acs + 1024; float* rds = wds + 1024;
    const float* cw = a.in[I_SCW] + (size_t)l * 4 * 1536; const float* cb = a.in[I_SCB] + (size_t)l * 1536;
    {
        const int h = 8 * g + wave; const float dtb = a.in[I_SDTB][l * 16 + h], A = -__expf(a.in[I_SALOG][l * 16 + h]);
        const float r0 = bf2f(PROJ[(size_t)(tok0 + 2 * lane) * INWP + O_DT + h]), r1 = bf2f(PROJ[(size_t)(tok0 + 2 * lane + 1) * INWP + O_DT + h]);
        const float d0 = softplus_f(r0 + dtb), d1 = softplus_f(r1 + dtb), a0 = d0 * A, a1 = d1 * A;
        const float incl = wave_scan_incl(a0 + a1, lane), last = __shfl(incl, 63), ac0 = incl - a1, ac1 = incl;
        const int o = wave * 128 + 2 * lane;
        dts[o] = d0; dts[o + 1] = d1; acs[o] = ac0; acs[o + 1] = ac1; wds[o] = __expf(last - ac0); wds[o + 1] = __expf(last - ac1); rds[o] = 1.f / d0; rds[o + 1] = 1.f / d1;
        float* ACUM = WSP(float, WS_ACUM); ACUM[(size_t)(tok0 + 2 * lane) * 16 + h] = ac0; ACUM[(size_t)(tok0 + 2 * lane + 1) * 16 + h] = ac1;
    }
    {
        const int cp = 2 * lane, r0 = 16 * wave, chB = 1024 + g * 128 + cp, chC = 1280 + g * 128 + cp;
        unsigned rb[19], rc[19];
        conv_load<16>(PROJ + (size_t)tok0 * INWP + O_XBC + chB, r0, c == 0, rb); conv_load<16>(PROJ + (size_t)tok0 * INWP + O_XBC + chC, r0, c == 0, rc);
        f32x2 y[16];
        conv_apply<16>(rb, cw + chB, cb + chB, y);
#pragma unroll
        for (int i = 0; i < 16; ++i) { const int s = r0 + i; *(unsigned*)(Bs + s * PB + cp) = pk2(y[i].x, y[i].y); BT[cp * PB + s] = f2bf(y[i].x); BT[(cp + 1) * PB + s] = f2bf(y[i].y); }
        conv_apply<16>(rc, cw + chC, cb + chC, y);
        bf16* CC = WSP(bf16, WS_CC);
#pragma unroll
        for (int i = 0; i < 16; ++i) { const int t = r0 + i; const unsigned w = pk2(y[i].x, y[i].y); *(unsigned*)(Cs + t * PB + cp) = w; *(unsigned*)(CC + (size_t)(tok0 + t) * 256 + g * 128 + cp) = w; }
    }
    __syncthreads();
    f32x4 gacc[8];
#pragma unroll
    for (int sb = 0; sb < 8; ++sb) { gacc[sb] = (f32x4){0.f, 0.f, 0.f, 0.f};
        if (sb <= wave) {
#pragma unroll
            for (int ks = 0; ks < 4; ++ks) gacc[sb] = mfma16(frag16(Bs, PB, 16 * sb, 32 * ks, lane), frag16(Cs, PB, 16 * wave, 32 * ks, lane), gacc[sb]); } }
    __syncthreads();
    float* YI = WSP(float, WS_YI); float* HLOC = WSP(float, WS_HLOC);
    bf16* XTb = (bf16*)lds;
    unsigned xraw[11];
    const int xcp = 2 * (tid & 31), xr0 = 8 * (tid >> 5);
    conv_load<8>(PROJ + (size_t)tok0 * INWP + O_XBC + (8 * g) * 64 + xcp, xr0, c == 0, xraw);
    { f32x2 y[8]; const int ch = (8 * g) * 64 + xcp; conv_apply<8>(xraw, cw + ch, cb + ch, y);
      conv_load<8>(PROJ + (size_t)tok0 * INWP + O_XBC + ch + 64, xr0, c == 0, xraw);
#pragma unroll
      for (int i = 0; i < 8; ++i) { const int t = xr0 + i; const float dt = dts[t]; XTb[xcp * PB + t] = f2bf(y[i].x * dt); XTb[(xcp + 1) * PB + t] = f2bf(y[i].y * dt); } }
    __syncthreads();
    for (int hh = 0; hh < 8; ++hh) {
        const int h = 8 * g + hh; const float Dh = a.in[I_SD][l * 16 + h];
        const bf16* XT = XTb + (hh & 1) * (64 * PB);
        const int t = 16 * wave + l15; const float at = acs[hh * 128 + t], rd = rds[hh * 128 + t];
        bf16x8 scf[4];
#pragma unroll
        for (int ks = 0; ks < 4; ++ks) { f32x4 v0, v1;
#pragma unroll
            for (int r = 0; r < 4; ++r) { const int s0 = 32 * ks + 4 * q4 + r, s1 = s0 + 16;
                v0[r] = (2 * ks <= wave && s0 <= t) ? gacc[2 * ks][r] * __expf(fminf(at - acs[hh * 128 + s0], 0.f)) : 0.f;
                v1[r] = (2 * ks + 1 <= wave && s1 <= t) ? gacc[2 * ks + 1][r] * __expf(fminf(at - acs[hh * 128 + s1], 0.f)) : 0.f; }
            scf[ks] = accpair(v0, v1); }
#pragma unroll
        for (int pb = 0; pb < 4; ++pb) { f32x4 acc = (f32x4){0.f, 0.f, 0.f, 0.f};
#pragma unroll
            for (int ks = 0; ks < 4; ++ks) if (2 * ks <= wave) acc = mfma16(frag16p(XT, PB, 16 * pb, 32 * ks, lane), scf[ks], acc);
            const int p0 = 16 * pb + 4 * q4; f32x4 o;
#pragma unroll
            for (int r = 0; r < 4; ++r) o[r] = acc[r] + Dh * bf2f(XT[(p0 + r) * PB + t]) * rd;
            *(f32x4*)(YI + (size_t)(tok0 + t) * 1024 + h * 64 + p0) = o; }
        {
            float* hl = HLOC + (size_t)((b * 16 + c) * 16 + h) * 8192;
            bf16x8 bw[4];
#pragma unroll
            for (int ks = 0; ks < 4; ++ks) { const u32x4 w = __builtin_bit_cast(u32x4, frag16(BT, PB, 16 * wave, 32 * ks, lane));
                const f32x4 d0 = *(const f32x4*)(wds + hh * 128 + 32 * ks + 8 * q4), d1 = *(const f32x4*)(wds + hh * 128 + 32 * ks + 8 * q4 + 4);
                u32x4 o; o.x = pk2(bflo(w.x) * d0.x, bfhi(w.x) * d0.y); o.y = pk2(bflo(w.y) * d0.z, bfhi(w.y) * d0.w); o.z = pk2(bflo(w.z) * d1.x, bfhi(w.z) * d1.y); o.w = pk2(bflo(w.w) * d1.z, bfhi(w.w) * d1.w);
                bw[ks] = __builtin_bit_cast(bf16x8, o); }
#pragma unroll
            for (int pb = 0; pb < 4; ++pb) { f32x4 acc = (f32x4){0.f, 0.f, 0.f, 0.f};
#pragma unroll
                for (int ks = 0; ks < 4; ++ks) acc = mfma16(bw[ks], frag16(XT, PB, 16 * pb, 32 * ks, lane), acc);
                *(f32x4*)(hl + (16 * pb + l15) * 128 + 16 * wave + 4 * q4) = acc; }
        }
        if (hh < 7) {
            f32x2 y[8]; const int ch = (h + 1) * 64 + xcp; conv_apply<8>(xraw, cw + ch, cb + ch, y);
            if (hh < 6) conv_load<8>(PROJ + (size_t)tok0 * INWP + O_XBC + ch + 64, xr0, c == 0, xraw);
            bf16* XN = XTb + ((hh + 1) & 1) * (64 * PB);
#pragma unroll
            for (int i = 0; i < 8; ++i) { const int tt = xr0 + i; const float dt = dts[(hh + 1) * 128 + tt]; XN[xcp * PB + tt] = f2bf(y[i].x * dt); XN[(xcp + 1) * PB + tt] = f2bf(y[i].y * dt); }
        }
        __syncthreads();
    }
}

__device__ __forceinline__ void ssd_sample_unit(int l, int unit, unsigned char* lds, int tid) { ENTER();
    const int g = unit & 1, b = unit >> 1, m0 = NP + 4 * b;
    const bf16* PROJ = WSP(bf16, WS_PROJ);
    float* xs = (float*)lds; float* Bv = xs + 2048; float* Cv = Bv + 512; float* ygs = Cv + 512; float* cbm = ygs + 2048; float* dtv = cbm + 16; float* acv = dtv + 32; float* yst = acv + 32;
    for (int idx = tid; idx < 768; idx += NTHR) {
        int ch; float* dst; int ds;
        if (idx < 512) { ch = g * 512 + idx; dst = xs + idx; ds = 512; } else if (idx < 640) { ch = 1024 + g * 128 + (idx - 512); dst = Bv + (idx - 512); ds = 128; } else { ch = 1280 + g * 128 + (idx - 640); dst = Cv + (idx - 640); ds = 128; }
        float xp[7];
#pragma unroll
        for (int j = 0; j < 3; ++j) xp[j] = a.in[I_SSC][((size_t)(l * NSB + b) * 3 + j) * 1536 + ch];
#pragma unroll
        for (int t = 0; t < 4; ++t) xp[3 + t] = bf2f(PROJ[(size_t)(m0 + t) * INWP + O_XBC + ch]);
        const float bias = a.in[I_SCB][l * 1536 + ch]; float w[4];
#pragma unroll
        for (int j = 0; j < 4; ++j) w[j] = a.in[I_SCW][(size_t)(l * 4 + j) * 1536 + ch];
#pragma unroll
        for (int t = 0; t < 4; ++t) dst[t * ds] = silu_f(w[0] * xp[t] + w[1] * xp[t + 1] + w[2] * xp[t + 2] + w[3] * xp[t + 3] + bias);
    }
    if (tid < 32) { const int hh = tid >> 2, t = tid & 3, h = 8 * g + hh; const float dtb = a.in[I_SDTB][l * 16 + h], A = -__expf(a.in[I_SALOG][l * 16 + h]); float ac = 0.f, dt = 0.f;
        for (int j = 0; j < 4; ++j) { const float d = softplus_f(bf2f(PROJ[(size_t)(m0 + j) * INWP + O_DT + h]) + dtb); if (j <= t) { ac += d * A; dt = d; } }
        dtv[hh * 4 + t] = dt; acv[hh * 4 + t] = ac; }
    __syncthreads();
    {
#pragma unroll
        for (int k = 0; k < 2; ++k) { const int pr = 2 * wave + k, t = pr >> 2, s = pr & 3;
            const float v = wave_sum(Cv[t * 128 + lane] * Bv[s * 128 + lane] + Cv[t * 128 + 64 + lane] * Bv[s * 128 + 64 + lane]); if (lane == 0) cbm[pr] = v; }
    }
    __syncthreads();
    for (int hh = 0; hh < 8; ++hh) {
        const int h = 8 * g + hh, p = tid >> 3, n0 = (tid & 7) * 16;
        const float* hin = a.in[I_SSD] + ((size_t)((l * NSB + b) * 16 + h) * 64 + p) * 128 + n0;
        float* hout = a.out + OUT_SSSD + ((size_t)((l * NSB + b) * 16 + h) * 64 + p) * 128 + n0;
        float h0[16];
#pragma unroll
        for (int i = 0; i < 4; ++i) { const f32x4 v = *(const f32x4*)(hin + 4 * i); h0[4 * i] = v.x; h0[4 * i + 1] = v.y; h0[4 * i + 2] = v.z; h0[4 * i + 3] = v.w; }
        const float ac3 = acv[hh * 4 + 3];
#pragma unroll
        for (int t = 0; t < 4; ++t) { float s = 0.f;
#pragma unroll
            for (int i = 0; i < 16; ++i) s += Cv[t * 128 + n0 + i] * h0[i];
            s += __shfl_xor(s, 1); s += __shfl_xor(s, 2); s += __shfl_xor(s, 4);
            if ((tid & 7) == 0) yst[t * 64 + p] = s; }
        float hn[16]; const float e3 = __expf(ac3);
#pragma unroll
        for (int i = 0; i < 16; ++i) hn[i] = e3 * h0[i];
#pragma unroll
        for (int s = 0; s < 4; ++s) { const float cf = __expf(ac3 - acv[hh * 4 + s]) * dtv[hh * 4 + s] * xs[s * 512 + hh * 64 + p];
#pragma unroll
            for (int i = 0; i < 16; ++i) hn[i] += cf * Bv[s * 128 + n0 + i]; }
#pragma unroll
        for (int i = 0; i < 4; ++i) *(f32x4*)(hout + 4 * i) = (f32x4){hn[4 * i], hn[4 * i + 1], hn[4 * i + 2], hn[4 * i + 3]};
        __syncthreads();
        if (tid < 256) { const int t = tid >> 6, pp = tid & 63; const float at = acv[hh * 4 + t]; float y = __expf(at) * yst[t * 64 + pp] + a.in[I_SD][l * 16 + h] * xs[t * 512 + hh * 64 + pp];
            for (int s = 0; s <= t; ++s) y += cbm[t * 4 + s] * __expf(at - acv[hh * 4 + s]) * dtv[hh * 4 + s] * xs[s * 512 + hh * 64 + pp];
            const float z = bf2f(PROJ[(size_t)(m0 + t) * INWP + O_SSDZ + h * 64 + pp]);
            ygs[t * 512 + hh * 64 + pp] = y * silu_f(z); }
        __syncthreads();
    }
    if (wave < 4) { const int t = wave; float ss = 0.f;
#pragma unroll
        for (int j = 0; j < 8; ++j) { const float v = ygs[t * 512 + lane + 64 * j]; ss += v * v; }
        const float rs = 1.f / sqrtf(wave_sum(ss) * (1.f / 512.f) + RMS_EPS);
        bf16* mx = WSP(bf16, WS_MIX) + (size_t)(m0 + t) * MIXW + g * 512;
#pragma unroll
        for (int j = 0; j < 8; ++j) { const int cidx = lane + 64 * j; mx[cidx] = f2bf(ygs[t * 512 + cidx] * rs * a.in[I_SNW][l * 1024 + g * 512 + cidx]); } }
}

__device__ __forceinline__ void gdn_sample_unit(int l, int unit, unsigned char* lds, int tid) { ENTER();
    const int h = unit & 3, b = unit >> 2, m0 = NP + 4 * b;
    const bf16* PROJ = WSP(bf16, WS_PROJ);
    float* qv = (float*)lds; float* kv = qv + 512; float* vv = kv + 512; float* pa = vv + 512; float* pb = pa + 512; float* ot = pb + 512; float* bet = ot + 512; float* gex = bet + 4;
    if (tid < 384) { const int which = tid >> 7, d = tid & 127, ch = which * 512 + h * 128 + d; float xp[7];
#pragma unroll
        for (int j = 0; j < 3; ++j) xp[j] = a.in[I_SGC][((size_t)(l * NSB + b) * 3 + j) * 1536 + ch];
#pragma unroll
        for (int t = 0; t < 4; ++t) xp[3 + t] = bf2f(PROJ[(size_t)(m0 + t) * INWP + O_GQKV + ch]);
        float w[4];
#pragma unroll
        for (int j = 0; j < 4; ++j) w[j] = a.in[I_GCW][(size_t)(l * 4 + j) * 1536 + ch];
        float* dst = qv + which * 512 + d;
#pragma unroll
        for (int t = 0; t < 4; ++t) dst[t * 128] = silu_f(w[0] * xp[t] + w[1] * xp[t + 1] + w[2] * xp[t + 2] + w[3] * xp[t + 3]);
    } else if (tid < 392) { const int t = (tid - 384) & 3;
        if (tid < 388) bet[t] = sigmoid_f(bf2f(PROJ[(size_t)(m0 + t) * INWP + O_GB + h]));
        else gex[t] = __expf(-__expf(a.in[I_GALOG][l * 4 + h]) * softplus_f(bf2f(PROJ[(size_t)(m0 + t) * INWP + O_GA + h]) + a.in[I_GDTB][l * 4 + h])); }
    __syncthreads();
    { const int t = wave >> 1, which = wave & 1; float* arr = (which ? kv : qv) + t * 128; const float v0 = arr[lane], v1 = arr[64 + lane];
      const float sc = (1.f / sqrtf(wave_sum(v0 * v0 + v1 * v1) + L2_EPS)) * (which ? 1.f : 0.08838834764831845f); arr[lane] = v0 * sc; arr[64 + lane] = v1 * sc; }
    __syncthreads();
    const int e = tid & 127, dq = tid >> 7;
    const float* sin_ = a.in[I_SGDN] + ((size_t)((l * NSB + b) * 4 + h) * 128 + 32 * dq) * 128 + e;
    float S[32];
#pragma unroll
    for (int i = 0; i < 32; ++i) S[i] = sin_[(size_t)i * 128];
    for (int t = 0; t < 4; ++t) {
        float ks = 0.f;
#pragma unroll
        for (int i = 0; i < 32; ++i) ks += kv[t * 128 + 32 * dq + i] * S[i];
        pa[dq * 128 + e] = ks; __syncthreads();
        const float kS = (pa[e] + pa[128 + e]) + (pa[256 + e] + pa[384 + e]);
        const float bt = bet[t], ge = gex[t], ve = vv[t * 128 + e]; float os = 0.f;
#pragma unroll
        for (int i = 0; i < 32; ++i) { const float ki = kv[t * 128 + 32 * dq + i]; S[i] = ge * (S[i] - bt * ki * kS) + bt * ki * ve; os += qv[t * 128 + 32 * dq + i] * S[i]; }
        pb[dq * 128 + e] = os; __syncthreads();
        if (dq == 0) ot[t * 128 + e] = (pb[e] + pb[128 + e]) + (pb[256 + e] + pb[384 + e]);
    }
    __syncthreads();
    if (wave < 4) { const int t = wave; const float o0 = ot[t * 128 + lane], o1 = ot[t * 128 + 64 + lane];
        const float rs = 1.f / sqrtf(wave_sum(o0 * o0 + o1 * o1) * (1.f / 128.f) + RMS_EPS);
        const bf16* zr = PROJ + (size_t)(m0 + t) * INWP + O_GZ + h * 128; const float* nw = a.in[I_GNW] + l * 128;
        bf16* mx = WSP(bf16, WS_MIX) + (size_t)(m0 + t) * MIXW + 1536 + h * 128;
        mx[lane] = f2bf(o0 * rs * nw[lane] * silu_f(bf2f(zr[lane]))); mx[64 + lane] = f2bf(o1 * rs * nw[64 + lane] * silu_f(bf2f(zr[64 + lane]))); }
    float* so = a.out + OUT_SGDN + ((size_t)((l * NSB + b) * 4 + h) * 128 + 32 * dq) * 128 + e;
#pragma unroll
    for (int i = 0; i < 32; ++i) so[(size_t)i * 128] = S[i];
}

__device__ __forceinline__ void gdn_prep_unit(int l, int u, unsigned char* lds, int tid) { ENTER();
    const int h = u & 3, c = (u >> 2) & 31, b = u >> 7, tok0 = b * SEQ + c * 64, q4 = lane >> 4, l15 = lane & 15;
    const bf16* PROJ = WSP(bf16, WS_PROJ);
    bf16* Ks = (bf16*)lds; bf16* KBs = (bf16*)(lds + 17408); bf16* Qs = (bf16*)(lds + 34816); bf16* VBT = (bf16*)(lds + 52224); bf16* KBGT = (bf16*)(lds + 70656); bf16* KDTs = (bf16*)(lds + 89088);
    float* Am = (float*)(lds + 107520); bf16* Ts = (bf16*)(lds + 124928); float* gcs = (float*)(lds + 134144); float* bts = gcs + 64;
    const int cp = 2 * lane, r0 = 8 * wave;
    unsigned rq[11], rk[11], rv[11];
    conv_load<8>(PROJ + (size_t)tok0 * INWP + O_GQKV + h * 128 + cp, r0, c == 0, rq); conv_load<8>(PROJ + (size_t)tok0 * INWP + O_GQKV + 512 + h * 128 + cp, r0, c == 0, rk);
    conv_load<8>(PROJ + (size_t)tok0 * INWP + O_GQKV + 1024 + h * 128 + cp, r0, c == 0, rv);
    if (wave == 0) {
        const float rb = bf2f(PROJ[(size_t)(tok0 + lane) * INWP + O_GB + h]), ra = bf2f(PROJ[(size_t)(tok0 + lane) * INWP + O_GA + h]);
        const float gt = -__expf(a.in[I_GALOG][l * 4 + h]) * softplus_f(ra + a.in[I_GDTB][l * 4 + h]);
        gcs[lane] = wave_scan_incl(gt, lane); bts[lane] = sigmoid_f(rb);
    }
    __syncthreads();
    {
        const float* cw = a.in[I_GCW] + (size_t)l * 4 * 1536; const float glast = gcs[63];
        f32x2 q[8], k[8], v[8];
        conv_apply<8>(rq, cw + h * 128 + cp, nullptr, q); conv_apply<8>(rk, cw + 512 + h * 128 + cp, nullptr, k); conv_apply<8>(rv, cw + 1024 + h * 128 + cp, nullptr, v);
        bf16* QG = WSP(bf16, WS_GQG) + (size_t)u * 8192;
#pragma unroll
        for (int i = 0; i < 8; ++i) { const int t = r0 + i;
            const float sq = 0.08838834764831845f / sqrtf(wave_sum(q[i].x * q[i].x + q[i].y * q[i].y) + L2_EPS), sk = 1.f / sqrtf(wave_sum(k[i].x * k[i].x + k[i].y * k[i].y) + L2_EPS);
            const float q0 = q[i].x * sq, q1 = q[i].y * sq, k0 = k[i].x * sk, k1 = k[i].y * sk, bt = bts[t], gc = gcs[t], eg = __expf(gc), ed = __expf(glast - gc);
            *(unsigned*)(Ks + t * 136 + cp) = pk2(k0, k1); *(unsigned*)(KBs + t * 136 + cp) = pk2(k0 * bt, k1 * bt); *(unsigned*)(Qs + t * 136 + cp) = pk2(q0, q1);
            VBT[cp * 72 + t] = f2bf(v[i].x * bt); VBT[(cp + 1) * 72 + t] = f2bf(v[i].y * bt);
            KBGT[cp * 72 + t] = f2bf(k0 * bt * eg); KBGT[(cp + 1) * 72 + t] = f2bf(k1 * bt * eg);
            KDTs[cp * 72 + t] = f2bf(k0 * ed); KDTs[(cp + 1) * 72 + t] = f2bf(k1 * ed);
            *(unsigned*)(QG + t * 128 + cp) = pk2(q0 * eg, q1 * eg); }
    }
    __syncthreads();
    bf16* ATT = WSP(bf16, WS_GATT) + (size_t)u * 4096;
    for (int item = wave; item < 26; item += 8) {
        if (item < 10) {
            const int tb = item >= 6 ? 3 : item >= 3 ? 2 : item >= 1 ? 1 : 0, sb = item - tb * (tb + 1) / 2;
            f32x4 acc = (f32x4){0.f, 0.f, 0.f, 0.f};
#pragma unroll
            for (int ks = 0; ks < 4; ++ks) acc = mfma16(frag16(KBs, 136, 16 * tb, 32 * ks, lane), frag16(Ks, 136, 16 * sb, 32 * ks, lane), acc);
            const int s = 16 * sb + l15; const float gs = gcs[s];
#pragma unroll
            for (int r = 0; r < 4; ++r) { const int t = 16 * tb + 4 * q4 + r; Am[t * 68 + s] = (s < t) ? acc[r] * __expf(fminf(gcs[t] - gs, 0.f)) : 0.f; }
        } else {
            const int j = item - 10, tb = j >> 2, sb = j & 3; f32x4 acc = (f32x4){0.f, 0.f, 0.f, 0.f};
            if (sb <= tb) {
#pragma unroll
                for (int ks = 0; ks < 4; ++ks) acc = mfma16(frag16(Ks, 136, 16 * sb, 32 * ks, lane), frag16(Qs, 136, 16 * tb, 32 * ks, lane), acc); }
            const int t = 16 * tb + l15, s0 = 16 * sb + 4 * q4; const float gt = gcs[t]; float vv[4];
#pragma unroll
            for (int r = 0; r < 4; ++r) vv[r] = (sb <= tb && s0 + r <= t) ? acc[r] * __expf(fminf(gt - gcs[s0 + r], 0.f)) : 0.f;
            u32x2 w; w.x = pk2(vv[0], vv[1]); w.y = pk2(vv[2], vv[3]); *(u32x2*)(ATT + t * 64 + s0) = w;
        }
    }
    __syncthreads();
#ifndef NOINV
    if (wave == 0) {
        float x[64]; int zo = 0; asm volatile("" : "+v"(zo)); const float* Amz = Am + zo;
#pragma unroll
        for (int i = 0; i < 64; ++i) { f32x4 a4 = (f32x4){fmaxf(0.f, 1.f - fabsf((float)(i - lane))), 0.f, 0.f, 0.f};
#pragma unroll
            for (int jj = 0; jj < (i + 3) / 4; ++jj) { const f32x4 av = *(const f32x4*)(Amz + i * 68 + 4 * jj);
#pragma unroll
                for (int e = 0; e < 4; ++e) if (4 * jj + e < i) a4[e] -= av[e] * x[4 * jj + e]; }
            const float acc = (a4[0] + a4[1]) + (a4[2] + a4[3]);
            x[i] = acc; Ts[i * 72 + lane] = f2bf(acc); }
    }
#endif
    __syncthreads();
    {
        float* U = WSP(float, WS_GU) + (size_t)u * 8192; bf16* NW = WSP(bf16, WS_GNW) + (size_t)u * 8192;
#pragma unroll
        for (int tb = 0; tb < 4; ++tb) { f32x4 au = (f32x4){0.f, 0.f, 0.f, 0.f}, aw = au;
#pragma unroll
            for (int ks = 0; ks < 2; ++ks) { const bf16x8 bf = frag16(Ts, 72, 16 * tb, 32 * ks, lane); au = mfma16(frag16(VBT, 72, 16 * wave, 32 * ks, lane), bf, au); aw = mfma16(frag16(KBGT, 72, 16 * wave, 32 * ks, lane), bf, aw); }
            const int t = 16 * tb + l15, e0 = 16 * wave + 4 * q4;
            *(f32x4*)(U + t * 128 + e0) = au; u32x2 w; w.x = pk2(-aw[0], -aw[1]); w.y = pk2(-aw[2], -aw[3]); *(u32x2*)(NW + t * 128 + e0) = w; }
        bf16* KDT = WSP(bf16, WS_GKDT) + (size_t)u * 8192;
#pragma unroll
        for (int i = 0; i < 2; ++i) { const int id = tid + 512 * i, d = id >> 3, cc = id & 7; *(u32x4*)(KDT + d * 64 + 8 * cc) = *(const u32x4*)(KDTs + d * 72 + 8 * cc); }
        if (tid == 0) WSP(float, WS_GEG)[u] = __expf(gcs[63]);
    }
}

struct GdnPre { u32x4 nw[2], qg[2], kd[2], at; float u[16]; unsigned z[8]; float eg; };
__device__ __forceinline__ void gdn_load_a(unsigned char* ws, int b, int h, int c, int tid, GdnPre& p) {
    const int u = (b * 32 + c) * 4 + h;
    const bf16* NW = WSP(bf16, WS_GNW) + (size_t)u * 8192; const bf16* QG = WSP(bf16, WS_GQG) + (size_t)u * 8192; const bf16* KDT = WSP(bf16, WS_GKDT) + (size_t)u * 8192; const bf16* ATT = WSP(bf16, WS_GATT) + (size_t)u * 4096;
#pragma unroll
    for (int i = 0; i < 2; ++i) { const int id = tid + 512 * i, row = id >> 4, cc = id & 15, d = id >> 3, c8 = id & 7;
        p.nw[i] = *(const u32x4*)(NW + row * 128 + 8 * cc); p.qg[i] = *(const u32x4*)(QG + row * 128 + 8 * cc); p.kd[i] = *(const u32x4*)(KDT + d * 64 + 8 * c8); }
    p.at = *(const u32x4*)(ATT + (tid >> 3) * 64 + 8 * (tid & 7));
    p.eg = WSP(float, WS_GEG)[u];
}
__device__ __forceinline__ void gdn_load_u(unsigned char* ws, int b, int h, int c, int lane, int wave, GdnPre& p) {
    const int u = (b * 32 + c) * 4 + h, q4 = lane >> 4, l15 = lane & 15, e0 = 16 * wave; const float* U = WSP(float, WS_GU) + (size_t)u * 8192;
#pragma unroll
    for (int tb = 0; tb < 4; ++tb)
#pragma unroll
        for (int r = 0; r < 4; ++r) p.u[4 * tb + r] = U[(16 * tb + 4 * q4 + r) * 128 + e0 + l15];
}
__device__ __forceinline__ void gdn_load_z(unsigned char* ws, int b, int h, int c, int lane, int wave, GdnPre& p) {
    const int tok0 = b * SEQ + c * 64; const bf16* PROJ = WSP(bf16, WS_PROJ);
#pragma unroll
    for (int i = 0; i < 8; ++i) p.z[i] = *(const unsigned*)(PROJ + (size_t)(tok0 + 8 * wave + i) * INWP + O_GZ + h * 128 + 2 * lane);
}
__device__ __forceinline__ void gdn_chain_unit(int l, int unit, unsigned char* lds, int tid) { ENTER();
    const int h = unit & 3, b = unit >> 2, q4 = lane >> 4, l15 = lane & 15, e0 = 16 * wave;
    bf16* NWs = (bf16*)lds; bf16* QGs = (bf16*)(lds + 17408); bf16* KDs = (bf16*)(lds + 34816); bf16* ATs = (bf16*)(lds + 53248); float* Os = (float*)(lds + 62464);
    f32x4 sacc[8];
#pragma unroll
    for (int i = 0; i < 8; ++i) sacc[i] = (f32x4){0.f, 0.f, 0.f, 0.f};
    const float nw0 = a.in[I_GNW][l * 128 + 2 * lane], nw1 = a.in[I_GNW][l * 128 + 2 * lane + 1];
    GdnPre p; gdn_load_a(ws, b, h, 0, tid, p); gdn_load_u(ws, b, h, 0, lane, wave, p); gdn_load_z(ws, b, h, 0, lane, wave, p);
#define SB() __builtin_amdgcn_sched_barrier(0)
    for (int c = 0; c < 32; ++c) {
        const int tok0 = b * SEQ + c * 64;
        asm volatile("s_waitcnt vmcnt(0)" ::: "memory");
#pragma unroll
        for (int i = 0; i < 2; ++i) { const int id = tid + 512 * i, row = id >> 4, cc = id & 15, d = id >> 3, c8 = id & 7;
            *(u32x4*)(NWs + row * 136 + 8 * cc) = p.nw[i]; *(u32x4*)(QGs + row * 136 + 8 * cc) = p.qg[i]; *(u32x4*)(KDs + d * 72 + 8 * c8) = p.kd[i]; }
        *(u32x4*)(ATs + (tid >> 3) * 72 + 8 * (tid & 7)) = p.at;
        float eg = p.eg; asm volatile("" : "+v"(eg));
#pragma unroll
        for (int i = 0; i < 16; ++i) asm volatile("" : "+v"(p.u[i]));
#pragma unroll
        for (int i = 0; i < 8; ++i) asm volatile("" : "+v"(p.z[i]));
        asm volatile("" ::: "memory");
        if (c + 1 < 32) gdn_load_a(ws, b, h, c + 1, tid, p);
        __syncthreads();
        bf16x8 sf[4];
#pragma unroll
        for (int ks = 0; ks < 4; ++ks) sf[ks] = accpair(sacc[2 * ks], sacc[2 * ks + 1]);
        f32x4 vn[4];
        {
            bf16x8 fa[4], fb[4];
#pragma unroll
            for (int ks = 0; ks < 4; ++ks) fa[ks] = frag16p(NWs, 136, 0, 32 * ks, lane);
#pragma unroll
            for (int tb = 0; tb < 4; ++tb) {
                if (tb + 1 < 4) {
#pragma unroll
                    for (int ks = 0; ks < 4; ++ks) fb[ks] = frag16p(NWs, 136, 16 * (tb + 1), 32 * ks, lane); }
                SB();
                f32x4 acc = (f32x4){p.u[4 * tb], p.u[4 * tb + 1], p.u[4 * tb + 2], p.u[4 * tb + 3]};
#pragma unroll
                for (int ks = 0; ks < 4; ++ks) acc = mfma16(fa[ks], sf[ks], acc);
                vn[tb] = acc; SB();
#pragma unroll
                for (int ks = 0; ks < 4; ++ks) fa[ks] = fb[ks]; }
        }
        const bf16x8 vf0 = accpair(vn[0], vn[1]), vf1 = accpair(vn[2], vn[3]);
        asm volatile("" ::: "memory"); if (c + 1 < 32) gdn_load_u(ws, b, h, c + 1, lane, wave, p);
        {
            bf16x8 fa[6], fb[6];
#pragma unroll
            for (int ks = 0; ks < 4; ++ks) fa[ks] = frag16p(QGs, 136, 0, 32 * ks, lane);
            fa[4] = frag16p(ATs, 72, 0, 0, lane); fa[5] = frag16p(ATs, 72, 0, 32, lane);
#pragma unroll
            for (int tb = 0; tb < 4; ++tb) {
                if (tb + 1 < 4) {
#pragma unroll
                    for (int ks = 0; ks < 4; ++ks) fb[ks] = frag16p(QGs, 136, 16 * (tb + 1), 32 * ks, lane);
                    fb[4] = frag16p(ATs, 72, 16 * (tb + 1), 0, lane); fb[5] = frag16p(ATs, 72, 16 * (tb + 1), 32, lane); }
                SB();
                f32x4 acc = (f32x4){0.f, 0.f, 0.f, 0.f};
#pragma unroll
                for (int ks = 0; ks < 4; ++ks) acc = mfma16(fa[ks], sf[ks], acc);
                acc = mfma16(fa[4], vf0, acc); acc = mfma16(fa[5], vf1, acc);
#pragma unroll
                for (int r = 0; r < 4; ++r) Os[(16 * tb + 4 * q4 + r) * 132 + e0 + l15] = acc[r];
                SB();
#pragma unroll
                for (int ks = 0; ks < 6; ++ks) fa[ks] = fb[ks]; }
        }
        {
            bf16x8 fa[4], fb[4];
            fa[0] = frag16p(KDs, 72, 0, 0, lane); fa[1] = frag16p(KDs, 72, 0, 32, lane); fa[2] = frag16p(KDs, 72, 16, 0, lane); fa[3] = frag16p(KDs, 72, 16, 32, lane);
#pragma unroll
            for (int dp = 0; dp < 4; ++dp) {
                if (dp + 1 < 4) { fb[0] = frag16p(KDs, 72, 32 * (dp + 1), 0, lane); fb[1] = frag16p(KDs, 72, 32 * (dp + 1), 32, lane); fb[2] = frag16p(KDs, 72, 32 * (dp + 1) + 16, 0, lane); fb[3] = frag16p(KDs, 72, 32 * (dp + 1) + 16, 32, lane); }
                SB();
                f32x4 a0 = sacc[2 * dp] * eg, a1 = sacc[2 * dp + 1] * eg;
                a0 = mfma16(fa[0], vf0, a0); a1 = mfma16(fa[2], vf0, a1); a0 = mfma16(fa[1], vf1, a0); a1 = mfma16(fa[3], vf1, a1);
                sacc[2 * dp] = a0; sacc[2 * dp + 1] = a1; SB();
#pragma unroll
                for (int ks = 0; ks < 4; ++ks) fa[ks] = fb[ks]; }
        }
        __syncthreads();
#pragma unroll
        for (int i = 0; i < 8; ++i) { const int t = 8 * wave + i; const f32x2 o = *(const f32x2*)(Os + t * 132 + 2 * lane);
            const float rs = __builtin_amdgcn_rsqf(wave_sum(o.x * o.x + o.y * o.y) * (1.f / 128.f) + RMS_EPS); const unsigned z = p.z[i];
            *(unsigned*)(WSP(bf16, WS_MIX) + (size_t)(tok0 + t) * MIXW + 1536 + h * 128 + 2 * lane) = pk2(o.x * rs * nw0 * silu_f(bflo(z)), o.y * rs * nw1 * silu_f(bfhi(z))); }
        asm volatile("" ::: "memory"); if (c + 1 < 32) gdn_load_z(ws, b, h, c + 1, lane, wave, p);
        __syncthreads();
    }
#undef SB
    float* so = a.out + OUT_PGDN + (size_t)((l * NPB + b) * 4 + h) * 16384;
#pragma unroll
    for (int db = 0; db < 8; ++db)
#pragma unroll
        for (int r = 0; r < 4; ++r) so[(16 * db + 4 * q4 + r) * 128 + e0 + l15] = sacc[db][r];
}

struct SsdPre { u32x4 cs[4]; f32x4 hl[4]; f32x4 yi[4]; u32x2 z[4]; float ac, dl; };
__device__ __forceinline__ void ssd_load(unsigned char* ws, int b, int h, int c, int tid, int lane, int wave, SsdPre& p) {
    const int g = h >> 3, tok0 = b * SEQ + c * 128, q4 = lane >> 4, l15 = lane & 15, hp = tid >> 3, hn0 = (tid & 7) * 16, tok = tok0 + 16 * wave + l15;
    const bf16* CC = WSP(bf16, WS_CC); const float* ACUM = WSP(float, WS_ACUM); const float* YI = WSP(float, WS_YI); const bf16* PROJ = WSP(bf16, WS_PROJ);
    const float* hl = WSP(float, WS_HLOC) + (size_t)((b * 16 + c) * 16 + h) * 8192 + hp * 128 + hn0;
#pragma unroll
    for (int i = 0; i < 4; ++i) { const int id = tid + 512 * i, row = id >> 4, cc = id & 15; p.cs[i] = *(const u32x4*)(CC + (size_t)(tok0 + row) * 256 + g * 128 + 8 * cc); p.hl[i] = *(const f32x4*)(hl + 4 * i); }
    p.ac = ACUM[(size_t)tok * 16 + h]; p.dl = ACUM[(size_t)(tok0 + 127) * 16 + h];
#pragma unroll
    for (int pb = 0; pb < 4; ++pb) { const int p0 = 16 * pb + 4 * q4; p.yi[pb] = *(const f32x4*)(YI + (size_t)tok * 1024 + h * 64 + p0); p.z[pb] = *(const u32x2*)(PROJ + (size_t)tok * INWP + O_SSDZ + h * 64 + p0); }
}
__device__ __forceinline__ void ssd_chain_unit(int l, int unit, unsigned char* lds, int tid) { ENTER();
    const int h = unit & 15, b = unit >> 4, q4 = lane >> 4, l15 = lane & 15;
    bf16* YG = WSP(bf16, WS_YG); float* SSQ = WSP(float, WS_SSQ);
    bf16* Hs = (bf16*)lds; bf16* Cs = (bf16*)(lds + 17408);
    const int hp = tid >> 3, hn0 = (tid & 7) * 16;
    float H[16];
#pragma unroll
    for (int i = 0; i < 16; ++i) H[i] = 0.f;
    SsdPre p; ssd_load(ws, b, h, 0, tid, lane, wave, p);
    for (int c = 0; c < 16; ++c) {
        const int tok0 = b * SEQ + c * 128;
        { u32x4 w0, w1; w0.x = pk2(H[0], H[1]); w0.y = pk2(H[2], H[3]); w0.z = pk2(H[4], H[5]); w0.w = pk2(H[6], H[7]); w1.x = pk2(H[8], H[9]); w1.y = pk2(H[10], H[11]); w1.z = pk2(H[12], H[13]); w1.w = pk2(H[14], H[15]);
          *(u32x4*)(Hs + hp * 136 + hn0) = w0; *(u32x4*)(Hs + hp * 136 + hn0 + 8) = w1; }
#pragma unroll
        for (int i = 0; i < 4; ++i) { const int id = tid + 512 * i, row = id >> 4, cc = id & 15; *(u32x4*)(Cs + row * 136 + 8 * cc) = p.cs[i]; }
        f32x4 chl[4], cyi[4]; u32x2 cz[4]; const float ea = __expf(p.ac), dl = __expf(p.dl);
#pragma unroll
        for (int i = 0; i < 4; ++i) { chl[i] = p.hl[i]; cyi[i] = p.yi[i]; cz[i] = p.z[i]; }
        if (c + 1 < 16) ssd_load(ws, b, h, c + 1, tid, lane, wave, p);
        __syncthreads();
        {
            const int tok = tok0 + 16 * wave + l15; float ssq = 0.f;
#pragma unroll
            for (int pb = 0; pb < 4; ++pb) { f32x4 acc = (f32x4){0.f, 0.f, 0.f, 0.f};
#pragma unroll
                for (int ks = 0; ks < 4; ++ks) acc = mfma16(frag16(Hs, 136, 16 * pb, 32 * ks, lane), frag16(Cs, 136, 16 * wave, 32 * ks, lane), acc);
                const int p0 = 16 * pb + 4 * q4; const f32x4 yi = cyi[pb]; const u32x2 z = cz[pb];
                const float y0 = (yi.x + ea * acc[0]) * silu_f(bflo(z.x)), y1 = (yi.y + ea * acc[1]) * silu_f(bfhi(z.x)), y2 = (yi.z + ea * acc[2]) * silu_f(bflo(z.y)), y3 = (yi.w + ea * acc[3]) * silu_f(bfhi(z.y));
                ssq += (y0 * y0 + y1 * y1) + (y2 * y2 + y3 * y3);
                u32x2 w; w.x = pk2(y0, y1); w.y = pk2(y2, y3); *(u32x2*)(YG + (size_t)tok * 1024 + h * 64 + p0) = w; }
            ssq = row16_sum(ssq); ssq = half_sum(ssq);
            if (q4 == 0) SSQ[(size_t)tok * 16 + h] = ssq;
        }
#pragma unroll
        for (int i = 0; i < 4; ++i) { const f32x4 v = chl[i]; H[4 * i] = dl * H[4 * i] + v.x; H[4 * i + 1] = dl * H[4 * i + 1] + v.y; H[4 * i + 2] = dl * H[4 * i + 2] + v.z; H[4 * i + 3] = dl * H[4 * i + 3] + v.w; }
        __syncthreads();
    }
    float* ho = a.out + OUT_PSSD + (size_t)((l * NPB + b) * 16 + h) * 8192 + hp * 128 + hn0;
#pragma unroll
    for (int i = 0; i < 4; ++i) *(f32x4*)(ho + 4 * i) = (f32x4){H[4 * i], H[4 * i + 1], H[4 * i + 2], H[4 * i + 3]};
}

__device__ __forceinline__ void ssd_final_unit(int l, int unit, int tid) { ENTER();
    const bf16* YG = WSP(bf16, WS_YG); const float* SSQ = WSP(float, WS_SSQ); bf16* MIX = WSP(bf16, WS_MIX);
    const int m0 = unit * 32 + wave * 4;
    u32x4 w[4][2]; f32x4 sq[4][4];
#pragma unroll
    for (int i = 0; i < 4; ++i) {
#pragma unroll
        for (int g = 0; g < 2; ++g) w[i][g] = *(const u32x4*)(YG + (size_t)(m0 + i) * 1024 + g * 512 + 8 * lane);
#pragma unroll
        for (int j = 0; j < 4; ++j) sq[i][j] = *(const f32x4*)(SSQ + (size_t)(m0 + i) * 16 + 4 * j); }
    f32x4 n0[2], n1[2];
#pragma unroll
    for (int g = 0; g < 2; ++g) { n0[g] = *(const f32x4*)(a.in[I_SNW] + l * 1024 + g * 512 + 8 * lane); n1[g] = *(const f32x4*)(a.in[I_SNW] + l * 1024 + g * 512 + 8 * lane + 4); }
#pragma unroll
    for (int i = 0; i < 4; ++i)
#pragma unroll
        for (int g = 0; g < 2; ++g) { const f32x4 s0 = sq[i][2 * g], s1 = sq[i][2 * g + 1]; const float ss = ((s0.x + s0.y) + (s0.z + s0.w)) + ((s1.x + s1.y) + (s1.z + s1.w));
            const float rs = __builtin_amdgcn_rsqf(ss * (1.f / 512.f) + RMS_EPS); const u32x4 v = w[i][g];
            u32x4 o; o.x = pk2(bflo(v.x) * rs * n0[g].x, bfhi(v.x) * rs * n0[g].y); o.y = pk2(bflo(v.y) * rs * n0[g].z, bfhi(v.y) * rs * n0[g].w);
            o.z = pk2(bflo(v.z) * rs * n1[g].x, bfhi(v.z) * rs * n1[g].y); o.w = pk2(bflo(v.w) * rs * n1[g].z, bfhi(v.w) * rs * n1[g].w);
            *(u32x4*)(MIX + (size_t)(m0 + i) * MIXW + g * 512 + 8 * lane) = o; }
}

__device__ __forceinline__ void attn_unit(int l, int unit, unsigned char* lds, int tid) { ENTER();
    const int qb = 7 - (unit >> 6), bh = unit & 63, b = bh >> 3, h = bh & 7, r32 = lane & 31, hh = lane >> 5;
    const bf16* Q = WSP(bf16, WS_Q); const bf16* KK = WSP(bf16, WS_KK); const bf16* VT = WSP(bf16, WS_VT); const float* RC = WSP(float, WS_ROPECS);
    bf16* Ks = (bf16*)lds; bf16* VTs = (bf16*)(lds + 13312);
    const int qrow = 256 * qb + 32 * wave + r32, tok = b * SEQ + qrow;
    bf16x8 qf[6];
    {
        const bf16* qp = Q + (size_t)tok * 768 + h * 96 + 8 * hh;
#pragma unroll
        for (int ks = 0; ks < 4; ++ks) { const u32x4 w = *(const u32x4*)(qp + 16 * ks); u32x4 o;
            o.x = pk2(bflo(w.x) * ATT_SC, bfhi(w.x) * ATT_SC); o.y = pk2(bflo(w.y) * ATT_SC, bfhi(w.y) * ATT_SC); o.z = pk2(bflo(w.z) * ATT_SC, bfhi(w.z) * ATT_SC); o.w = pk2(bflo(w.w) * ATT_SC, bfhi(w.w) * ATT_SC);
            qf[ks] = __builtin_bit_cast(bf16x8, o); }
        const u32x4 w1 = *(const u32x4*)(qp + 64), w2 = *(const u32x4*)(qp + 80);
        const f32x4 c0 = *(const f32x4*)(RC + (size_t)tok * 32 + 8 * hh), c1 = *(const f32x4*)(RC + (size_t)tok * 32 + 8 * hh + 4), s0 = *(const f32x4*)(RC + (size_t)tok * 32 + 16 + 8 * hh), s1 = *(const f32x4*)(RC + (size_t)tok * 32 + 16 + 8 * hh + 4);
        float x1[8] = {bflo(w1.x), bfhi(w1.x), bflo(w1.y), bfhi(w1.y), bflo(w1.z), bfhi(w1.z), bflo(w1.w), bfhi(w1.w)};
        float x2[8] = {bflo(w2.x), bfhi(w2.x), bflo(w2.y), bfhi(w2.y), bflo(w2.z), bfhi(w2.z), bflo(w2.w), bfhi(w2.w)};
        float cc[8] = {c0.x, c0.y, c0.z, c0.w, c1.x, c1.y, c1.z, c1.w}, sn[8] = {s0.x, s0.y, s0.z, s0.w, s1.x, s1.y, s1.z, s1.w};
        float o1[8], o2[8];
#pragma unroll
        for (int i = 0; i < 8; ++i) { o1[i] = (x1[i] * cc[i] - x2[i] * sn[i]) * ATT_SC; o2[i] = (x2[i] * cc[i] + x1[i] * sn[i]) * ATT_SC; }
        u32x4 p1, p2; p1.x = pk2(o1[0], o1[1]); p1.y = pk2(o1[2], o1[3]); p1.z = pk2(o1[4], o1[5]); p1.w = pk2(o1[6], o1[7]); p2.x = pk2(o2[0], o2[1]); p2.y = pk2(o2[2], o2[3]); p2.z = pk2(o2[4], o2[5]); p2.w = pk2(o2[6], o2[7]);
        qf[4] = __builtin_bit_cast(bf16x8, p1); qf[5] = __builtin_bit_cast(bf16x8, p2);
    }
    f32x16 o0, o1;
#pragma unroll
    for (int r = 0; r < 16; ++r) { o0[r] = 0.f; o1[r] = 0.f; }
    float m = -1e30f, lsum = 0.f;
    const int KT = 4 * qb + 4;
    const int kr0 = tid / 12, kc0 = tid % 12, kr1 = (tid + 512) / 12, kc1 = (tid + 512) % 12, vr = tid >> 3, vc = tid & 7;
    const bf16* kbase = KK + (size_t)(b * SEQ) * 768 + h * 96; const bf16* vbase = VT + (size_t)(h * 64 + vr) * NP + b * SEQ + 8 * vc;
    u32x4 kreg0 = *(const u32x4*)(kbase + (size_t)kr0 * 768 + 8 * kc0), kreg1 = (u32x4){0u, 0u, 0u, 0u}, vreg = *(const u32x4*)(vbase);
    if (tid < 256) kreg1 = *(const u32x4*)(kbase + (size_t)kr1 * 768 + 8 * kc1);
    *(u32x4*)(Ks + kr0 * 104 + 8 * kc0) = kreg0; if (tid < 256) *(u32x4*)(Ks + kr1 * 104 + 8 * kc1) = kreg1; *(u32x4*)(VTs + vr * 72 + 8 * vc) = vreg;
    if (1 < KT) { kreg0 = *(const u32x4*)(kbase + (size_t)(64 + kr0) * 768 + 8 * kc0); if (tid < 256) kreg1 = *(const u32x4*)(kbase + (size_t)(64 + kr1) * 768 + 8 * kc1); vreg = *(const u32x4*)(vbase + 64); }
    __syncthreads();
    for (int kt = 0; kt < KT; ++kt) {
        const int key0 = 64 * kt; const bf16* Kc = Ks + (kt & 1) * 11264; const bf16* Vc = VTs + (kt & 1) * 11264;
        if (key0 <= 256 * qb + 32 * wave + 31) {
            bf16x8 ka[12];
#pragma unroll
            for (int ks = 0; ks < 6; ++ks) { ka[2 * ks] = *(const bf16x8*)(Kc + r32 * 104 + 16 * ks + 8 * hh); ka[2 * ks + 1] = *(const bf16x8*)(Kc + (32 + r32) * 104 + 16 * ks + 8 * hh); }
            __builtin_amdgcn_sched_barrier(0);
            f32x16 s0, s1;
#pragma unroll
            for (int r = 0; r < 16; ++r) { s0[r] = 0.f; s1[r] = 0.f; }
#pragma unroll
            for (int ks = 0; ks < 6; ++ks) { s0 = mfma32(ka[2 * ks], qf[ks], s0); s1 = mfma32(ka[2 * ks + 1], qf[ks], s1); }
            bf16x4 vl[8], vh[8];
#pragma unroll
            for (int kk = 0; kk < 4; ++kk) { const bf16* vp0 = Vc + r32 * 72 + 16 * kk + 4 * hh; const bf16* vp1 = vp0 + 32 * 72;
                vl[2 * kk] = *(const bf16x4*)vp0; vh[2 * kk] = *(const bf16x4*)(vp0 + 8); vl[2 * kk + 1] = *(const bf16x4*)vp1; vh[2 * kk + 1] = *(const bf16x4*)(vp1 + 8); }
            __builtin_amdgcn_sched_barrier(0);
            if (key0 + 63 > 256 * qb + 32 * wave) {
#pragma unroll
                for (int r = 0; r < 16; ++r) { const int key = key0 + (r & 3) + 8 * (r >> 2) + 4 * hh; if (key > qrow) s0[r] = -1e30f; if (key + 32 > qrow) s1[r] = -1e30f; } }
            float mx = s0[0];
#pragma unroll
            for (int r = 1; r < 16; ++r) mx = fmaxf(mx, s0[r]);
#pragma unroll
            for (int r = 0; r < 16; ++r) mx = fmaxf(mx, s1[r]);
            mx = half_max(mx);
            const float mn = fmaxf(m, mx), alpha = __builtin_amdgcn_exp2f(m - mn); m = mn;
            float ps = 0.f;
#pragma unroll
            for (int r = 0; r < 16; ++r) { s0[r] = __builtin_amdgcn_exp2f(s0[r] - mn); s1[r] = __builtin_amdgcn_exp2f(s1[r] - mn); ps += s0[r] + s1[r]; }
            ps = half_sum(ps); lsum = lsum * alpha + ps;
#pragma unroll
            for (int r = 0; r < 16; ++r) { o0[r] *= alpha; o1[r] *= alpha; }
            bf16x8 pf[4];
#pragma unroll
            for (int s2 = 0; s2 < 2; ++s2) { u32x4 w;
                w.x = pk2(s0[8 * s2], s0[8 * s2 + 1]); w.y = pk2(s0[8 * s2 + 2], s0[8 * s2 + 3]); w.z = pk2(s0[8 * s2 + 4], s0[8 * s2 + 5]); w.w = pk2(s0[8 * s2 + 6], s0[8 * s2 + 7]); pf[s2] = __builtin_bit_cast(bf16x8, w);
                w.x = pk2(s1[8 * s2], s1[8 * s2 + 1]); w.y = pk2(s1[8 * s2 + 2], s1[8 * s2 + 3]); w.z = pk2(s1[8 * s2 + 4], s1[8 * s2 + 5]); w.w = pk2(s1[8 * s2 + 6], s1[8 * s2 + 7]); pf[2 + s2] = __builtin_bit_cast(bf16x8, w); }
#pragma unroll
            for (int kk = 0; kk < 4; ++kk) {
                const bf16x4 l0 = vl[2 * kk], h0 = vh[2 * kk], l1 = vl[2 * kk + 1], h1 = vh[2 * kk + 1];
                o0 = mfma32((bf16x8){l0[0], l0[1], l0[2], l0[3], h0[0], h0[1], h0[2], h0[3]}, pf[kk], o0);
                o1 = mfma32((bf16x8){l1[0], l1[1], l1[2], l1[3], h1[0], h1[1], h1[2], h1[3]}, pf[kk], o1); }
        }
        if (kt + 1 < KT) {
            bf16* Kn = Ks + ((kt + 1) & 1) * 11264; bf16* Vn = VTs + ((kt + 1) & 1) * 11264;
            *(u32x4*)(Kn + kr0 * 104 + 8 * kc0) = kreg0; if (tid < 256) *(u32x4*)(Kn + kr1 * 104 + 8 * kc1) = kreg1; *(u32x4*)(Vn + vr * 72 + 8 * vc) = vreg;
            if (kt + 2 < KT) { kreg0 = *(const u32x4*)(kbase + (size_t)(key0 + 128 + kr0) * 768 + 8 * kc0); if (tid < 256) kreg1 = *(const u32x4*)(kbase + (size_t)(key0 + 128 + kr1) * 768 + 8 * kc1); vreg = *(const u32x4*)(vbase + key0 + 128); }
        }
        __syncthreads();
    }
    {
        const float inv = 1.f / lsum; const bf16* gp = WSP(bf16, WS_PROJ) + (size_t)tok * INWP + O_GATE + h * 64; bf16* mp = WSP(bf16, WS_MIX) + (size_t)tok * MIXW + 1024 + h * 64;
#pragma unroll
        for (int rr = 0; rr < 4; ++rr) { const int d0 = 8 * rr + 4 * hh;
            { const u32x2 gz = *(const u32x2*)(gp + d0); u32x2 w; w.x = pk2(o0[4 * rr] * inv * silu_f(bflo(gz.x)), o0[4 * rr + 1] * inv * silu_f(bfhi(gz.x))); w.y = pk2(o0[4 * rr + 2] * inv * silu_f(bflo(gz.y)), o0[4 * rr + 3] * inv * silu_f(bfhi(gz.y))); *(u32x2*)(mp + d0) = w; }
            { const u32x2 gz = *(const u32x2*)(gp + 32 + d0); u32x2 w; w.x = pk2(o1[4 * rr] * inv * silu_f(bflo(gz.x)), o1[4 * rr + 1] * inv * silu_f(bfhi(gz.x))); w.y = pk2(o1[4 * rr + 2] * inv * silu_f(bflo(gz.y)), o1[4 * rr + 3] * inv * silu_f(bfhi(gz.y))); *(u32x2*)(mp + 32 + d0) = w; } }
    }
}

struct DecRegs { f32x4 L[2][4]; f32x4 R; };
__device__ __forceinline__ void dec_load(const CAS KArgs& a, unsigned char* ws, int l, int b, int sp, int j, int tid, DecRegs& d) {
    if (j < 16) {
        const int page = ((const int*)a.in[I_PT])[b * NPAGES + 8 * sp + (j >> 1)]; const int key0 = (j & 1) * 64;
        const float* lat = a.in[I_CLAT] + ((size_t)(l * NPHYS + page) * PAGE + key0) * 256; const float* rp = a.in[I_CROPE] + ((size_t)(l * NPHYS + page) * PAGE + key0) * 32;
#pragma unroll
        for (int g2 = 0; g2 < 2; ++g2) { const int gi = tid + 512 * g2, kq = gi >> 6, dq = gi & 63;
#pragma unroll
            for (int i = 0; i < 4; ++i) d.L[g2][i] = __builtin_nontemporal_load((const f32x4*)(lat + (size_t)(4 * kq + i) * 256 + 4 * dq)); }
        d.R = __builtin_nontemporal_load((const f32x4*)(rp + (size_t)(tid >> 3) * 32 + 4 * (tid & 7)));
    } else {
        const bf16* ck = WSP(bf16, WS_CKVN) + (size_t)(NP + 4 * b) * 256; const bf16* kr = WSP(bf16, WS_KROPE) + (size_t)(NP + 4 * b) * 32;
#pragma unroll
        for (int g2 = 0; g2 < 2; ++g2) { const int gi = tid + 512 * g2, kq = gi >> 6, dq = gi & 63;
#pragma unroll
            for (int i = 0; i < 4; ++i) { f32x4 v = (f32x4){0.f, 0.f, 0.f, 0.f}; if (kq == 0) { const u32x2 w = *(const u32x2*)(ck + i * 256 + 4 * dq); v = (f32x4){bflo(w.x), bfhi(w.x), bflo(w.y), bfhi(w.y)}; } d.L[g2][i] = v; } }
        f32x4 v = (f32x4){0.f, 0.f, 0.f, 0.f}; if ((tid >> 3) < 4) { const u32x2 w = *(const u32x2*)(kr + (tid >> 3) * 32 + 4 * (tid & 7)); v = (f32x4){bflo(w.x), bfhi(w.x), bflo(w.y), bfhi(w.y)}; } d.R = v;
    }
}
__device__ __forceinline__ void dec_store(const DecRegs& d, bf16* Kb, int tid) {
#pragma unroll
    for (int g2 = 0; g2 < 2; ++g2) { const int gi = tid + 512 * g2, kq = gi >> 6, dq = gi & 63;
#pragma unroll
        for (int i = 0; i < 4; ++i) { u32x2 w; w.x = pk2(d.L[g2][i].x, d.L[g2][i].y); w.y = pk2(d.L[g2][i].z, d.L[g2][i].w); *(u32x2*)(Kb + (4 * kq + i) * 296 + 4 * dq) = w; } }
    { u32x2 w; w.x = pk2(d.R.x, d.R.y); w.y = pk2(d.R.z, d.R.w); *(u32x2*)(Kb + (tid >> 3) * 296 + 256 + 4 * (tid & 7)) = w; }
}
__device__ __forceinline__ void decode_unit(int l, int unit, unsigned char* lds, int tid) { ENTER();
    const int sp = unit & 15, b = unit >> 4, r32 = lane & 31, hh = lane >> 5;
    bf16* Qs = (bf16*)lds; bf16* Kbuf = (bf16*)(lds + 18944);
    {
        const int row = tid >> 4, t = row >> 3, hq = row & 7, c0 = (tid & 15) * 16;
        const bf16* src = WSP(bf16, WS_QLAT) + (size_t)(4 * b + t) * 2048 + hq * 256 + c0;
#pragma unroll
        for (int i = 0; i < 2; ++i) { const u32x4 w = *(const u32x4*)(src + 8 * i); u32x4 o;
            o.x = pk2(bflo(w.x) * ATT_SC, bfhi(w.x) * ATT_SC); o.y = pk2(bflo(w.y) * ATT_SC, bfhi(w.y) * ATT_SC); o.z = pk2(bflo(w.z) * ATT_SC, bfhi(w.z) * ATT_SC); o.w = pk2(bflo(w.w) * ATT_SC, bfhi(w.w) * ATT_SC);
            *(u32x4*)(Qs + row * 296 + c0 + 8 * i) = o; }
        const int i = tid & 15, tr = NP + 4 * b + t; const bf16* qr = WSP(bf16, WS_Q) + (size_t)tr * 768 + hq * 96 + 64; const float* RC = WSP(float, WS_ROPECS) + (size_t)tr * 32;
        const float x1 = bf2f(qr[i]), x2 = bf2f(qr[16 + i]), c = RC[i], s = RC[16 + i];
        Qs[row * 296 + 256 + i] = f2bf((x1 * c - x2 * s) * ATT_SC); Qs[row * 296 + 272 + i] = f2bf((x2 * c + x1 * s) * ATT_SC);
    }
    const int nt = 16 + (sp == 15 ? 1 : 0);
    DecRegs d; dec_load(a, ws, l, b, sp, 0, tid, d);
    dec_store(d, Kbuf, tid);
    dec_load(a, ws, l, b, sp, 1, tid, d);
    __syncthreads();
    bf16x8 qf[18];
#pragma unroll
    for (int ks = 0; ks < 18; ++ks) qf[ks] = *(const bf16x8*)(Qs + r32 * 296 + 16 * ks + 8 * hh);
    f32x16 oacc;
#pragma unroll
    for (int r = 0; r < 16; ++r) oacc[r] = 0.f;
    float m = -1e30f, lsum = 0.f;
    for (int j = 0; j < nt; ++j) {
        const bf16* Ks = Kbuf + (j & 1) * (64 * 296);
        f32x16 s0, s1;
#pragma unroll
        for (int r = 0; r < 16; ++r) { s0[r] = 0.f; s1[r] = 0.f; }
#pragma unroll
        for (int g3 = 0; g3 < 6; ++g3) {
            bf16x8 ka[6];
#pragma unroll
            for (int kq = 0; kq < 3; ++kq) { const int ks = 3 * g3 + kq; ka[2 * kq] = *(const bf16x8*)(Ks + r32 * 296 + 16 * ks + 8 * hh); ka[2 * kq + 1] = *(const bf16x8*)(Ks + (32 + r32) * 296 + 16 * ks + 8 * hh); }
            __builtin_amdgcn_sched_barrier(0);
#pragma unroll
            for (int kq = 0; kq < 3; ++kq) { s0 = mfma32(ka[2 * kq], qf[3 * g3 + kq], s0); s1 = mfma32(ka[2 * kq + 1], qf[3 * g3 + kq], s1); }
            __builtin_amdgcn_sched_barrier(0); }
        if (j == 16) { const int tq = r32 >> 3;
#pragma unroll
            for (int r = 0; r < 16; ++r) { const int kl = (r & 3) + 8 * (r >> 2) + 4 * hh; if (!(kl < 4 && kl <= tq)) s0[r] = -1e30f; s1[r] = -1e30f; } }
        float mx = s0[0];
#pragma unroll
        for (int r = 1; r < 16; ++r) mx = fmaxf(mx, s0[r]);
#pragma unroll
        for (int r = 0; r < 16; ++r) mx = fmaxf(mx, s1[r]);
        mx = half_max(mx);
        const float mn = fmaxf(m, mx), alpha = __builtin_amdgcn_exp2f(m - mn); m = mn;
        float ps = 0.f;
#pragma unroll
        for (int r = 0; r < 16; ++r) { s0[r] = __builtin_amdgcn_exp2f(s0[r] - mn); s1[r] = __builtin_amdgcn_exp2f(s1[r] - mn); ps += s0[r] + s1[r]; }
        ps = half_sum(ps); lsum = lsum * alpha + ps;
#pragma unroll
        for (int r = 0; r < 16; ++r) oacc[r] *= alpha;
        bf16x8 pf[4];
#pragma unroll
        for (int s2 = 0; s2 < 2; ++s2) { u32x4 w;
            w.x = pk2(s0[8 * s2], s0[8 * s2 + 1]); w.y = pk2(s0[8 * s2 + 2], s0[8 * s2 + 3]); w.z = pk2(s0[8 * s2 + 4], s0[8 * s2 + 5]); w.w = pk2(s0[8 * s2 + 6], s0[8 * s2 + 7]); pf[s2] = __builtin_bit_cast(bf16x8, w);
            w.x = pk2(s1[8 * s2], s1[8 * s2 + 1]); w.y = pk2(s1[8 * s2 + 2], s1[8 * s2 + 3]); w.z = pk2(s1[8 * s2 + 4], s1[8 * s2 + 5]); w.w = pk2(s1[8 * s2 + 6], s1[8 * s2 + 7]); pf[2 + s2] = __builtin_bit_cast(bf16x8, w); }
#pragma unroll
        for (int kk = 0; kk < 4; ++kk) {
            const bf16* vp = Ks + (16 * kk + 4 * hh) * 296 + 32 * wave + r32;
            const bf16x8 va = (bf16x8){(short)vp[0], (short)vp[296], (short)vp[2 * 296], (short)vp[3 * 296], (short)vp[8 * 296], (short)vp[9 * 296], (short)vp[10 * 296], (short)vp[11 * 296]};
            oacc = mfma32(va, pf[kk], oacc); }
        if (j + 1 < nt) { dec_store(d, Kbuf + ((j + 1) & 1) * (64 * 296), tid); if (j + 2 < nt) dec_load(a, ws, l, b, sp, j + 2, tid, d); }
        __syncthreads();
    }
    float* po = WSP(float, WS_PARTO) + ((size_t)(b * 16 + sp) * 32 + r32) * 256 + 32 * wave + 4 * hh;
#pragma unroll
    for (int rr = 0; rr < 4; ++rr) *(f32x4*)(po + 8 * rr) = (f32x4){oacc[4 * rr], oacc[4 * rr + 1], oacc[4 * rr + 2], oacc[4 * rr + 3]};
    if (wave == 0 && hh == 0) { float* pm = WSP(float, WS_PARTML) + ((size_t)(b * 16 + sp) * 32 + r32) * 2; pm[0] = m; pm[1] = lsum; }
}
__device__ __forceinline__ void combine_unit(int l, int u, unsigned char* lds, int tid) { ENTER();
    const int b = u >> 2, t = u & 3;
    float* olat = (float*)lds; float* wts = olat + 2048;
    const float* PO = WSP(float, WS_PARTO) + (size_t)b * 16 * 32 * 256; const float* PM = WSP(float, WS_PARTML) + (size_t)b * 16 * 32 * 2;
    if (tid < 8) { const int q = t * 8 + tid; float M = -1e30f;
        for (int sp = 0; sp < 16; ++sp) M = fmaxf(M, PM[(sp * 32 + q) * 2]);
        float L = 0.f;
        for (int sp = 0; sp < 16; ++sp) { const float w = __builtin_amdgcn_exp2f(PM[(sp * 32 + q) * 2] - M); L += PM[(sp * 32 + q) * 2 + 1] * w; wts[tid * 16 + sp] = w; }
        const float il = 1.f / L;
        for (int sp = 0; sp < 16; ++sp) wts[tid * 16 + sp] *= il; }
    __syncthreads();
    { const int d = tid & 255, h2 = tid >> 8;
#pragma unroll
        for (int hi = 0; hi < 4; ++hi) { const int hq = 4 * h2 + hi, q = t * 8 + hq; float acc = 0.f;
#pragma unroll
            for (int sp = 0; sp < 16; ++sp) acc += PO[((size_t)sp * 32 + q) * 256 + d] * wts[hq * 16 + sp];
            olat[hq * 256 + d] = acc; } }
    __syncthreads();
    {
        const int hq = tid >> 6; const bf16* wr = WSP(bf16, WS_WUV) + (size_t)l * 512 * 256 + (size_t)tid * 256; const float* ol = olat + hq * 256; float acc = 0.f;
#pragma unroll 8
        for (int c = 0; c < 32; ++c) { const u32x4 w = *(const u32x4*)(wr + 8 * c); const f32x4 o0 = *(const f32x4*)(ol + 8 * c), o1 = *(const f32x4*)(ol + 8 * c + 4);
            acc += (bflo(w.x) * o0.x + bfhi(w.x) * o0.y) + (bflo(w.y) * o0.z + bfhi(w.y) * o0.w) + (bflo(w.z) * o1.x + bfhi(w.z) * o1.y) + (bflo(w.w) * o1.z + bfhi(w.w) * o1.w); }
        const int tr = NP + 4 * b + t; const float gz = bf2f(WSP(bf16, WS_PROJ)[(size_t)tr * INWP + O_GATE + tid]);
        WSP(bf16, WS_MIX)[(size_t)tr * MIXW + 1024 + tid] = f2bf(acc * silu_f(gz));
    }
}


__device__ __forceinline__ void tiny_out_unit(int l, int tile, unsigned char* lds, int tid) { ENTER();
    __syncthreads();
    const bf16* WoT = WSP(bf16, WS_WOUT) + (size_t)l * DM * MIXW;
    const int r0 = NP + 16 * (tile >> 5), c0 = 32 * (tile & 31), q4 = lane >> 4, l15 = lane & 15;
    const bf16* ap = WSP(bf16, WS_MIX) + (size_t)(r0 + l15) * MIXW + 256 * wave + 8 * q4; const bf16* bp = WoT + (size_t)(c0 + l15) * MIXW + 256 * wave + 8 * q4;
    f32x4 acc0 = (f32x4){0.f, 0.f, 0.f, 0.f}, acc1 = acc0;
#pragma unroll
    for (int ks = 0; ks < 8; ++ks) { const bf16x8 af = *(const bf16x8*)(ap + 32 * ks); acc0 = mfma16(af, *(const bf16x8*)(bp + 32 * ks), acc0); acc1 = mfma16(af, *(const bf16x8*)(bp + (size_t)16 * MIXW + 32 * ks), acc1); }
    float* part = (float*)lds;
#pragma unroll
    for (int r = 0; r < 4; ++r) { part[(wave * 16 + 4 * q4 + r) * 32 + l15] = acc0[r]; part[(wave * 16 + 4 * q4 + r) * 32 + 16 + l15] = acc1[r]; }
    __syncthreads();
    const int row = tid >> 5, col = tid & 31; float s = 0.f;
#pragma unroll
    for (int w = 0; w < 8; ++w) s += part[(w * 16 + row) * 32 + col];
    const size_t o = (size_t)(r0 + row) * DM + c0 + col; WSP(float, WS_Y)[o] = s + ALPHA * WSP(float, WS_XF)[o];
}
__device__ __forceinline__ void ln_phase(int l, int tid, int bid, int G) { ENTER();
    const float* lg = a.in[I_LNG] + l * DM; const float* lb = a.in[I_LNB] + l * DM;
    const int NGW = G * NWAVES;
    for (int m = bid * NWAVES + wave; m < MT; m += 2 * NGW) {
        const int m2 = (m + NGW < MT) ? m + NGW : m;
        const float* yr = WSP(float, WS_Y) + (size_t)m * DM; const float* yr2 = WSP(float, WS_Y) + (size_t)m2 * DM;
        if (l == 0) ln_row2(yr, yr2, lg, lb, WSP(float, WS_XF) + (size_t)m * DM, WSP(bf16, WS_XN) + (size_t)m * DM, WSP(float, WS_XF) + (size_t)m2 * DM, WSP(bf16, WS_XN) + (size_t)m2 * DM, lane);
        else ln_row2(yr, yr2, lg, lb, (m < NP) ? a.out + OUT_YP + (size_t)m * DM : a.out + OUT_YS + (size_t)(m - NP) * DM, nullptr, (m2 < NP) ? a.out + OUT_YP + (size_t)m2 * DM : a.out + OUT_YS + (size_t)(m2 - NP) * DM, nullptr, lane);
    }
}

constexpr int NPH = 15;
#ifndef PHM
#define PHM 0xFFFF
#endif
#ifndef UM
#define UM 0xFFFF
#endif
#ifndef DUP
#define DUP 0
#endif
#ifndef UDUP
#define UDUP 0
#endif
#ifndef UM2
#define UM2 0xFFFF
#endif
#define REPS(bit) (((DUP) & (bit)) ? 2 : 1)
__global__ void __launch_bounds__(NTHR, 2) hymba_fwd(KArgs a_unused) {
    extern __shared__ __attribute__((aligned(16))) unsigned char lds[];
    const int tid = threadIdx.x, lane = tid & 63, wave = __builtin_amdgcn_readfirstlane(tid >> 6), bid = blockIdx.x, G = gridDim.x;
    const CAS KArgs* kp_ = (const CAS KArgs*)__builtin_amdgcn_kernarg_segment_ptr(); const CAS KArgs& a = *kp_; unsigned char* ws = a.ws;
#define FRESH() asm volatile("" : "+s"(ws))
    volatile unsigned* MISC = (volatile unsigned*)(lds + MISC_OFF);
    if (tid < 64) MISC[tid] = 0u;
    __syncthreads();
    unsigned* ctl = (unsigned*)(a.ws + WS_CTL);
    const int lo = a.ph_lo, hi = a.ph_hi;
    XcdBarrier bar; bar.bar = ctl + CW_BAR; bar.x = 0; bar.st = nullptr;
    if (hi - lo > 1) bar = xcd_barrier_post(ctl + CW_BAR, (volatile LAS unsigned*)(lds + MISC_OFF + 32));
    volatile unsigned* slot = MISC + 16;
#define IN(k) (lo <= (k) && (k) < hi)
#define SEAM(k) do { if (IN(k) && IN((k) + 1)) xcd_barrier(bar); } while (0)
    if (IN(0) && (PHM & 1)) { for (int rep = 0; rep < REPS(1); ++rep) { if (rep) xcd_barrier(bar); ph_prologue(lds, tid, bid, G); } }
    SEAM(0);
    for (int l = 0; l < 2; ++l) {
        const int P = 1 + 7 * l;
        if (IN(P) && (PHM & 2)) for (int rep = 0; rep < REPS(2); ++rep) { if (rep) xcd_barrier(bar); FRESH();
            pg8::Gemm g{WSP(bf16, WS_XN), WSP(bf16, WS_WIN) + (size_t)l * INWP * DM, MP, INWP, DM, DM, DM}; pg8::StaticOrder S; S.init(MP, INWP, G, bid);
            pg8::EpiBf16 E{WSP(bf16, WS_PROJ), INWP, 0};
            pg8::gemm_phase<pg8::EpiBf16, pg8::StaticOrder, true, true>((PG8_LAS unsigned char*)lds, g, S, E);
        }
        SEAM(P);
        if (IN(P + 1) && (PHM & 4)) for (int rep = 0; rep < REPS(4); ++rep) { if (rep) xcd_barrier(bar);
            unsigned* ctr = ctl + CW_Q + 64 * (2 * l + 8 * rep); const int um = rep ? (UM2) : (UM);
            for (;;) { int u = q_next(ctr, slot, tid);
                if (u < 64) { if (um & 4) ssd_sample_unit(l, u, lds, tid); continue; } u -= 64;
                if (u < 128) { if (um & 8) gdn_sample_unit(l, u, lds, tid); continue; } u -= 128;
                if (u < 256) { if (um & 1) { ssd_s1_unit(l, u, lds, tid); if (UDUP & 1) { __syncthreads(); ssd_s1_unit(l, u, lds, tid); } } continue; } u -= 256;
                if (u < 1024) { if (um & 2) { gdn_prep_unit(l, u, lds, tid); if (UDUP & 2) { __syncthreads(); gdn_prep_unit(l, u, lds, tid); } } continue; } u -= 1024;
                if (u < 516) { if (um & 16) e1_unit(l, u, tid); continue; }
                break; }
        }
        SEAM(P + 1);
        if (IN(P + 2) && (PHM & 8)) for (int rep = 0; rep < REPS(8); ++rep) { if (rep) xcd_barrier(bar); FRESH();
            { pg8::Gemm g{WSP(bf16, WS_CQN), WSP(bf16, WS_WUQ) + (size_t)l * 768 * 384, MP, 768, 384, 384, 384}; pg8::StaticOrder S; S.init(MP, 768, G, bid);
              pg8::EpiBf16 E{WSP(bf16, WS_Q), 768, 0}; pg8::gemm_phase<pg8::EpiBf16, pg8::StaticOrder, true, true>((PG8_LAS unsigned char*)lds, g, S, E); }
            { pg8::Gemm g{WSP(bf16, WS_CKVN), WSP(bf16, WS_WUK) + (size_t)l * 512 * 256, NP, 512, 256, 256, 256}; pg8::StaticOrder S; S.init(NP, 512, G, (bid + G - 195 % G) % G);
              pg8::EpiBf16 E{WSP(bf16, WS_KK), 768, 1}; pg8::gemm_phase<pg8::EpiBf16, pg8::StaticOrder, true, true>((PG8_LAS unsigned char*)lds, g, S, E); }
            { pg8::Gemm g{WSP(bf16, WS_WUV) + (size_t)l * 512 * 256, WSP(bf16, WS_CKVN), 512, NP, 256, 256, 256}; pg8::StaticOrder S; S.init(512, NP, G, (bid + G - 67 % G) % G);
              pg8::EpiBf16 E{WSP(bf16, WS_VT), NP, 0}; pg8::gemm_phase<pg8::EpiBf16, pg8::StaticOrder, true, true>((PG8_LAS unsigned char*)lds, g, S, E); }
            { pg8::Gemm g{WSP(bf16, WS_CQN) + (size_t)NP * 384, WSP(bf16, WS_WABS) + (size_t)l * 2048 * 384, 256, 2048, 384, 384, 384}; pg8::StaticOrder S; S.init(256, 2048, G, (bid + G - 195 % G) % G);
              pg8::EpiBf16 E{WSP(bf16, WS_QLAT), 2048, 0}; pg8::gemm_phase<pg8::EpiBf16, pg8::StaticOrder, true, true>((PG8_LAS unsigned char*)lds, g, S, E); }
        }
        SEAM(P + 2);
        if (IN(P + 3) && (PHM & 16)) for (int rep = 0; rep < REPS(16); ++rep) { if (rep) xcd_barrier(bar);
            unsigned* ctr = ctl + CW_Q + 64 * (2 * l + 1 + 8 * rep); const int um = rep ? (UM2) : (UM);
            for (;;) { int u = q_next(ctr, slot, tid);
                if (u < 32) { if (um & 32) { gdn_chain_unit(l, u, lds, tid); if (UDUP & 32) { __syncthreads(); gdn_chain_unit(l, u, lds, tid); } } continue; } u -= 32;
                if (u < 128) { if (um & 64) { ssd_chain_unit(l, u, lds, tid); if (UDUP & 64) { __syncthreads(); ssd_chain_unit(l, u, lds, tid); } } continue; } u -= 128;
                if (u < 1024) { if (u & 1) { if (um & 128) { decode_unit(l, u >> 1, lds, tid); if (UDUP & 128) { __syncthreads(); decode_unit(l, u >> 1, lds, tid); } } } else if (um & 256) { attn_unit(l, u >> 1, lds, tid); if (UDUP & 256) { __syncthreads(); attn_unit(l, u >> 1, lds, tid); } } continue; }
                break; }
        }
        SEAM(P + 3);
        if (IN(P + 4) && (PHM & 32)) for (int rep = 0; rep < REPS(32); ++rep) { if (rep) xcd_barrier(bar);
            for (int u = bid; u < 640; u += G) { if (u < 128) { __syncthreads(); combine_unit(l, u, lds, tid); } else ssd_final_unit(l, u - 128, tid); }
        }
        SEAM(P + 4);
        if (IN(P + 5) && (PHM & 64)) for (int rep = 0; rep < REPS(64); ++rep) { if (rep) xcd_barrier(bar); FRESH();
            const bf16* WoT = WSP(bf16, WS_WOUT) + (size_t)l * DM * MIXW;
            { pg8::Gemm g{WSP(bf16, WS_MIX), WoT, NP, DM, MIXW, MIXW, MIXW}; pg8::StaticOrder S; S.init(NP, DM, G, bid);
              pg8::EpiF32Res E{WSP(float, WS_Y), WSP(float, WS_XF), DM, ALPHA}; pg8::gemm_phase<pg8::EpiF32Res, pg8::StaticOrder, false, true>((PG8_LAS unsigned char*)lds, g, S, E); }
            for (int tile = bid; tile < 256; tile += G) tiny_out_unit(l, tile, lds, tid);
        }
        SEAM(P + 5);
        if (IN(P + 6) && (PHM & 128)) for (int rep = 0; rep < REPS(128); ++rep) { if (rep) xcd_barrier(bar); FRESH();
            ln_phase(l, tid, bid, G);
        }
        if (l == 0) SEAM(P + 6);
    }
#undef IN
#undef SEAM
}

#ifndef MK_ONE_LAUNCH
#define MK_ONE_LAUNCH 1
#endif
extern "C" void kernel_launch(void* const* d_in, const int* in_sizes, int n_in, void* d_out, int out_size, void* d_ws, size_t ws_size, hipStream_t stream) {
    static int grid = 0;
    if (grid == 0) {
        if (n_in != N_IN || (size_t)out_size != OUT_END || ws_size < WS_END) { fprintf(stderr, "kernel_launch: unexpected shapes: n_in %d out %d ws %zu\n", n_in, out_size, ws_size); grid = -1; return; }
        int dev = 0, cus = 0;
        if (hipGetDevice(&dev) != hipSuccess || hipDeviceGetAttribute(&cus, hipDeviceAttributeMultiprocessorCount, dev) != hipSuccess) { grid = -1; return; }
        if (hipFuncSetAttribute((const void*)hymba_fwd, hipFuncAttributeMaxDynamicSharedMemorySize, LDS_BYTES) != hipSuccess) { fprintf(stderr, "kernel_launch: hipFuncSetAttribute failed\n"); grid = -1; return; }
        int per_cu = 0; (void)hipOccupancyMaxActiveBlocksPerMultiprocessor(&per_cu, (const void*)hymba_fwd, NTHR, LDS_BYTES); (void)hipGetLastError();
        grid = cus > 256 ? 256 : cus;
    }
    if (grid < 0) return;
    (void)hipMemsetAsync((char*)d_ws + WS_CTL, 0, CTL_ZERO_BYTES, stream);
    KArgs a{};
    for (int i = 0; i < N_IN; ++i) a.in[i] = (const float*)d_in[i];
    a.out = (float*)d_out; a.ws = (unsigned char*)d_ws;
#if MK_ONE_LAUNCH
    a.ph_lo = 0; a.ph_hi = NPH;
    hipLaunchKernelGGL(hymba_fwd, dim3(grid), dim3(NTHR), LDS_BYTES, stream, a);
#else
    for (int p = 0; p < NPH; ++p) { a.ph_lo = p; a.ph_hi = p + 1; hipLaunchKernelGGL(hymba_fwd, dim3(grid), dim3(NTHR), LDS_BYTES, stream, a); }
#endif
}
```
